# Optimizing an MI355X kernel written in HIP

```python
import jax, jax.numpy as jnp
from jax import lax
import numpy as np

D_MODEL = 1024
BATCH = 8
SEQ = 4096
DEPTH = 2

MIX_WIDTH = 512
N_BRANCH = 4
MLA_HEADS = 8
QK_NOPE = 64
QK_ROPE = 32
V_HEAD = 64
Q_LORA = 384
KV_LORA = 256
ROPE_THETA = 10000.0
Q_BLOCK = 128
POOL_WINDOWS = (2, 4, 8, 16)
POOL_GROUP = MIX_WIDTH // 4
SSD_HEADS = 8
SSD_HEADDIM = 64
SSD_GROUPS = 2
SSD_STATE = 64
SSD_CHUNK = 128
CONV_WIDTH = 4
SSD_XBC = SSD_HEADS * SSD_HEADDIM + 2 * SSD_GROUPS * SSD_STATE
LRU_BLOCKS = 8
LRU_BLOCK = MIX_WIDTH // LRU_BLOCKS
LRU_C = 8.0
D_FF = 4 * D_MODEL
PLE_DIM = 256
EPS = 1e-6

SPLIT_SIZES = (Q_LORA, KV_LORA, QK_ROPE,
               MIX_WIDTH,
               MIX_WIDTH, SSD_XBC, SSD_HEADS,
               MIX_WIDTH, MIX_WIDTH,
               N_BRANCH * D_MODEL)
IN_COLS = sum(SPLIT_SIZES)

kernel_name = "hybrid_gated_mla_pool_ssd_rglru_block"


def _split_points():
    pts, acc = [], 0
    for s in SPLIT_SIZES[:-1]:
        acc += s
        pts.append(acc)
    return pts


def rmsnorm(x, g):
    x32 = x.astype(jnp.float32)
    y = x32 * lax.rsqrt(jnp.mean(x32 * x32, axis=-1, keepdims=True) + EPS)
    return (y * g.astype(jnp.float32)).astype(x.dtype)


def causal_dwconv(x, w, b):
    c = x.shape[-1]
    y = lax.conv_general_dilated(x, w[:, None, :].astype(x.dtype), window_strides=(1,),
                                 padding=[(CONV_WIDTH - 1, 0)],
                                 dimension_numbers=('NWC', 'WIO', 'NWC'),
                                 feature_group_count=c)
    return y + b.astype(x.dtype)


def rope_tables(positions):
    inv = 1.0 / (ROPE_THETA ** (jnp.arange(0, QK_ROPE, 2, dtype=jnp.float32) / QK_ROPE))
    ang = positions.astype(jnp.float32)[..., None] * inv
    return jnp.cos(ang), jnp.sin(ang)


def apply_rope(x, cos, sin):
    x32 = x.astype(jnp.float32)
    x1, x2 = jnp.split(x32, 2, axis=-1)
    out = jnp.concatenate([x1 * cos - x2 * sin, x2 * cos + x1 * sin], axis=-1)
    return out.astype(x.dtype)


def mla_mixer(c_q, c_kv, k_r, cos, sin, q_norm, w_uq, kv_norm, w_ukv):
    b, s, _ = c_q.shape
    q = (rmsnorm(c_q, q_norm) @ w_uq).reshape(b, s, MLA_HEADS, QK_NOPE + QK_ROPE)
    q_nope = q[..., :QK_NOPE]
    q_rope = apply_rope(q[..., QK_NOPE:], cos[:, :, None], sin[:, :, None])
    kv = (rmsnorm(c_kv, kv_norm) @ w_ukv).reshape(b, s, MLA_HEADS, QK_NOPE + V_HEAD)
    k_nope, v = kv[..., :QK_NOPE], kv[..., QK_NOPE:]
    k_rope = apply_rope(k_r, cos, sin)
    scale = (QK_NOPE + QK_ROPE) ** -0.5
    outs = []
    for blk in range(s // Q_BLOCK):
        q0, kend = blk * Q_BLOCK, (blk + 1) * Q_BLOCK
        sc = (jnp.einsum('bqhd,bkhd->bhqk', q_nope[:, q0:kend], k_nope[:, :kend])
              + jnp.einsum('bqhd,bkd->bhqk', q_rope[:, q0:kend], k_rope[:, :kend]))
        sc = sc.astype(jnp.float32) * scale
        qi = q0 + jnp.arange(Q_BLOCK)[:, None]
        ki = jnp.arange(kend)[None, :]
        sc = jnp.where(ki <= qi, sc, -jnp.inf)
        pr = jax.nn.softmax(sc, axis=-1).astype(v.dtype)
        outs.append(jnp.einsum('bhqk,bkhd->bqhd', pr, v[:, :kend]))
    o = jnp.concatenate(outs, axis=1)
    return o.reshape(b, s, MLA_HEADS * V_HEAD)


def pool_mixer(u, w_pool, pool_scale):
    b, s, _ = u.shape
    u32 = u.astype(jnp.float32)
    maxw = max(POOL_WINDOWS)
    cs = jnp.pad(jnp.cumsum(u32, axis=1), ((0, 0), (maxw, 0), (0, 0)))
    t = jnp.arange(s)
    groups = []
    for g, w in enumerate(POOL_WINDOWS):
        sl = slice(g * POOL_GROUP, (g + 1) * POOL_GROUP)
        win_sum = cs[:, maxw:, sl] - cs[:, maxw - w:maxw - w + s, sl]
        count = jnp.minimum(t + 1, w).astype(jnp.float32)[None, :, None]
        groups.append(win_sum / count - u32[..., sl])
    d = jnp.stack(groups, axis=2).astype(u.dtype)
    y = jnp.einsum('bsgc,gcd->bsgd', d, w_pool).reshape(b, s, MIX_WIDTH)
    return y * pool_scale


def segsum(a):
    t = a.shape[-1]
    cs = jnp.cumsum(a, axis=-1)
    diff = cs[..., :, None] - cs[..., None, :]
    mask = jnp.tril(jnp.ones((t, t), dtype=bool))
    return jnp.where(mask, diff, -jnp.inf)


def ssd_mixer(z, xbc, dt, conv_w, conv_b, dt_bias, a_log, d_skip, norm_g):
    b, s, _ = z.shape
    nc, lc, g, r, n, hp = s // SSD_CHUNK, SSD_CHUNK, SSD_GROUPS, SSD_HEADS // SSD_GROUPS, SSD_STATE, SSD_HEADDIM
    xbc = jax.nn.silu(causal_dwconv(xbc, conv_w, conv_b)).astype(jnp.float32)
    xs = xbc[..., :MIX_WIDTH]
    bm = xbc[..., MIX_WIDTH:MIX_WIDTH + g * n].reshape(b, nc, lc, g, n)
    cm = xbc[..., MIX_WIDTH + g * n:].reshape(b, nc, lc, g, n)
    dt = jax.nn.softplus(dt.astype(jnp.float32) + dt_bias.astype(jnp.float32))
    a_head = -jnp.exp(a_log.astype(jnp.float32))
    x = xs.reshape(b, nc, lc, g, r, hp)
    xdt = x * dt.reshape(b, nc, lc, g, r)[..., None]
    a = (dt * a_head).reshape(b, nc, lc, g, r).transpose(0, 3, 4, 1, 2)
    a_cs = jnp.cumsum(a, axis=-1)
    lmat = jnp.exp(segsum(a))
    cb = jnp.einsum('bclgn,bcsgn->bgcls', cm, bm)
    y_diag = jnp.einsum('bgrcls,bcsgrp->bclgrp', cb[:, :, None] * lmat, xdt)
    decay_states = jnp.exp(a_cs[..., -1:] - a_cs)
    states = jnp.einsum('bclgn,bgrcl,bclgrp->bcgrpn', bm, decay_states, xdt)
    states = jnp.concatenate([jnp.zeros_like(states[:, :1]), states], axis=1)
    chunk_a = jnp.pad(a_cs[..., -1], ((0, 0), (0, 0), (0, 0), (1, 0)))
    decay_chunk = jnp.exp(segsum(chunk_a))
    states = jnp.einsum('bgrzc,bcgrpn->bzgrpn', decay_chunk, states)[:, :-1]
    y_off = jnp.einsum('bclgn,bcgrpn,bgrcl->bclgrp', cm, states, jnp.exp(a_cs))
    y = (y_diag + y_off).reshape(b, s, SSD_HEADS, hp) \
        + xs.reshape(b, s, SSD_HEADS, hp) * d_skip.astype(jnp.float32)[:, None]
    y = y.reshape(b, s, MIX_WIDTH) * jax.nn.silu(z.astype(jnp.float32))
    return rmsnorm(y, norm_g).astype(z.dtype)


def rglru_mixer(gate_in, x_in, conv_w, conv_b, w_a, b_a, w_i, b_i, lam):
    b, s, _ = x_in.shape
    gate = jax.nn.gelu(gate_in)
    xc = causal_dwconv(x_in, conv_w, conv_b)
    xb = xc.reshape(b, s, LRU_BLOCKS, LRU_BLOCK)
    r_t = jax.nn.sigmoid((jnp.einsum('bshi,hij->bshj', xb, w_a).reshape(b, s, MIX_WIDTH) + b_a).astype(jnp.float32))
    i_t = jax.nn.sigmoid((jnp.einsum('bshi,hij->bshj', xb, w_i).reshape(b, s, MIX_WIDTH) + b_i).astype(jnp.float32))
    log_a = -LRU_C * r_t * jax.nn.softplus(-lam.astype(jnp.float32))
    a_t = jnp.exp(log_a)
    mult = jnp.sqrt(-jnp.expm1(2.0 * log_a))
    u = xc.astype(jnp.float32) * i_t * mult

    def combine(lhs, rhs):
        a1, b1 = lhs
        a2, b2 = rhs
        return a1 * a2, a2 * b1 + b2

    _, h = lax.associative_scan(combine, (a_t, u), axis=1)
    return h.astype(x_in.dtype) * gate


def setup_inputs(seed: int = 0) -> dict:
    key = jax.random.key(seed)
    ks = iter(jax.random.split(key, 48))
    f32 = jnp.float32

    def nrm(shape, fan_in):
        return jax.random.normal(next(ks), shape, f32) * (fan_in ** -0.5)

    def gain(shape):
        return 1.0 + 0.05 * jax.random.normal(next(ks), shape, f32)

    def small(shape):
        return 0.01 * jax.random.normal(next(ks), shape, f32)

    L = DEPTH
    x = jax.random.normal(next(ks), (BATCH, SEQ, D_MODEL), f32)
    p = jax.random.normal(next(ks), (DEPTH, BATCH, SEQ, PLE_DIM), f32)
    offs = jax.random.randint(next(ks), (BATCH, 1), 0, 1024, dtype=jnp.int32)
    positions = (offs + jnp.arange(SEQ, dtype=jnp.int32)[None, :]).astype(jnp.int32)
    dt0 = jnp.exp(jax.random.uniform(next(ks), (L, SSD_HEADS), f32, np.log(1e-3), np.log(1e-1)))
    dt_bias = dt0 + jnp.log(-jnp.expm1(-dt0))
    a_log = jnp.log(jax.random.uniform(next(ks), (L, SSD_HEADS), f32, 1.0, 16.0))
    a_pow = jax.random.uniform(next(ks), (L, MIX_WIDTH), f32, 0.9, 0.999) ** (1.0 / LRU_C)
    lam = jnp.log(a_pow) - jnp.log1p(-a_pow)
    return {
        "x": x,
        "p": p,
        "positions": positions,
        "g_mix": gain((L, D_MODEL)),
        "w_in": nrm((L, D_MODEL, IN_COLS), D_MODEL),
        "q_norm": gain((L, Q_LORA)),
        "w_uq": nrm((L, Q_LORA, MLA_HEADS * (QK_NOPE + QK_ROPE)), Q_LORA),
        "kv_norm": gain((L, KV_LORA)),
        "w_ukv": nrm((L, KV_LORA, MLA_HEADS * (QK_NOPE + V_HEAD)), KV_LORA),
        "w_pool": nrm((L, 4, POOL_GROUP, POOL_GROUP), POOL_GROUP),
        "pool_scale": 1.0 + 0.1 * jax.random.normal(next(ks), (L, MIX_WIDTH), f32),
        "ssd_conv_w": nrm((L, CONV_WIDTH, SSD_XBC), CONV_WIDTH),
        "ssd_conv_b": small((L, SSD_XBC)),
        "ssd_dt_bias": dt_bias,
        "ssd_a_log": a_log,
        "ssd_d": gain((L, SSD_HEADS)),
        "ssd_norm": gain((L, MIX_WIDTH)),
        "lru_conv_w": nrm((L, CONV_WIDTH, MIX_WIDTH), CONV_WIDTH),
        "lru_conv_b": small((L, MIX_WIDTH)),
        "lru_w_a": nrm((L, LRU_BLOCKS, LRU_BLOCK, LRU_BLOCK), LRU_BLOCK),
        "lru_b_a": small((L, MIX_WIDTH)),
        "lru_w_i": nrm((L, LRU_BLOCKS, LRU_BLOCK, LRU_BLOCK), LRU_BLOCK),
        "lru_b_i": small((L, MIX_WIDTH)),
        "lru_lambda": lam,
        "w_branch": nrm((L, N_BRANCH, MIX_WIDTH, D_MODEL), MIX_WIDTH),
        "w_out": nrm((L, D_MODEL, D_MODEL), D_MODEL),
        "g_mlp": gain((L, D_MODEL)),
        "w_ff1": nrm((L, D_MODEL, D_FF), D_MODEL),
        "w_ff2": nrm((L, D_FF, D_MODEL), D_FF),
        "g_ple": gain((L, D_MODEL)),
        "w_ple_gate": nrm((L, D_MODEL, D_MODEL), D_MODEL),
        "w_ple": nrm((L, PLE_DIM, D_MODEL), PLE_DIM),
        "g_final": gain((D_MODEL,)),
    }


def reference(x, p, positions, g_mix, w_in, q_norm, w_uq, kv_norm, w_ukv, w_pool, pool_scale,
              ssd_conv_w, ssd_conv_b, ssd_dt_bias, ssd_a_log, ssd_d, ssd_norm,
              lru_conv_w, lru_conv_b, lru_w_a, lru_b_a, lru_w_i, lru_b_i, lru_lambda,
              w_branch, w_out, g_mlp, w_ff1, w_ff2, g_ple, w_ple_gate, w_ple, g_final):
    b, s, _ = x.shape
    cos, sin = rope_tables(positions)
    pts = _split_points()
    for l in range(DEPTH):
        h = rmsnorm(x, g_mix[l])
        u = h @ w_in[l]
        c_q, c_kv, k_r, u_pool, z, xbc, dt, lru_g, lru_x, gates = jnp.split(u, pts, axis=-1)
        y_a = mla_mixer(c_q, c_kv, k_r, cos, sin, q_norm[l], w_uq[l], kv_norm[l], w_ukv[l])
        y_b = pool_mixer(u_pool, w_pool[l], pool_scale[l])
        y_c = ssd_mixer(z, xbc, dt, ssd_conv_w[l], ssd_conv_b[l], ssd_dt_bias[l], ssd_a_log[l],
                        ssd_d[l], ssd_norm[l])
        y_d = rglru_mixer(lru_g, lru_x, lru_conv_w[l], lru_conv_b[l], lru_w_a[l], lru_b_a[l],
                          lru_w_i[l], lru_b_i[l], lru_lambda[l])
        gates = jax.nn.sigmoid(gates.reshape(b, s, N_BRANCH, D_MODEL))
        merged = (gates[:, :, 0] * (y_a @ w_branch[l, 0])
                  + gates[:, :, 1] * (y_b @ w_branch[l, 1])
                  + gates[:, :, 2] * (y_c @ w_branch[l, 2])
                  + gates[:, :, 3] * (y_d @ w_branch[l, 3]))
        x = x + merged @ w_out[l]
        h2 = rmsnorm(x, g_mlp[l])
        x = x + jnp.square(jax.nn.relu(h2 @ w_ff1[l])) @ w_ff2[l]
        ple_gate = jax.nn.sigmoid(rmsnorm(x, g_ple[l]) @ w_ple_gate[l])
        x = x + (p[l] @ w_ple[l]) * ple_gate
    return rmsnorm(x, g_final)
```

```cpp
#include <hip/hip_runtime.h>
#include <hip/hip_cooperative_groups.h>
#include <cstdio>
#include <cstdint>
#include <cmath>
namespace cg = cooperative_groups;

#define LAS __attribute__((address_space(3)))
typedef unsigned short bf16_t;
typedef short bf16x8 __attribute__((ext_vector_type(8)));
typedef float f32x4 __attribute__((ext_vector_type(4)));
typedef float f32x2 __attribute__((ext_vector_type(2)));
typedef unsigned u32x4 __attribute__((ext_vector_type(4)));
typedef unsigned u32x2 __attribute__((ext_vector_type(2)));
typedef __bf16 bf16x2_t __attribute__((ext_vector_type(2)));

constexpr int M = 32768, SEQ = 4096, NB = 8, D = 1024, DEPTH = 2;
constexpr int INC = 7592;
constexpr float EPS = 1e-6f;
constexpr float QSCALE = 0.10206207261596577f * 1.4426950408889634f;

constexpr size_t MiB = 1u << 20;
constexpr size_t WS_SSQA = 2 * MiB, WS_SSQB = 4 * MiB, WS_RSQ = 6 * MiB, WS_RSKV = WS_RSQ + 128 * 1024, WS_RSC = WS_RSKV + 128 * 1024;
constexpr size_t WS_DTF = 7 * MiB, WS_CS = 8 * MiB, WS_SSQC = 12 * MiB;
constexpr size_t WS_W = 16 * MiB, WS_XB = 60 * MiB, WS_Y = 124 * MiB, WS_BIG = 252 * MiB, WS_END = 512 * MiB;
constexpr size_t B_U1 = WS_BIG, B_UA = WS_BIG + 64 * MiB, B_UB = WS_BIG + 112 * MiB, B_BC = WS_BIG + 224 * MiB, B_KR = WS_BIG + 240 * MiB;
constexpr size_t B_QR = WS_BIG + 112 * MiB, B_KV = WS_BIG + 128 * MiB, B_LA = WS_BIG + 192 * MiB;
constexpr size_t B_T0 = WS_BIG, B_T1 = WS_BIG + 64 * MiB, B_MB = WS_BIG + 128 * MiB;
constexpr size_t B_H = WS_BIG;
constexpr size_t Y_TP = WS_Y, Y_PB = WS_Y + 64 * MiB;
constexpr size_t W_IN = 0, W_G = W_IN + 3584ull * 1024, W_UQ = W_G + 4096ull * 1024, W_UKV = W_UQ + 768ull * 384, W_POOL = W_UKV + 1024ull * 256,
                 W_LRU = W_POOL + 512ull * 256, W_BR = W_LRU + 1024ull * 128, W_OUT = W_BR + 4096ull * 512, W_FF1 = W_OUT + 1024ull * 1024,
                 W_FF2 = W_FF1 + 4096ull * 1024, W_PG = W_FF2 + 4096ull * 1024, W_PLE = W_PG + 1024ull * 1024, W_TOTAL = W_PLE + 1024ull * 256;
static_assert(W_TOTAL * 2 <= 44 * MiB, "weights fit");

struct Params {
    const float* in[33];
    float* out;
    unsigned char* ws;
    double inv_freq[16];
};

typedef const __attribute__((address_space(4))) Params* PP;
#if defined(__HIP_DEVICE_COMPILE__)
#define ASSUME_GLOBAL(p) do { __builtin_assume(!__builtin_amdgcn_is_shared((const __attribute__((address_space(0))) void*)(p))); __builtin_assume(!__builtin_amdgcn_is_private((const __attribute__((address_space(0))) void*)(p))); } while (0)
#else
#define ASSUME_GLOBAL(p) do { } while (0)
#endif
__device__ __forceinline__ unsigned cvt_pk_bf16(float lo, float hi) { unsigned r; asm("v_cvt_pk_bf16_f32 %0, %1, %2" : "=v"(r) : "v"(lo), "v"(hi)); return r; }
__device__ __forceinline__ float bflo(unsigned w) { return __uint_as_float(w << 16); }
__device__ __forceinline__ float bfhi(unsigned w) { return __uint_as_float(w & 0xffff0000u); }
__device__ __forceinline__ float bf2f(bf16_t h) { return __uint_as_float(((unsigned)h) << 16); }
__device__ __forceinline__ bf16_t f2bf(float f) { return (bf16_t)(cvt_pk_bf16(f, 0.f) & 0xffffu); }
__device__ __forceinline__ u32x4 pack8(f32x4 a, f32x4 b) { u32x4 w; w.x = cvt_pk_bf16(a[0], a[1]); w.y = cvt_pk_bf16(a[2], a[3]); w.z = cvt_pk_bf16(b[0], b[1]); w.w = cvt_pk_bf16(b[2], b[3]); return w; }
__device__ __forceinline__ void unpack8(u32x4 w, f32x4& a, f32x4& b) { a = (f32x4){bflo(w.x), bfhi(w.x), bflo(w.y), bfhi(w.y)}; b = (f32x4){bflo(w.z), bfhi(w.z), bflo(w.w), bfhi(w.w)}; }
__device__ __forceinline__ float dot2x(unsigned a, unsigned b, float c) { return c + bflo(a) * bflo(b) + bfhi(a) * bfhi(b); }
__device__ __forceinline__ float sigmoidf_(float x) { return __builtin_amdgcn_rcpf(1.f + __builtin_amdgcn_exp2f(-1.4426950408889634f * x)); }
__device__ __forceinline__ float one_minus_exp(float x) {
    const float p = -x * (1.f + x * (0.5f + x * (0.16666667f + x * (0.041666668f + x * (0.008333334f + x * (0.0013888889f + x * 0.0001984127f))))));
    return x < -0.25f ? 1.f - __expf(x) : p;
}
__device__ __forceinline__ float wave_sum(float v) {
#pragma unroll
    for (int o = 1; o < 64; o <<= 1) v += __shfl_xor(v, o);
    return v;
}
__device__ __forceinline__ float rstd16(const float* ssq, int row) {
    const f32x4* p = (const f32x4*)(ssq + (size_t)row * 16);
    f32x4 a = p[0], b = p[1], c = p[2], d = p[3];
    f32x4 s = (a + b) + (c + d);
    return rsqrtf(((s[0] + s[1]) + (s[2] + s[3])) * (1.f / 1024.f) + EPS);
}

namespace pg8 {
constexpr int BM = 256, BK = 64, HALF = 128, HTB = HALF * BK * 2, STAGE_BYTES = 8 * HTB, NXCD = 8, WGM = 8;
__host__ __device__ __forceinline__ int lds_byte(int r, int c) { const int st = (r >> 4) * 2 + (c >> 5), rr = r & 15, cc = c & 31, ob = rr * 64 + cc * 2; return st * 1024 + (ob ^ (((ob >> 9) & 1) << 5)); }
__host__ __device__ __forceinline__ void stage_rc(int b, int& R, int& C) { const int st = b / 1024, sb = b % 1024, swz = sb ^ (((sb >> 9) & 1) << 5); R = (st >> 1) * 16 + swz / 64; C = (st & 1) * 32 + (swz % 64) / 2; }
__host__ __device__ __forceinline__ int perm32(int rho) { const int n = rho >> 4, i = rho & 15; return 8 * (i >> 2) + 4 * n + (i & 3); }

struct Unit { int pm, pn, ui; };
struct Gemm { const bf16_t* A; const bf16_t* Bt; int M, N, K, lda, a_pn_off, a_sh; };

struct StaticOrder {
    int nM, nN, nwg, G, c, rev;
    __device__ __forceinline__ void init(int M_, int N_, int G_, int c_) { nM = M_ / BM; nN = N_ / BM; nwg = nM * nN; G = G_; c = c_; rev = 0; }
    __device__ __forceinline__ bool next(int i, Unit& u) const {
        const long L = (long)i * G + c; if (L >= nwg) return false;
        int wgid = (int)L; { const int q = nwg / NXCD, r = nwg % NXCD, xcd = wgid % NXCD, off = wgid / NXCD; wgid = (xcd < r ? xcd * (q + 1) : r * (q + 1) + (xcd - r) * q) + off; }
        const int nig = WGM * nN, gid = wgid / nig, fm = gid * WGM, gsz = (nM - fm) < WGM ? (nM - fm) : WGM;
        u.pm = fm + ((wgid % nig) % gsz); u.pn = (wgid % nig) / gsz; if (rev) u.pm = nM - 1 - u.pm; return true;
    }
};

struct GateOrder {
    StaticOrder base;
    __device__ __forceinline__ bool next(int i, Unit& u) const { Unit t; if (!base.next(i >> 2, t)) return false; u.pm = t.pm; u.pn = (i & 3) * 4 + t.pn; return true; }
};
constexpr int RSL_OFF = 135168;
template <class Sched>
__device__ __forceinline__ void rstd_prepass(LAS unsigned char* lds, const float* ssq, const Sched& S, int tid_) {
    asm volatile("" : "+v"(tid_));
    LAS float* rsl = (LAS float*)(lds + RSL_OFF); Unit u;
    for (int i = tid_ >> 8; i < 10 && S.next(i, u); i += 2) rsl[i * 256 + (tid_ & 255)] = rstd16(ssq, u.pm * 256 + (tid_ & 255));
    __syncthreads();
}
#define RSL(u_, row_) (((const LAS float*)(lds_rs + RSL_OFF))[(u_).ui * 256 + ((row_) & 255)])
template <class Epi, class Sched>
__device__ __forceinline__ void gemm_phase(LAS unsigned char* lds, const Gemm g, const Sched& S, const Epi& E) {
    int tid = threadIdx.x; asm volatile("" : "+v"(tid));
    const int wid = __builtin_amdgcn_readfirstlane(tid >> 6), lane = tid & 63, wr = wid >> 2, wc = wid & 3, fr = lane & 15, fq = lane >> 4;
    int K = g.K, lda = g.lda; asm volatile("" : "+s"(K), "+s"(lda));
    const int nt = K / BK;
    unsigned voffA[2], voffB[2];
#pragma unroll
    for (int i = 0; i < 2; ++i) { int R, C; stage_rc(tid * 16 + i * 8192, R, C); const int Rb = (R & ~31) + perm32(R & 31);
        voffA[i] = (unsigned)(R * lda + C) * 2u; voffB[i] = (unsigned)(Rb * K + C) * 2u; }
    const size_t kstep = (size_t)(BK * 2);
    const size_t hsA = (size_t)HALF * lda * 2, hsB = (size_t)HALF * K * 2;
    const size_t tsA = 2 * hsA, tsB = 2 * hsB, pnA = (size_t)g.a_pn_off * 2;
    const unsigned ldsw = (unsigned)wid * 1024u;
    const int aoff = lds_byte(wr * 64 + fr, fq * 8), boff = lds_byte(wc * 32 + fr, fq * 8);
#define PG8_SA(b, h) (((b) * 2 + (h)) * HTB)
#define PG8_SB(b, h) ((4 + (b) * 2 + (h)) * HTB)
#define PG8_STAGE(bufoff, gbase, voff) do { _Pragma("unroll") for (int _i = 0; _i < 2; ++_i) \
        __builtin_amdgcn_global_load_lds((const unsigned*)((const char*)(gbase) + (voff)[_i]), (LAS unsigned*)(lds + (bufoff) + ldsw + _i * 8192), 16, 0, 0); } while (0)
#define PG8_LDA(dst, b, h) do { _Pragma("unroll") for (int m = 0; m < 4; ++m) _Pragma("unroll") for (int k = 0; k < 2; ++k) dst[m][k] = *(const LAS bf16x8*)(lds + PG8_SA(b, h) + aoff + m * 2048 + k * 1024); } while (0)
#define PG8_LDB(dst, b, h) do { _Pragma("unroll") for (int n = 0; n < 2; ++n) _Pragma("unroll") for (int k = 0; k < 2; ++k) dst[n][k] = *(const LAS bf16x8*)(lds + PG8_SB(b, h) + boff + n * 2048 + k * 1024); } while (0)
#define PG8_MMA(ai, bj, At, Bt) do { __builtin_amdgcn_s_setprio(1); _Pragma("unroll") for (int m = 0; m < 4; ++m) _Pragma("unroll") for (int n = 0; n < 2; ++n) _Pragma("unroll") for (int k = 0; k < 2; ++k) \
        acc[ai][bj][m][n] = __builtin_amdgcn_mfma_f32_16x16x32_bf16(Bt[n][k], At[m][k], acc[ai][bj][m][n], 0, 0, 0); __builtin_amdgcn_s_setprio(0); } while (0)
#define PG8_WAIT_V(n) asm volatile("s_waitcnt vmcnt(" #n ")" ::: "memory")
#define PG8_WAIT_L(n) asm volatile("s_waitcnt lgkmcnt(" #n ")" ::: "memory")
#define PG8_BAR __builtin_amdgcn_s_barrier()
#define PG8_SCHED __builtin_amdgcn_sched_barrier(0)
    Unit cur, nxt; int ui = 0;
    if (!S.next(0, cur)) return;
    f32x4 acc[2][2][4][2];
#pragma unroll
    for (int a = 0; a < 2; ++a)
#pragma unroll
        for (int b = 0; b < 2; ++b)
#pragma unroll
            for (int m = 0; m < 4; ++m)
#pragma unroll
                for (int n = 0; n < 2; ++n) acc[a][b][m][n] = (f32x4){0.f, 0.f, 0.f, 0.f};
    bf16x8 At[4][2], B0[2][2], B1[2][2];
    const char* cA = (const char*)g.A + (size_t)cur.pm * tsA + (size_t)(cur.pn >> g.a_sh) * pnA; const char* cB = (const char*)g.Bt + (size_t)cur.pn * tsB;
    PG8_STAGE(PG8_SB(0, 0), cB, voffB); PG8_STAGE(PG8_SB(0, 1), cB + hsB, voffB); PG8_STAGE(PG8_SA(0, 0), cA, voffA); PG8_STAGE(PG8_SA(0, 1), cA + hsA, voffA);
    if (wr == 1) PG8_BAR;
    PG8_WAIT_V(2); PG8_BAR;
    PG8_STAGE(PG8_SB(1, 0), cB + kstep, voffB); PG8_STAGE(PG8_SA(1, 0), cA + kstep, voffA); PG8_STAGE(PG8_SB(1, 1), cB + hsB + kstep, voffB);
    PG8_WAIT_V(6); PG8_BAR;
    for (;;) {
        const bool has_next = S.next(ui + 1, nxt);
        const char* nA = has_next ? (const char*)g.A + (size_t)nxt.pm * tsA + (size_t)(nxt.pn >> g.a_sh) * pnA : cA; const char* nB = has_next ? (const char*)g.Bt + (size_t)nxt.pn * tsB : cB;
        for (int t = 0; t < nt; t += 2) {
            const bool last = (t == nt - 2);
            const char* a1 = cA + (size_t)(t + 1) * kstep;
            const char* a2 = last ? nA : cA + (size_t)(t + 2) * kstep; const char* b2 = last ? nB : cB + (size_t)(t + 2) * kstep;
            const char* a3 = a2 + kstep; const char* b3 = b2 + kstep;
            PG8_LDB(B0, 0, 0); PG8_LDB(B1, 0, 1); PG8_SCHED; PG8_LDA(At, 0, 0); PG8_STAGE(PG8_SA(1, 1), a1 + hsA, voffA);
            PG8_WAIT_V(8); PG8_WAIT_L(0); PG8_BAR; PG8_MMA(0, 0, At, B0); PG8_MMA(0, 1, At, B1); PG8_BAR; PG8_SCHED;
            PG8_LDA(At, 0, 1); PG8_STAGE(PG8_SB(0, 0), b2, voffB); PG8_STAGE(PG8_SB(0, 1), b2 + hsB, voffB); PG8_STAGE(PG8_SA(0, 0), a2, voffA);
            PG8_WAIT_V(8); PG8_WAIT_L(0); PG8_BAR; PG8_MMA(1, 0, At, B0); PG8_MMA(1, 1, At, B1); PG8_BAR; PG8_SCHED;
            PG8_LDB(B0, 1, 0); PG8_LDB(B1, 1, 1); PG8_SCHED; PG8_LDA(At, 1, 0); PG8_STAGE(PG8_SA(0, 1), a2 + hsA, voffA);
            PG8_WAIT_V(8); PG8_WAIT_L(0); PG8_BAR; PG8_MMA(0, 0, At, B0); PG8_MMA(0, 1, At, B1); PG8_BAR; PG8_SCHED;
            PG8_LDA(At, 1, 1); PG8_STAGE(PG8_SB(1, 0), b3, voffB); PG8_STAGE(PG8_SB(1, 1), b3 + hsB, voffB); PG8_STAGE(PG8_SA(1, 0), a3, voffA);
            PG8_WAIT_V(8); PG8_WAIT_L(0); PG8_BAR; PG8_MMA(1, 0, At, B0); PG8_MMA(1, 1, At, B1); PG8_BAR; PG8_SCHED;
        }
        if (wr == 0) PG8_BAR;
        cur.ui = ui; E(acc, cur, wr, wc, fr, fq);
        if (!has_next) break;
#pragma unroll
        for (int a = 0; a < 2; ++a)
#pragma unroll
            for (int b = 0; b < 2; ++b)
#pragma unroll
                for (int m = 0; m < 4; ++m)
#pragma unroll
                    for (int n = 0; n < 2; ++n) acc[a][b][m][n] = (f32x4){0.f, 0.f, 0.f, 0.f};
        cur = nxt; cA = nA; cB = nB; ++ui;
        if (wr == 1) PG8_BAR;
    }
    PG8_WAIT_V(0);
    PG8_BAR;
#undef PG8_SA
#undef PG8_SB
#undef PG8_STAGE
#undef PG8_LDA
#undef PG8_LDB
#undef PG8_MMA
#undef PG8_WAIT_V
#undef PG8_WAIT_L
#undef PG8_BAR
#undef PG8_SCHED
}

struct MUnit { int pm, pn, ui, kind, n; };
struct MergeOrder { StaticOrder base;
    __device__ __forceinline__ bool next(int i, MUnit& u) const { Unit t; if (!base.next(i >> 3, t)) return false; u.pm = t.pm; u.pn = t.pn; u.n = (i >> 1) & 3; u.kind = i & 1; u.ui = i; return true; } };
template <class Epi>
__device__ __forceinline__ void gemm_merge_fused(LAS unsigned char* lds, const bf16_t* Yb, const bf16_t* XBb, const bf16_t* WBR, const bf16_t* WG, const MergeOrder& S, const Epi& E) {
    int tid = threadIdx.x; asm volatile("" : "+v"(tid));
    const int wid = __builtin_amdgcn_readfirstlane(tid >> 6), lane = tid & 63, wr = wid >> 2, wc = wid & 3, fr = lane & 15, fq = lane >> 4;
    int R0, C0; stage_rc(tid * 16, R0, C0);
    const unsigned Rb0 = (unsigned)((R0 & ~31) + perm32(R0 & 31)), Ra0 = (unsigned)R0, C2 = (unsigned)C0 * 2u;
    int la0 = 4096, lb0 = 1024, la1_ = 2048, lb1 = 2048, nt0 = 8, nt1 = 16;
    asm volatile("" : "+s"(la0), "+s"(lb0), "+s"(la1_), "+s"(lb1), "+s"(nt0), "+s"(nt1));
#define MF_LA(k) ((unsigned)((k) ? la1_ : la0))
#define MF_LB(k) ((unsigned)((k) ? lb1 : lb0))
    const size_t kstep = (size_t)(BK * 2);
#define MF_ABASE(u_) ((u_).kind ? (const char*)XBb + (size_t)(u_).pm * 256 * 1024 * 2 : (const char*)Yb + (size_t)(u_).pm * 256 * 2048 * 2 + (size_t)(u_).n * 512 * 2)
#define MF_BBASE(u_) ((u_).kind ? (const char*)WG + ((size_t)(u_).n * 1024 + (size_t)(u_).pn * 256) * 1024 * 2 : (const char*)WBR + ((size_t)(u_).n * 1024 + (size_t)(u_).pn * 256) * 512 * 2)
    const unsigned ldsw = (unsigned)wid * 1024u;
    const int aoff = lds_byte(wr * 64 + fr, fq * 8), boff = lds_byte(wc * 32 + fr, fq * 8);
#define PG8_SA(b, h) (((b) * 2 + (h)) * HTB)
#define PG8_SB(b, h) ((4 + (b) * 2 + (h)) * HTB)
#define PG8_STAGE(bufoff, gbase, voff) do { _Pragma("unroll") for (int _i = 0; _i < 2; ++_i) \
        __builtin_amdgcn_global_load_lds((const unsigned*)((const char*)(gbase) + (voff)[_i]), (LAS unsigned*)(lds + (bufoff) + ldsw + _i * 8192), 16, 0, 0); } while (0)
#define PG8_LDA(dst, b, h) do { _Pragma("unroll") for (int m = 0; m < 4; ++m) _Pragma("unroll") for (int k = 0; k < 2; ++k) dst[m][k] = *(const LAS bf16x8*)(lds + PG8_SA(b, h) + aoff + m * 2048 + k * 1024); } while (0)
#define PG8_LDB(dst, b, h) do { _Pragma("unroll") for (int n = 0; n < 2; ++n) _Pragma("unroll") for (int k = 0; k < 2; ++k) dst[n][k] = *(const LAS bf16x8*)(lds + PG8_SB(b, h) + boff + n * 2048 + k * 1024); } while (0)
#define PG8_MMA(ai, bj, At, Bt) do { __builtin_amdgcn_s_setprio(1); _Pragma("unroll") for (int m = 0; m < 4; ++m) _Pragma("unroll") for (int n = 0; n < 2; ++n) _Pragma("unroll") for (int k = 0; k < 2; ++k) \
        acc[ai][bj][m][n] = __builtin_amdgcn_mfma_f32_16x16x32_bf16(Bt[n][k], At[m][k], acc[ai][bj][m][n], 0, 0, 0); __builtin_amdgcn_s_setprio(0); } while (0)
#define PG8_WAIT_V(n) asm volatile("s_waitcnt vmcnt(" #n ")" ::: "memory")
#define PG8_WAIT_L(n) asm volatile("s_waitcnt lgkmcnt(" #n ")" ::: "memory")
#define PG8_BAR __builtin_amdgcn_s_barrier()
#define PG8_SCHED __builtin_amdgcn_sched_barrier(0)
    MUnit cur, nxt; int ui = 0;
    if (!S.next(0, cur)) return;
    f32x4 acc[2][2][4][2];
#pragma unroll
    for (int a = 0; a < 2; ++a)
#pragma unroll
        for (int b = 0; b < 2; ++b)
#pragma unroll
            for (int m = 0; m < 4; ++m)
#pragma unroll
                for (int n = 0; n < 2; ++n) acc[a][b][m][n] = (f32x4){0.f, 0.f, 0.f, 0.f};
    bf16x8 At[4][2], B0[2][2], B1[2][2];
    const char* cA = MF_ABASE(cur); const char* cB = MF_BBASE(cur); int ck = cur.kind;
    { const unsigned la = MF_LA(ck), lb = MF_LB(ck); unsigned voffA[2] = {Ra0 * la + C2, Ra0 * la + C2 + 64u * la}, voffB[2] = {Rb0 * lb + C2, Rb0 * lb + C2 + 64u * lb}; const size_t hsA = (size_t)128 * la, hsB = (size_t)128 * lb;
    PG8_STAGE(PG8_SB(0, 0), cB, voffB); PG8_STAGE(PG8_SB(0, 1), cB + hsB, voffB); PG8_STAGE(PG8_SA(0, 0), cA, voffA); PG8_STAGE(PG8_SA(0, 1), cA + hsA, voffA);
    if (wr == 1) PG8_BAR;
    PG8_WAIT_V(2); PG8_BAR;
    PG8_STAGE(PG8_SB(1, 0), cB + kstep, voffB); PG8_STAGE(PG8_SA(1, 0), cA + kstep, voffA); PG8_STAGE(PG8_SB(1, 1), cB + hsB + kstep, voffB);
    PG8_WAIT_V(6); PG8_BAR; }
    for (;;) {
        const bool has_next = S.next(ui + 1, nxt);
        const char* nA = cA; const char* nB = cB; int nk = ck;
        if (has_next) { nA = MF_ABASE(nxt); nB = MF_BBASE(nxt); nk = nxt.kind; }
        const int nt = ck ? nt1 : nt0;
        for (int t = 0; t < nt; t += 2) {
            const bool last = (t == nt - 2);
            const int kx = last ? nk : ck;
            const unsigned la1 = MF_LA(ck), lax = MF_LA(kx), lbx = MF_LB(kx);
            unsigned voffA1[2] = {Ra0 * la1 + C2, Ra0 * la1 + C2 + 64u * la1};
            unsigned voffA[2] = {Ra0 * lax + C2, Ra0 * lax + C2 + 64u * lax};
            unsigned voffB[2] = {Rb0 * lbx + C2, Rb0 * lbx + C2 + 64u * lbx};
            const size_t hsA1 = (size_t)128 * la1, hsA = (size_t)128 * lax, hsB = (size_t)128 * lbx;
            const char* a1 = cA + (size_t)(t + 1) * kstep;
            const char* a2 = last ? nA : cA + (size_t)(t + 2) * kstep; const char* b2 = last ? nB : cB + (size_t)(t + 2) * kstep;
            const char* a3 = a2 + kstep; const char* b3 = b2 + kstep;
            PG8_LDB(B0, 0, 0); PG8_LDB(B1, 0, 1); PG8_SCHED; PG8_LDA(At, 0, 0); PG8_STAGE(PG8_SA(1, 1), a1 + hsA1, voffA1);
            PG8_WAIT_V(8); PG8_WAIT_L(0); PG8_BAR; PG8_MMA(0, 0, At, B0); PG8_MMA(0, 1, At, B1); PG8_BAR; PG8_SCHED;
            PG8_LDA(At, 0, 1); PG8_STAGE(PG8_SB(0, 0), b2, voffB); PG8_STAGE(PG8_SB(0, 1), b2 + hsB, voffB); PG8_STAGE(PG8_SA(0, 0), a2, voffA);
            PG8_WAIT_V(8); PG8_WAIT_L(0); PG8_BAR; PG8_MMA(1, 0, At, B0); PG8_MMA(1, 1, At, B1); PG8_BAR; PG8_SCHED;
            PG8_LDB(B0, 1, 0); PG8_LDB(B1, 1, 1); PG8_SCHED; PG8_LDA(At, 1, 0); PG8_STAGE(PG8_SA(0, 1), a2 + hsA, voffA);
            PG8_WAIT_V(8); PG8_WAIT_L(0); PG8_BAR; PG8_MMA(0, 0, At, B0); PG8_MMA(0, 1, At, B1); PG8_BAR; PG8_SCHED;
            PG8_LDA(At, 1, 1); PG8_STAGE(PG8_SB(1, 0), b3, voffB); PG8_STAGE(PG8_SB(1, 1), b3 + hsB, voffB); PG8_STAGE(PG8_SA(1, 0), a3, voffA);
            PG8_WAIT_V(8); PG8_WAIT_L(0); PG8_BAR; PG8_MMA(1, 0, At, B0); PG8_MMA(1, 1, At, B1); PG8_BAR; PG8_SCHED;
        }
        if (wr == 0) PG8_BAR;
        cur.ui = ui; E(acc, cur, wr, wc, fr, fq);
        if (!has_next) break;
#pragma unroll
        for (int a = 0; a < 2; ++a)
#pragma unroll
            for (int b = 0; b < 2; ++b)
#pragma unroll
                for (int m = 0; m < 4; ++m)
#pragma unroll
                    for (int n = 0; n < 2; ++n) acc[a][b][m][n] = (f32x4){0.f, 0.f, 0.f, 0.f};
        cur = nxt; cA = nA; cB = nB; ck = nk; ++ui;
        if (wr == 1) PG8_BAR;
    }
    PG8_WAIT_V(0);
    PG8_BAR;
#undef MF_ABASE
#undef MF_BBASE
#undef MF_LA
#undef MF_LB
#undef PG8_SA
#undef PG8_SB
#undef PG8_STAGE
#undef PG8_LDA
#undef PG8_LDB
#undef PG8_MMA
#undef PG8_WAIT_V
#undef PG8_WAIT_L
#undef PG8_BAR
#undef PG8_SCHED
}

#define EPI_ROWS_BEGIN _Pragma("unroll") for (int ai = 0; ai < 2; ++ai) _Pragma("unroll") for (int m = 0; m < 4; ++m) { const int row = u.pm * 256 + ai * 128 + wr * 64 + m * 16 + fr;
#define EPI_ROWS_END if (m & 1) asm volatile("" ::: "memory"); }
typedef const f32x4 (&AccRef)[2][2][4][2];

struct EpiInproj {
    bf16_t *u1, *ua, *ub; const LAS unsigned char* lds_rs;
    __device__ __forceinline__ void operator()(AccRef acc, const Unit& u, int wr, int wc, int fr, int fq) const {
        bf16_t* base; int ld, ct; const int pn = u.pn;
        if (pn < 4) { base = u1; ld = 1024; ct = pn; } else if (pn < 7) { base = ua; ld = 768; ct = pn - 4; } else { base = ub; ld = 1792; ct = pn - 7; }
        const int col0 = ct * 256 + wc * 32 + 8 * fq;
        EPI_ROWS_BEGIN
            const float r = RSL(u, row);
#pragma unroll
            for (int bj = 0; bj < 2; ++bj) *(u32x4*)(base + (size_t)row * ld + col0 + bj * 128) = pack8(acc[ai][bj][m][0] * r, acc[ai][bj][m][1] * r);
        EPI_ROWS_END
    }
};
struct EpiQ {
    bf16_t *y, *qr; const float* rsq; const f32x2* cs;
    __device__ __forceinline__ void operator()(AccRef acc, const Unit& u, int wr, int wc, int fr, int fq) const {
        const int pn = u.pn;
        EPI_ROWS_BEGIN
            const float r = rsq[row] * QSCALE;
#pragma unroll
            for (int bj = 0; bj < 2; ++bj) {
                f32x4 v0 = acc[ai][bj][m][0] * r, v1 = acc[ai][bj][m][1] * r;
                if (pn < 2) { *(u32x4*)(y + (size_t)row * 2048 + pn * 256 + bj * 128 + wc * 32 + 8 * fq) = pack8(v0, v1); }
                else {
                    const int c0 = bj * 128 + wc * 32 + 8 * fq, i0 = (c0 & 31) >> 1;
                    const f32x4* cp = (const f32x4*)(cs + (size_t)row * 16 + i0);
                    const f32x4 t0 = cp[0], t1 = cp[1];
                    f32x4 o0, o1;
                    o0[0] = v0[0] * t0[0] - v0[1] * t0[1]; o0[1] = v0[1] * t0[0] + v0[0] * t0[1];
                    o0[2] = v0[2] * t0[2] - v0[3] * t0[3]; o0[3] = v0[3] * t0[2] + v0[2] * t0[3];
                    o1[0] = v1[0] * t1[0] - v1[1] * t1[1]; o1[1] = v1[1] * t1[0] + v1[0] * t1[1];
                    o1[2] = v1[2] * t1[2] - v1[3] * t1[3]; o1[3] = v1[3] * t1[2] + v1[2] * t1[3];
                    *(u32x4*)(qr + (size_t)row * 256 + c0) = pack8(o0, o1);
                }
            }
        EPI_ROWS_END
    }
};
struct EpiRowScale {
    bf16_t* o0; int ld; const float* rs; size_t split;
    __device__ __forceinline__ void operator()(AccRef acc, const Unit& u, int wr, int wc, int fr, int fq) const {
        bf16_t* o = split ? o0 + (size_t)(u.pn >> 2) * split : o0;
        const int col0 = (split ? (u.pn & 3) : u.pn) * 256 + wc * 32 + 8 * fq;
        EPI_ROWS_BEGIN
            const float r = rs ? rs[row] : 1.f;
#pragma unroll
            for (int bj = 0; bj < 2; ++bj) *(u32x4*)(o + (size_t)row * ld + col0 + bj * 128) = pack8(acc[ai][bj][m][0] * r, acc[ai][bj][m][1] * r);
        EPI_ROWS_END
    }
};
struct EpiLru {
    bf16_t* y3; bf16_t* la; const float *b_a, *b_i, *lam;
    __device__ __forceinline__ void operator()(AccRef acc, const Unit& u, int wr, int wc, int fr, int fq) const {
#pragma unroll
        for (int n = 0; n < 2; ++n) {
            const int ch0 = u.pn * 128 + wc * 32 + 8 * fq + 4 * n;
            const f32x4 ba = *(const f32x4*)(b_a + ch0), bi = *(const f32x4*)(b_i + ch0), lm = *(const f32x4*)(lam + ch0);
            f32x4 sp;
#pragma unroll
            for (int e = 0; e < 4; ++e) sp[e] = -8.f * log1pf(__expf(-lm[e]));
            EPI_ROWS_BEGIN
                bf16_t* xp = y3 + (size_t)row * 2048 + ch0;
                const u32x2 xw = *(const u32x2*)xp;
                const f32x4 xc = (f32x4){bflo(xw.x), bfhi(xw.x), bflo(xw.y), bfhi(xw.y)};
                f32x4 uo, lo;
#pragma unroll
                for (int e = 0; e < 4; ++e) {
                    const float rr = acc[ai][0][m][n][e] + ba[e], ii = acc[ai][1][m][n][e] + bi[e];
                    const float log_a = sp[e] * sigmoidf_(rr);
                    const float mult = sqrtf(one_minus_exp(2.f * log_a));
                    uo[e] = xc[e] * sigmoidf_(ii) * mult; lo[e] = log_a;
                }
                u32x2 w0, w1; w0.x = cvt_pk_bf16(uo[0], uo[1]); w0.y = cvt_pk_bf16(uo[2], uo[3]); w1.x = cvt_pk_bf16(lo[0], lo[1]); w1.y = cvt_pk_bf16(lo[2], lo[3]);
                *(u32x2*)xp = w0;
                *(u32x2*)(la + (size_t)row * 512 + ch0) = w1;
                asm volatile("" ::: "memory");
            EPI_ROWS_END
        }
    }
};
struct EpiGate {
    const LAS unsigned char* lds_rs; const bf16_t* tall; bf16_t* mb; const float* rsc;
    __device__ __forceinline__ void operator()(AccRef acc, const Unit& u, int wr, int wc, int fr, int fq) const {
        const int n = u.pn >> 2; const bf16_t* tn = tall + (size_t)n * 64 * MiB / 2; const float* trs = (n == 2) ? rsc : nullptr;
        const int col0 = (u.pn & 3) * 256 + wc * 32 + 8 * fq;
        u32x4 tq[2][4][2];
#pragma unroll
        for (int ai = 0; ai < 2; ++ai)
#pragma unroll
            for (int m = 0; m < 4; ++m)
#pragma unroll
                for (int bj = 0; bj < 2; ++bj) tq[ai][m][bj] = *(const u32x4*)(tn + (size_t)(u.pm * 256 + ai * 128 + wr * 64 + m * 16 + fr) * 1024 + col0 + bj * 128);
        EPI_ROWS_BEGIN
            const float r = RSL(u, row); const float ts = trs ? trs[row] : 1.f;
#pragma unroll
            for (int bj = 0; bj < 2; ++bj) {
                const size_t off = (size_t)row * 1024 + col0 + bj * 128;
                f32x4 t0, t1; unpack8(tq[ai][m][bj], t0, t1); t0 = t0 * ts; t1 = t1 * ts;
                f32x4 g0 = acc[ai][bj][m][0] * r, g1 = acc[ai][bj][m][1] * r;
#pragma unroll
                for (int e = 0; e < 4; ++e) { g0[e] = sigmoidf_(g0[e]) * t0[e]; g1[e] = sigmoidf_(g1[e]) * t1[e]; }
                if (n > 0) { f32x4 p0, p1; unpack8(*(const u32x4*)(mb + off), p0, p1); g0 += p0; g1 += p1; }
                *(u32x4*)(mb + off) = pack8(g0, g1);
            }
        EPI_ROWS_END
    }
};
struct EpiMerge {
    const LAS unsigned char* lds_rs; bf16_t* tall; bf16_t* mb;
    __device__ __forceinline__ void operator()(AccRef acc, const MUnit& u, int wr, int wc, int fr, int fq) const {
        const int n = u.n; bf16_t* tn = tall;
        const int col0 = u.pn * 256 + wc * 32 + 8 * fq;
        if (u.kind == 0) {
            EPI_ROWS_BEGIN
#pragma unroll
                for (int bj = 0; bj < 2; ++bj) *(u32x4*)(tn + (size_t)row * 1024 + col0 + bj * 128) = pack8(acc[ai][bj][m][0], acc[ai][bj][m][1]);
            EPI_ROWS_END
        } else {
            const LAS float* rsl = (const LAS float*)(lds_rs + RSL_OFF) + (u.ui >> 3) * 256;
            u32x4 tq[2][4][2];
#pragma unroll
            for (int ai = 0; ai < 2; ++ai)
#pragma unroll
                for (int m = 0; m < 4; ++m)
#pragma unroll
                    for (int bj = 0; bj < 2; ++bj) tq[ai][m][bj] = *(const u32x4*)(tn + (size_t)(u.pm * 256 + ai * 128 + wr * 64 + m * 16 + fr) * 1024 + col0 + bj * 128);
            EPI_ROWS_BEGIN
                const float r = rsl[row & 255]; const float ts = (n == 2) ? rsl[1024 + (row & 255)] : 1.f;
#pragma unroll
                for (int bj = 0; bj < 2; ++bj) {
                    const size_t off = (size_t)row * 1024 + col0 + bj * 128;
                    f32x4 t0, t1; unpack8(tq[ai][m][bj], t0, t1); t0 = t0 * ts; t1 = t1 * ts;
                    f32x4 g0 = acc[ai][bj][m][0] * r, g1 = acc[ai][bj][m][1] * r;
#pragma unroll
                    for (int e = 0; e < 4; ++e) { g0[e] = sigmoidf_(g0[e]) * t0[e]; g1[e] = sigmoidf_(g1[e]) * t1[e]; }
                    if (n > 0) { f32x4 p0, p1; unpack8(*(const u32x4*)(mb + off), p0, p1); g0 += p0; g1 += p1; }
                    *(u32x4*)(mb + off) = pack8(g0, g1);
                }
            EPI_ROWS_END
        }
    }
};
__device__ __forceinline__ void merge_prepass(LAS unsigned char* lds, const float* ssq, const float* ssqc, const MergeOrder& S, int tid_) {
    asm volatile("" : "+v"(tid_));
    LAS float* rsl = (LAS float*)(lds + RSL_OFF); Unit t;
    const int ti = tid_ >> 8, rr = tid_ & 255;
    if (S.base.next(ti, t)) { const int row = t.pm * 256 + rr; rsl[ti * 256 + rr] = rstd16(ssq, row);
        const f32x4* p = (const f32x4*)(ssqc + (size_t)row * 16); const f32x4 a = p[0], b = p[1], c = p[2], d = p[3]; const f32x4 q = (a + b) + (c + d);
        rsl[1024 + ti * 256 + rr] = rsqrtf(((q[0] + q[1]) + (q[2] + q[3])) * (1.f / 512.f) + EPS); }
    __syncthreads();
}
template <int MODE  > struct EpiRes {
    const float* xold; float* xf; bf16_t* xb; float* ssq_out; const LAS unsigned char* lds_rs; const bf16_t* tp;
    __device__ __forceinline__ void operator()(AccRef acc, const Unit& u, int wr, int wc, int fr, int fq) const {
        const int col0 = u.pn * 256 + wc * 32 + 8 * fq;
        EPI_ROWS_BEGIN
            float r = 1.f; if (MODE == 1) r = RSL(u, row);
            float ss = 0.f;
#pragma unroll
            for (int bj = 0; bj < 2; ++bj) {
                const size_t off = (size_t)row * 1024 + col0 + bj * 128;
                f32x4 a0 = acc[ai][bj][m][0], a1 = acc[ai][bj][m][1];
                if (MODE == 1) { f32x4 t0, t1; unpack8(*(const u32x4*)(tp + off), t0, t1);
#pragma unroll
                    for (int e = 0; e < 4; ++e) { a0[e] = sigmoidf_(a0[e] * r) * t0[e]; a1[e] = sigmoidf_(a1[e] * r) * t1[e]; } }
                const f32x4 n0 = *(const f32x4*)(xold + off) + a0, n1 = *(const f32x4*)(xold + off + 4) + a1;
                *(f32x4*)(xf + off) = n0; *(f32x4*)(xf + off + 4) = n1;
                if (MODE == 0) *(u32x4*)(xb + off) = pack8(n0, n1);
                ss += (n0[0] * n0[0] + n0[1] * n0[1]) + (n0[2] * n0[2] + n0[3] * n0[3]) + (n1[0] * n1[0] + n1[1] * n1[1]) + (n1[2] * n1[2] + n1[3] * n1[3]);
            }
            ss += __shfl_xor(ss, 16); ss += __shfl_xor(ss, 32);
            if (fq == 0) ssq_out[(size_t)row * 16 + u.pn * 4 + wc] = ss;
        EPI_ROWS_END
    }
};
struct EpiFF1 {
    bf16_t* h; const LAS unsigned char* lds_rs;
    __device__ __forceinline__ void operator()(AccRef acc, const Unit& u, int wr, int wc, int fr, int fq) const {
        const int col0 = u.pn * 256 + wc * 32 + 8 * fq;
        EPI_ROWS_BEGIN
            const float r = RSL(u, row);
#pragma unroll
            for (int bj = 0; bj < 2; ++bj) {
                f32x4 a0 = acc[ai][bj][m][0] * r, a1 = acc[ai][bj][m][1] * r;
#pragma unroll
                for (int e = 0; e < 4; ++e) { const float p = fmaxf(a0[e], 0.f), q = fmaxf(a1[e], 0.f); a0[e] = p * p; a1[e] = q * q; }
                *(u32x4*)(h + (size_t)row * 4096 + col0 + bj * 128) = pack8(a0, a1);
            }
        EPI_ROWS_END
    }
};
}

__device__ __forceinline__ void conv_weights(PP P, int l, bf16_t* W, int tid_, int bid_, int ngt, LAS unsigned char* lds) {
    asm volatile("" : "+v"(tid_)); const int gt = bid_ * 512 + tid_;
    if (l == 0 && gt < 64) ((unsigned*)P->ws)[64 + gt] = 0u;
    const float* g_mix = P->in[3] + l * 1024; const float* w_in = P->in[4] + (size_t)l * 1024 * INC;
    const float* q_norm = P->in[5] + l * 384; const float* w_uq = P->in[6] + (size_t)l * 384 * 768;
    const float* kv_norm = P->in[7] + l * 256; const float* w_ukv = P->in[8] + (size_t)l * 256 * 1024;
    const float* w_pool = P->in[9] + (size_t)l * 4 * 128 * 128; const float* pool_scale = P->in[10] + l * 512;
    const float* ssd_norm = P->in[16] + l * 512;
    const float* w_a = P->in[19] + (size_t)l * 8 * 64 * 64; const float* w_i = P->in[21] + (size_t)l * 8 * 64 * 64;
    const float* w_branch = P->in[24] + (size_t)l * 4 * 512 * 1024; const float* w_out = P->in[25] + (size_t)l * 1024 * 1024;
    const float* g_mlp = P->in[26] + l * 1024; const float* w_ff1 = P->in[27] + (size_t)l * 1024 * 4096; const float* w_ff2 = P->in[28] + (size_t)l * 4096 * 1024;
    const float* g_ple = P->in[29] + l * 1024; const float* w_pg = P->in[30] + (size_t)l * 1024 * 1024; const float* w_ple = P->in[31] + (size_t)l * 256 * 1024;
    constexpr int TOTAL_ITEMS = (int)(W_TOTAL / 2048);
    const int wave_ = tid_ >> 6, lane = tid_ & 63;
    LAS float* scr = (LAS float*)(lds + wave_ * 8448);
    for (int item = bid_ * 8 + wave_; item < TOTAL_ITEMS; item += ngt / 64) {
        const long e = (long)item * 2048;
        int N, K; size_t base; int mat;
        if (e < (long)W_G) { mat = 0; base = W_IN; N = 3584; K = 1024; }
        else if (e < (long)W_UQ) { mat = 1; base = W_G; N = 4096; K = 1024; }
        else if (e < (long)W_UKV) { mat = 2; base = W_UQ; N = 768; K = 384; }
        else if (e < (long)W_POOL) { mat = 3; base = W_UKV; N = 1024; K = 256; }
        else if (e < (long)W_LRU) { mat = 4; base = W_POOL; N = 512; K = 256; }
        else if (e < (long)W_BR) { mat = 5; base = W_LRU; N = 1024; K = 128; }
        else if (e < (long)W_OUT) { mat = 6; base = W_BR; N = 4096; K = 512; }
        else if (e < (long)W_FF1) { mat = 7; base = W_OUT; N = 1024; K = 1024; }
        else if (e < (long)W_FF2) { mat = 8; base = W_FF1; N = 4096; K = 1024; }
        else if (e < (long)W_PG) { mat = 9; base = W_FF2; N = 1024; K = 4096; }
        else if (e < (long)W_PLE) { mat = 10; base = W_PG; N = 1024; K = 1024; }
        else { mat = 11; base = W_PLE; N = 1024; K = 256; }
        const int idx = item - (int)(base / 2048), nblk = N / 32, n0 = (idx % nblk) * 32, k0 = (idx / nblk) * 64;
        const int n = n0 + (lane & 31);
        const float* ptr = nullptr; int stride = 0; const float* gk = nullptr; float sn = 1.f; bool valid = true;
        switch (mat) {
        case 0: { int sc;
            if (n < 512) sc = 1184 + n; else if (n < 1024) sc = 2472 + (n - 512);
            else if (n < 1408) sc = n - 1024; else if (n < 1664) sc = 384 + (n - 1408); else if (n < 1696) sc = 640 + (n - 1664);
            else if (n < 1704) sc = 2464 + (n - 1696); else if (n < 1792) { sc = 0; valid = false; }
            else { const int q = n - 1792; if (q < 512) sc = 672 + q; else if (q < 1280) sc = 1696 + (q - 512); else sc = 2984 + (q - 1280); }
            ptr = w_in + (size_t)k0 * INC + sc; stride = INC; gk = g_mix + k0; } break;
        case 1: ptr = w_in + (size_t)k0 * INC + 3496 + n; stride = INC; gk = g_mix + k0; break;
        case 2: { int sc; if (n < 512) sc = (n >> 6) * 96 + (n & 63); else { const int q = n - 512, hd = q >> 5, jj = q & 31; sc = hd * 96 + 64 + (jj & 1) * 16 + (jj >> 1); }
            ptr = w_uq + (size_t)k0 * 768 + sc; stride = 768; gk = q_norm + k0; } break;
        case 3: { int sc; if (n < 512) sc = (n >> 6) * 128 + (n & 63); else { const int q = n - 512; sc = (q >> 6) * 128 + 64 + (q & 63); }
            ptr = w_ukv + (size_t)k0 * 1024 + sc; stride = 1024; gk = kv_norm + k0; } break;
        case 4: { const int g = n >> 7, j = n & 127, pn = n >> 8, gk_ = 2 * pn + (k0 >> 7), i0 = k0 & 127; valid = (gk_ == g);
            ptr = w_pool + (size_t)g * 16384 + i0 * 128 + j; stride = 128; sn = pool_scale[n]; } break;
        case 5: { const int pn = n >> 8, bj = (n & 255) >> 7, ch = 128 * pn + (n & 127), hb = ch >> 6, j = ch & 63, hbk = 2 * pn + (k0 >> 6), i0 = k0 & 63; valid = (hbk == hb);
            ptr = (bj ? w_i : w_a) + (size_t)hb * 4096 + i0 * 64 + j; stride = 64; } break;
        case 6: { const int br = n >> 10, nn = n & 1023; ptr = w_branch + (size_t)br * 512 * 1024 + (size_t)k0 * 1024 + nn; stride = 1024; if (br == 2) gk = ssd_norm + k0; } break;
        case 7: ptr = w_out + (size_t)k0 * 1024 + n; stride = 1024; break;
        case 8: ptr = w_ff1 + (size_t)k0 * 4096 + n; stride = 4096; gk = g_mlp + k0; break;
        case 9: ptr = w_ff2 + (size_t)k0 * 1024 + n; stride = 1024; break;
        case 10: ptr = w_pg + (size_t)k0 * 1024 + n; stride = 1024; gk = g_ple + k0; break;
        default: ptr = w_ple + (size_t)k0 * 1024 + n; stride = 1024; break;
        }
        const int kh = lane >> 5;
#pragma unroll 8
        for (int i = 0; i < 32; ++i) { const int kk = 2 * i + kh; float x = 0.f; if (valid) { x = ptr[(size_t)kk * stride] * sn; if (gk) x *= gk[kk]; } scr[kk * 33 + (lane & 31)] = x; }
        asm volatile("s_waitcnt lgkmcnt(0)" ::: "memory");
        const int c = lane & 7;
#pragma unroll
        for (int jj = 0; jj < 4; ++jj) { const int nn = (lane >> 3) + 8 * jj; const LAS float* sp_ = scr + (8 * c) * 33 + nn;
            u32x4 o; o.x = cvt_pk_bf16(sp_[0], sp_[33]); o.y = cvt_pk_bf16(sp_[66], sp_[99]); o.z = cvt_pk_bf16(sp_[132], sp_[165]); o.w = cvt_pk_bf16(sp_[198], sp_[231]);
            *(u32x4*)(W + base + (size_t)(n0 + nn) * K + k0 + 8 * c) = o; }
        asm volatile("s_waitcnt lgkmcnt(0)" ::: "memory");
    }
}

__device__ __forceinline__ void p0_rows(PP P, const float* x, bool first, bf16_t* XB, float* ssq, f32x2* CS, int gw, int ngw, int tid_) {
    asm volatile("" : "+v"(tid_)); const int lane = tid_ & 63;
    const int* pos = (const int*)P->in[2];
    for (int mb = gw; mb < M; mb += 4 * ngw) {
        f32x4 v[4][4];
#pragma unroll
        for (int u = 0; u < 4; ++u) { const f32x4* xr = (const f32x4*)(x + (size_t)(mb + u * ngw) * D) + lane;
#pragma unroll
            for (int j = 0; j < 4; ++j) v[u][j] = xr[64 * j]; }
#pragma unroll
        for (int u = 0; u < 4; ++u) { const int m = mb + u * ngw; u32x2* o = (u32x2*)(XB + (size_t)m * D) + lane; float s = 0.f;
#pragma unroll
            for (int j = 0; j < 4; ++j) { const f32x4 t = v[u][j]; s += (t[0] * t[0] + t[1] * t[1]) + (t[2] * t[2] + t[3] * t[3]); u32x2 w; w.x = cvt_pk_bf16(t[0], t[1]); w.y = cvt_pk_bf16(t[2], t[3]); o[64 * j] = w; }
            if (first) {
                s = wave_sum(s);
                if (lane < 16) {
                    ssq[(size_t)m * 16 + lane] = (lane == 0) ? s : 0.f;
                    const double ang = (double)pos[m] * P->inv_freq[lane];
                    const double k = rint(ang * 0.15915494309189535);
                    const float r = (float)(ang - k * 6.283185307179586);
                    f32x2 cs_; cs_[0] = cosf(r); cs_[1] = sinf(r);
                    CS[(size_t)m * 16 + lane] = cs_;
                }
            }
        }
    }
}

__device__ __forceinline__ void p2_pool_block(const bf16_t* UB, bf16_t* Y, int m0, int lane) {
    const int g = lane >> 4, w = 2 << g, t0 = m0 & (SEQ - 1);
    const bf16_t* base = UB + (size_t)m0 * 1792 + lane * 8;
    bf16_t* ob = Y + (size_t)m0 * 2048 + 512 + lane * 8;
    u32x4 prev[16];
#pragma unroll
    for (int j = 0; j < 16; ++j) { prev[j] = (u32x4){0u, 0u, 0u, 0u}; if (t0 > 0) prev[j] = *(const u32x4*)(base - (size_t)(16 - j) * 1792); }
    f32x4 s0 = {0.f, 0.f, 0.f, 0.f}, s1 = {0.f, 0.f, 0.f, 0.f};
#pragma unroll
    for (int j = 0; j < 16; ++j) { f32x4 a, b; unpack8(prev[j], a, b); const float mk = (16 - j <= w) ? 1.f : 0.f; s0 += a * mk; s1 += b * mk; }
    for (int bt = 0; bt < 4; ++bt) {
        u32x4 cur[16];
#pragma unroll
        for (int j = 0; j < 16; ++j) cur[j] = *(const u32x4*)(base + (size_t)(bt * 16 + j) * 1792);
#pragma unroll
        for (int j = 0; j < 16; ++j) {
            const u32x4 o2 = (j >= 2) ? cur[j >= 2 ? j - 2 : 0] : prev[14 + j < 16 ? 14 + j : 15];
            const u32x4 o4 = (j >= 4) ? cur[j >= 4 ? j - 4 : 0] : prev[12 + j < 16 ? 12 + j : 15];
            const u32x4 o8 = (j >= 8) ? cur[j >= 8 ? j - 8 : 0] : prev[8 + j < 16 ? 8 + j : 15];
            const u32x4 o16 = prev[j];
            u32x4 os;
            os.x = g == 0 ? o2.x : g == 1 ? o4.x : g == 2 ? o8.x : o16.x; os.y = g == 0 ? o2.y : g == 1 ? o4.y : g == 2 ? o8.y : o16.y;
            os.z = g == 0 ? o2.z : g == 1 ? o4.z : g == 2 ? o8.z : o16.z; os.w = g == 0 ? o2.w : g == 1 ? o4.w : g == 2 ? o8.w : o16.w;
            f32x4 c0, c1, q0, q1; unpack8(cur[j], c0, c1); unpack8(os, q0, q1);
            s0 += c0 - q0; s1 += c1 - q1;
            const int t = t0 + bt * 16 + j; const int cnt = (t + 1) < w ? (t + 1) : w; const float inv = __builtin_amdgcn_rcpf((float)cnt);
            *(u32x4*)(ob + (size_t)(bt * 16 + j) * 2048) = pack8(s0 * inv - c0, s1 * inv - c1);
        }
#pragma unroll
        for (int j = 0; j < 16; ++j) prev[j] = cur[j];
    }
}
__device__ __forceinline__ void p2_conv_block(const bf16_t* src, int m0, bool active, const float* wgt, int wp, const float* bias, bool silu, bf16_t* out, int opitch) {
    if (!active) return;
    const int t0 = m0 & (SEQ - 1);
    const bf16_t* base = src + (size_t)m0 * 1792; bf16_t* ob = out + (size_t)m0 * opitch;
    f32x4 w0[4], w1[4];
#pragma unroll
    for (int k = 0; k < 4; ++k) { w0[k] = *(const f32x4*)(wgt + k * wp); w1[k] = *(const f32x4*)(wgt + k * wp + 4); }
    const f32x4 b0 = *(const f32x4*)bias, b1 = *(const f32x4*)(bias + 4);
    u32x4 p3[3];
#pragma unroll
    for (int j = 0; j < 3; ++j) { p3[j] = (u32x4){0u, 0u, 0u, 0u}; if (t0 > 0) p3[j] = *(const u32x4*)(base - (size_t)(3 - j) * 1792); }
    for (int bt = 0; bt < 4; ++bt) {
        u32x4 cur[16];
#pragma unroll
        for (int j = 0; j < 16; ++j) cur[j] = *(const u32x4*)(base + (size_t)(bt * 16 + j) * 1792);
#pragma unroll
        for (int j = 0; j < 16; ++j) {
            f32x4 a0 = b0, a1 = b1;
#pragma unroll
            for (int k = 0; k < 4; ++k) { const int jj = j - 3 + k; const u32x4 rw = (jj >= 0) ? cur[jj >= 0 ? jj : 0] : p3[jj < 0 ? 3 + jj : 0];
                f32x4 x0, x1; unpack8(rw, x0, x1); a0 += x0 * w0[k]; a1 += x1 * w1[k]; }
            if (silu) {
#pragma unroll
                for (int e = 0; e < 4; ++e) { a0[e] = a0[e] * sigmoidf_(a0[e]); a1[e] = a1[e] * sigmoidf_(a1[e]); } }
            *(u32x4*)(ob + (size_t)(bt * 16 + j) * opitch) = pack8(a0, a1);
        }
        p3[0] = cur[13]; p3[1] = cur[14]; p3[2] = cur[15];
    }
}
__device__ __forceinline__ void p2_prep(PP P, int l, unsigned char* ws, int gw, int ngw, int tid_) {
    asm volatile("" : "+v"(tid_)); const int lane = tid_ & 63;
    const bf16_t* UA = (const bf16_t*)(ws + B_UA); const bf16_t* UB = (const bf16_t*)(ws + B_UB);
    bf16_t* Y = (bf16_t*)(ws + WS_Y); bf16_t* BC = (bf16_t*)(ws + B_BC); bf16_t* KR = (bf16_t*)(ws + B_KR);
    float* RSQ = (float*)(ws + WS_RSQ); float* RSKV = (float*)(ws + WS_RSKV); float* DTF = (float*)(ws + WS_DTF); const f32x2* CS = (const f32x2*)(ws + WS_CS);
    const float* scw = P->in[11] + l * 4 * 768; const float* scb = P->in[12] + l * 768; const float* dtb = P->in[13] + l * 8;
    const float* lcw = P->in[17] + l * 4 * 512; const float* lcb = P->in[18] + l * 512;
    for (int mb = gw; mb < M; mb += 4 * ngw) {
        u32x4 q4[4], k4[4]; float x1[4], x2[4], dtr[4]; f32x2 cc[4];
#pragma unroll
        for (int u = 0; u < 4; ++u) { const int m = M - 1 - (mb + u * ngw); const bf16_t* ua = UA + (size_t)m * 768;
            q4[u] = (u32x4){0u, 0u, 0u, 0u}; k4[u] = (u32x4){0u, 0u, 0u, 0u}; x1[u] = 0.f; x2[u] = 0.f; dtr[u] = 0.f; cc[u] = (f32x2){0.f, 0.f};
            if (lane < 48) q4[u] = *(const u32x4*)(ua + lane * 8);
            if (lane < 32) k4[u] = *(const u32x4*)(ua + 384 + lane * 8);
            if (lane < 16) { x1[u] = bf2f(ua[640 + lane]); x2[u] = bf2f(ua[656 + lane]); cc[u] = CS[(size_t)m * 16 + lane]; }
            if (lane < 8) dtr[u] = bf2f(ua[672 + lane]); }
#pragma unroll
        for (int u = 0; u < 4; ++u) { const int m = M - 1 - (mb + u * ngw);
            f32x4 a, b; unpack8(q4[u], a, b); float s = (a[0]*a[0]+a[1]*a[1])+(a[2]*a[2]+a[3]*a[3])+(b[0]*b[0]+b[1]*b[1])+(b[2]*b[2]+b[3]*b[3]);
            unpack8(k4[u], a, b); float s2 = (a[0]*a[0]+a[1]*a[1])+(a[2]*a[2]+a[3]*a[3])+(b[0]*b[0]+b[1]*b[1])+(b[2]*b[2]+b[3]*b[3]);
            s = wave_sum(s); s2 = wave_sum(s2);
            if (lane == 0) { RSQ[m] = rsqrtf(s * (1.f / 384.f) + EPS); RSKV[m] = rsqrtf(s2 * (1.f / 256.f) + EPS); }
            if (lane < 16) *(unsigned*)(KR + (size_t)m * 32 + 2 * lane) = cvt_pk_bf16(x1[u] * cc[u][0] - x2[u] * cc[u][1], x2[u] * cc[u][0] + x1[u] * cc[u][1]);
            if (lane < 8) { const float v = dtr[u] + dtb[lane]; DTF[(size_t)m * 8 + lane] = v > 20.f ? v : log1pf(__expf(v)); } }
    }
    for (int wt = gw; wt < 2048; wt += ngw) {
        const int rb = 511 - (wt >> 2), cgp = wt & 3, m0 = rb * 64;
        if (cgp == 0) p2_pool_block(UB, Y, m0, lane);
        else if (cgp == 1) p2_conv_block(UB + 512 + 8 * lane, m0, true, scw + 8 * lane, 768, scb + 8 * lane, true, Y + 1024 + 8 * lane, 2048);
        else if (cgp == 2) p2_conv_block(UB + 1024 + 8 * (lane & 31), m0, lane < 32, scw + 512 + 8 * (lane & 31), 768, scb + 512 + 8 * (lane & 31), true, BC + 8 * (lane & 31), 256);
        else p2_conv_block(UB + 1280 + 8 * lane, m0, true, lcw + 8 * lane, 512, lcb + 8 * lane, false, Y + 1536 + 8 * lane, 2048);
    }
}

__device__ __forceinline__ void rstd_c_rows(unsigned char* ws, int gw, int ngw, int tid_) {
    asm volatile("" : "+v"(tid_)); const int lane = tid_ & 63;
    const bf16_t* Y = (const bf16_t*)(ws + WS_Y); float* RSC = (float*)(ws + WS_RSC);
    for (int m = gw; m < M; m += ngw) { f32x4 a, b; unpack8(*(const u32x4*)(Y + (size_t)m * 2048 + 1024 + lane * 8), a, b);
        float s = (a[0]*a[0]+a[1]*a[1])+(a[2]*a[2]+a[3]*a[3])+(b[0]*b[0]+b[1]*b[1])+(b[2]*b[2]+b[3]*b[3]); s = wave_sum(s);
        if (lane == 0) RSC[m] = rsqrtf(s * (1.f / 512.f) + EPS); }
}
__device__ __forceinline__ void conv_p(PP P, int l, bf16_t* PB, int tid_, int bid_, int ngt) {
    asm volatile("" : "+v"(tid_)); const int gt = bid_ * 512 + tid_;
    const f32x4* src = (const f32x4*)(P->in[1] + (size_t)l * M * 256);
    for (long c = gt; c < (long)M * 256 / 8; c += ngt) { const f32x4 a = src[2 * c], b = src[2 * c + 1]; *(u32x4*)(PB + c * 8) = pack8(a, b); }
}
__device__ __forceinline__ void final_norm(PP P, const float* ssq, int gw, int ngw, int tid_) {
    asm volatile("" : "+v"(tid_)); const int lane = tid_ & 63;
    const f32x4* gf = (const f32x4*)P->in[32];
    f32x4 g4[4];
#pragma unroll
    for (int j = 0; j < 4; ++j) g4[j] = gf[64 * j + lane];
    for (int mb = gw; mb < M; mb += 4 * ngw) {
        f32x4 v[4][4]; float r[4];
#pragma unroll
        for (int u = 0; u < 4; ++u) { const int m = mb + u * ngw; r[u] = 0.f;
            if (m < M) { const f32x4* xr = (const f32x4*)(P->out + (size_t)m * D) + lane; r[u] = rstd16(ssq, m);
#pragma unroll
                for (int j = 0; j < 4; ++j) v[u][j] = xr[64 * j]; } }
#pragma unroll
        for (int u = 0; u < 4; ++u) { const int m = mb + u * ngw;
            if (m < M) { f32x4* xr = (f32x4*)(P->out + (size_t)m * D) + lane;
#pragma unroll
                for (int j = 0; j < 4; ++j) xr[64 * j] = v[u][j] * r[u] * g4[j]; } }
    }
}


typedef float f32x16 __attribute__((ext_vector_type(16)));
__device__ __forceinline__ unsigned pk2c(float lo, float hi) { f32x2 v = {lo, hi}; bf16x2_t b = __builtin_convertvector(v, bf16x2_t); return __builtin_bit_cast(unsigned, b); }
constexpr int AT_KP = 208, AT_VP = 192, AT_KB = 64 * AT_KP, AT_VB = 64 * AT_VP, AT_BUF = AT_KB + AT_VB;
typedef short v4i16_t __attribute__((ext_vector_type(4)));
__device__ __forceinline__ void attn_unit(unsigned char* ws, LAS unsigned char* lds, int b, int h, int qb, int wave, int tid_, bf16_t* Obase, int opitch) {
    asm volatile("" : "+v"(tid_));
    const int lane = tid_ & 63, r = lane & 31, hh = lane >> 5;
    bf16_t* Y = (bf16_t*)(ws + WS_Y); const bf16_t* QR = (const bf16_t*)(ws + B_QR); const bf16_t* KV = (const bf16_t*)(ws + B_KV); const bf16_t* KR = (const bf16_t*)(ws + B_KR);
    const int q0 = qb * 256, qw0 = q0 + wave * 32;
    const size_t mrow = (size_t)b * SEQ + qw0 + r;
    bf16x8 qf[6];
#pragma unroll
    for (int ks = 0; ks < 4; ++ks) qf[ks] = *(const bf16x8*)(Y + mrow * 2048 + h * 64 + 16 * ks + 8 * hh);
#pragma unroll
    for (int ks = 0; ks < 2; ++ks) qf[4 + ks] = *(const bf16x8*)(QR + mrow * 256 + h * 32 + 16 * ks + 8 * hh);
    f32x16 o0, o1;
#pragma unroll
    for (int i = 0; i < 16; ++i) { o0[i] = 0.f; o1[i] = 0.f; }
    float mx = -1e30f, lsum = 0.f;
    const int nkt = (q0 + 256) / 64;
    const int skv = tid_ >> 3, sc = tid_ & 7;
    const int rkv = tid_ >> 2, rc = tid_ & 3;
    const bf16_t* gk = KV + ((size_t)b * SEQ + skv) * 1024 + h * 64 + sc * 8;
    const bf16_t* gv = gk + 512;
    const bf16_t* gr = KR + ((size_t)b * SEQ + rkv) * 32 + rc * 8;
    u32x4 rk, rv, rr;
    rk = *(const u32x4*)gk; rv = *(const u32x4*)gv; if (tid_ < 256) rr = *(const u32x4*)gr;
    __syncthreads();
    {
        LAS unsigned char* kb = lds; LAS unsigned char* vb = lds + AT_KB;
        *(LAS u32x4*)(kb + skv * AT_KP + sc * 16) = rk;
        if (tid_ < 256) *(LAS u32x4*)(kb + rkv * AT_KP + 128 + rc * 16) = rr;
        *(LAS u32x4*)(vb + skv * AT_VP + sc * 16) = rv;
    }
    __syncthreads();
    for (int kt = 0; kt < nkt; ++kt) {
        const bool more = (kt + 1 < nkt);
        if (more) { const size_t adv = (size_t)(kt + 1) * 64;
            rk = *(const u32x4*)(gk + adv * 1024); rv = *(const u32x4*)(gv + adv * 1024); if (tid_ < 256) rr = *(const u32x4*)(gr + adv * 32); }
        LAS unsigned char* kb = lds + (kt & 1) * AT_BUF; LAS unsigned char* vb = kb + AT_KB;
        const int kv0 = kt * 64;
        if (kv0 <= qw0 + 31) {
            __builtin_amdgcn_iglp_opt(0);
            f32x16 p0, p1;
#pragma unroll
            for (int i = 0; i < 16; ++i) { p0[i] = 0.f; p1[i] = 0.f; }
            bf16x8 kf0[6], kf1[6];
#pragma unroll
            for (int ks = 0; ks < 6; ++ks) {
                kf0[ks] = *(const LAS bf16x8*)(kb + r * AT_KP + (16 * ks + 8 * hh) * 2);
                kf1[ks] = *(const LAS bf16x8*)(kb + (32 + r) * AT_KP + (16 * ks + 8 * hh) * 2);
            }
#pragma unroll
            for (int ks = 0; ks < 6; ++ks) {
                p0 = __builtin_amdgcn_mfma_f32_32x32x16_bf16(kf0[ks], qf[ks], p0, 0, 0, 0);
                p1 = __builtin_amdgcn_mfma_f32_32x32x16_bf16(kf1[ks], qf[ks], p1, 0, 0, 0);
            }
            if (kv0 + 63 > qw0) {
                const int qg = qw0 + r;
#pragma unroll
                for (int i = 0; i < 16; ++i) { const int kvl = kv0 + (i & 3) + 8 * (i >> 2) + 4 * hh; if (kvl > qg) p0[i] = -1e30f; if (kvl + 32 > qg) p1[i] = -1e30f; }
            }
            float tm = fmaxf(p0[0], p1[0]);
#pragma unroll
            for (int i = 1; i < 16; ++i) tm = fmaxf(tm, fmaxf(p0[i], p1[i]));
            tm = fmaxf(tm, __shfl_xor(tm, 32));
            if (__any(tm > mx + 8.f)) {
                const float mn = fmaxf(mx, tm);
                const float alpha = __builtin_amdgcn_exp2f(mx - mn);
                mx = mn; lsum *= alpha;
#pragma unroll
                for (int i = 0; i < 16; ++i) { o0[i] *= alpha; o1[i] *= alpha; }
            }
            float ps = 0.f;
#pragma unroll
            for (int i = 0; i < 16; ++i) { p0[i] = __builtin_amdgcn_exp2f(p0[i] - mx); p1[i] = __builtin_amdgcn_exp2f(p1[i] - mx); ps += p0[i] + p1[i]; }
            lsum += ps;
            u32x4 vw0[4], vw1[4];
            {
                const int li = lane & 15, tq = li >> 2, tp = li & 3, dblk = (lane >> 4) & 1;
                const LAS unsigned char* vbase = vb + (4 * hh + tq) * AT_VP + (16 * dblk + 4 * tp) * 2;
#pragma unroll
                for (int f = 0; f < 4; ++f) {
                    const v4i16_t lo0 = __builtin_amdgcn_ds_read_tr16_b64_v4i16((LAS v4i16_t*)(vbase + (16 * f) * AT_VP));
                    const v4i16_t hi0 = __builtin_amdgcn_ds_read_tr16_b64_v4i16((LAS v4i16_t*)(vbase + (16 * f + 8) * AT_VP));
                    const v4i16_t lo1 = __builtin_amdgcn_ds_read_tr16_b64_v4i16((LAS v4i16_t*)(vbase + (16 * f) * AT_VP + 64));
                    const v4i16_t hi1 = __builtin_amdgcn_ds_read_tr16_b64_v4i16((LAS v4i16_t*)(vbase + (16 * f + 8) * AT_VP + 64));
                    const u32x2 a = __builtin_bit_cast(u32x2, lo0), b2 = __builtin_bit_cast(u32x2, hi0), c = __builtin_bit_cast(u32x2, lo1), d2 = __builtin_bit_cast(u32x2, hi1);
                    vw0[f].x = a.x; vw0[f].y = a.y; vw0[f].z = b2.x; vw0[f].w = b2.y; vw1[f].x = c.x; vw1[f].y = c.y; vw1[f].z = d2.x; vw1[f].w = d2.y;
                }
            }
            u32x4 pw[4];
#pragma unroll
            for (int s2 = 0; s2 < 2; ++s2) {
                pw[s2].x = pk2c(p0[8 * s2 + 0], p0[8 * s2 + 1]); pw[s2].y = pk2c(p0[8 * s2 + 2], p0[8 * s2 + 3]); pw[s2].z = pk2c(p0[8 * s2 + 4], p0[8 * s2 + 5]); pw[s2].w = pk2c(p0[8 * s2 + 6], p0[8 * s2 + 7]);
                pw[2 + s2].x = pk2c(p1[8 * s2 + 0], p1[8 * s2 + 1]); pw[2 + s2].y = pk2c(p1[8 * s2 + 2], p1[8 * s2 + 3]); pw[2 + s2].z = pk2c(p1[8 * s2 + 4], p1[8 * s2 + 5]); pw[2 + s2].w = pk2c(p1[8 * s2 + 6], p1[8 * s2 + 7]); }
#pragma unroll
            for (int f = 0; f < 4; ++f) {
                const bf16x8 pf = __builtin_bit_cast(bf16x8, pw[f]);
                o0 = __builtin_amdgcn_mfma_f32_32x32x16_bf16(__builtin_bit_cast(bf16x8, vw0[f]), pf, o0, 0, 0, 0);
                o1 = __builtin_amdgcn_mfma_f32_32x32x16_bf16(__builtin_bit_cast(bf16x8, vw1[f]), pf, o1, 0, 0, 0);
            }
        }
        if (more) {
            LAS unsigned char* kb2 = lds + ((kt + 1) & 1) * AT_BUF; LAS unsigned char* vb2 = kb2 + AT_KB;
            *(LAS u32x4*)(kb2 + skv * AT_KP + sc * 16) = rk;
            if (tid_ < 256) *(LAS u32x4*)(kb2 + rkv * AT_KP + 128 + rc * 16) = rr;
            *(LAS u32x4*)(vb2 + skv * AT_VP + sc * 16) = rv;
        }
        __syncthreads();
    }
    lsum += __shfl_xor(lsum, 32);
    const float inv = 1.f / lsum;
    bf16_t* orow = Obase + mrow * opitch + h * 64;
#pragma unroll
    for (int g = 0; g < 4; ++g) {
        u32x2 w0, w1;
        w0.x = pk2c(o0[4 * g] * inv, o0[4 * g + 1] * inv); w0.y = pk2c(o0[4 * g + 2] * inv, o0[4 * g + 3] * inv);
        w1.x = pk2c(o1[4 * g] * inv, o1[4 * g + 1] * inv); w1.y = pk2c(o1[4 * g + 2] * inv, o1[4 * g + 3] * inv);
        *(u32x2*)(orow + 8 * g + 4 * hh) = w0;
        *(u32x2*)(orow + 32 + 8 * g + 4 * hh) = w1;
    }
}
__device__ __forceinline__ void attn_phase(unsigned char* ws, LAS unsigned char* lds, unsigned* ctr, int wave, int tid_, bf16_t* Obase, int opitch) {
    LAS unsigned* slot = (LAS unsigned*)(lds + 2 * AT_BUF + 64);
    for (;;) {
        if (tid_ == 0) *slot = atomicAdd(ctr, 1u);
        __syncthreads();
        const unsigned u = *slot;
        if (u >= 1024u) break;
        const int qb = 15 - (int)(u >> 6), bh = (int)(u & 63u);
        attn_unit(ws, lds, bh >> 3, bh & 7, qb, wave, tid_, Obase, opitch);
    }
}

constexpr int SD_CS = 0, SD_BS = 18432, SD_XT = 36864, SD_BDT = 62464, SD_MM = 79872, SD_F = 131072;
constexpr int SD_CP = 144, SD_XP = 400, SD_DP = 272, SD_MP = 400;
#define MFMA32(a, b, c) __builtin_amdgcn_mfma_f32_32x32x16_bf16((a), (b), (c), 0, 0, 0)
__device__ __forceinline__ void ssd_mfma(PP P, int l, unsigned char* ws, LAS unsigned char* lds, int unit, int wave, int tid_) {
    asm volatile("" : "+v"(tid_));
    const int lane = tid_ & 63, r = lane & 31, hh = lane >> 5;
    const int b = unit >> 3, h = unit & 7, g = h >> 2;
    bf16_t* Y = (bf16_t*)(ws + WS_Y); const bf16_t* BC = (const bf16_t*)(ws + B_BC); const bf16_t* U1 = (const bf16_t*)(ws + B_U1); const float* DTF = (const float*)(ws + WS_DTF);
    const float Ah = -__expf(P->in[14][l * 8 + h]); const float Dh = P->in[15][l * 8 + h];
    LAS float* F0 = (LAS float*)(lds + SD_F);
    for (int idx = tid_; idx < 64 * 32; idx += 512) { const int p = idx >> 5, c = idx & 31; *(LAS unsigned*)(lds + SD_XT + p * SD_XP + 256 + c * 4) = 0u; }
    f32x16 S;
#pragma unroll
    for (int i = 0; i < 16; ++i) S[i] = 0.f;
    const int l_ = tid_ >> 2, qd = tid_ & 3;
    const size_t mb0 = (size_t)b * SEQ;
    u32x4 c0, c1, b0, b1, x0, x1;
#define SSD_LOAD(ck_) do { const size_t m_ = mb0 + (size_t)(ck_) * 128 + l_; \
        c0 = *(const u32x4*)(BC + m_ * 256 + 128 + g * 64 + 16 * qd); c1 = *(const u32x4*)(BC + m_ * 256 + 128 + g * 64 + 16 * qd + 8); \
        b0 = *(const u32x4*)(BC + m_ * 256 + g * 64 + 16 * qd); b1 = *(const u32x4*)(BC + m_ * 256 + g * 64 + 16 * qd + 8); \
        x0 = *(const u32x4*)(Y + m_ * 2048 + 1024 + h * 64 + 16 * qd); x1 = *(const u32x4*)(Y + m_ * 2048 + 1024 + h * 64 + 16 * qd + 8); } while (0)
#define SSD_FCALC(ck_) do { LAS float* F_ = F0 + ((ck_) & 1) * 512; const size_t m_ = mb0 + (size_t)(ck_) * 128; \
        const float d0 = DTF[(m_ + lane) * 8 + h], d1 = DTF[(m_ + 64 + lane) * 8 + h]; float s0 = d0 * Ah, s1 = d1 * Ah; \
        _Pragma("unroll") for (int o = 1; o < 64; o <<= 1) { const float t0 = __shfl_up(s0, o), t1 = __shfl_up(s1, o); if (lane >= o) { s0 += t0; s1 += t1; } } \
        const float tot0 = __shfl(s0, 63); s1 += tot0; const float tot = __shfl(s1, 63); \
        F_[lane] = s0; F_[64 + lane] = s1; F_[128 + lane] = __expf(s0); F_[192 + lane] = __expf(s1); \
        F_[256 + lane] = __expf(tot - s0); F_[320 + lane] = __expf(tot - s1); F_[384 + lane] = d0; F_[448 + lane] = d1; } while (0)
#define SSD_STAGE(ck_) do { const LAS float* F_ = F0 + ((ck_) & 1) * 512; const float ea = F_[128 + l_], dec = F_[256 + l_], dt = F_[384 + l_]; \
        *(LAS u32x4*)(lds + SD_CS + l_ * SD_CP + qd * 32) = c0; *(LAS u32x4*)(lds + SD_CS + l_ * SD_CP + qd * 32 + 16) = c1; \
        *(LAS u32x4*)(lds + SD_BS + l_ * SD_CP + qd * 32) = b0; *(LAS u32x4*)(lds + SD_BS + l_ * SD_CP + qd * 32 + 16) = b1; \
        f32x4 ca, cb, cc, cd; unpack8(c0, ca, cb); unpack8(c1, cc, cd); \
        *(LAS u32x4*)(lds + SD_MM + l_ * SD_MP + 256 + qd * 32) = pack8(ca * ea, cb * ea); *(LAS u32x4*)(lds + SD_MM + l_ * SD_MP + 256 + qd * 32 + 16) = pack8(cc * ea, cd * ea); \
        f32x4 ba, bb, bc, bd; unpack8(b0, ba, bb); unpack8(b1, bc, bd); f32x4 xa, xb, xc, xd; unpack8(x0, xa, xb); unpack8(x1, xc, xd); \
        LAS unsigned short* bdt = (LAS unsigned short*)(lds + SD_BDT + (16 * qd) * SD_DP + l_ * 2); LAS unsigned short* xt = (LAS unsigned short*)(lds + SD_XT + (16 * qd) * SD_XP + l_ * 2); \
        _Pragma("unroll") for (int e = 0; e < 4; ++e) { \
            bdt[(e) * (SD_DP / 2)] = f2bf(ba[e] * dec); bdt[(4 + e) * (SD_DP / 2)] = f2bf(bb[e] * dec); bdt[(8 + e) * (SD_DP / 2)] = f2bf(bc[e] * dec); bdt[(12 + e) * (SD_DP / 2)] = f2bf(bd[e] * dec); \
            xt[(e) * (SD_XP / 2)] = f2bf(xa[e] * dt); xt[(4 + e) * (SD_XP / 2)] = f2bf(xb[e] * dt); xt[(8 + e) * (SD_XP / 2)] = f2bf(xc[e] * dt); xt[(12 + e) * (SD_XP / 2)] = f2bf(xd[e] * dt); } } while (0)
    SSD_LOAD(0);
    if (wave == 0) SSD_FCALC(0);
    __syncthreads();
    SSD_STAGE(0);
    SSD_LOAD(1);
    if (wave == 7) SSD_FCALC(1);
    __syncthreads();
    for (int ck = 0; ck < 32; ++ck) {
        const size_t m0 = mb0 + (size_t)ck * 128;
        const LAS float* F = F0 + (ck & 1) * 512;
        {
            const int lt = wave & 3;
#pragma unroll
            for (int sti = 0; sti < 2; ++sti) {
                const int st = 2 * (wave >> 2) + sti;
                if (st <= lt) {
                    f32x16 ga;
#pragma unroll
                    for (int i = 0; i < 16; ++i) ga[i] = 0.f;
#pragma unroll
                    for (int ks = 0; ks < 4; ++ks) {
                        const bf16x8 a = *(const LAS bf16x8*)(lds + SD_CS + (32 * lt + r) * SD_CP + 32 * ks + 16 * hh);
                        const bf16x8 bq = *(const LAS bf16x8*)(lds + SD_BS + (32 * st + r) * SD_CP + 32 * ks + 16 * hh);
                        ga = MFMA32(a, bq, ga);
                    }
                    const int sg = 32 * st + r; const float acs_s = F[sg];
#pragma unroll
                    for (int i = 0; i < 16; ++i) { const int lg = 32 * lt + (i & 3) + 8 * (i >> 2) + 4 * hh;
                        const float v = (sg <= lg) ? ga[i] * __expf(F[lg] - acs_s) : 0.f;
                        *(LAS unsigned short*)(lds + SD_MM + lg * SD_MP + sg * 2) = f2bf(v); }
                }
            }
        }
        __syncthreads();
        {
            __builtin_amdgcn_iglp_opt(0);
            const int lt = wave >> 1, pt = wave & 1;
            const size_t m = m0 + 32 * lt + r;
            bf16_t* yrow = Y + m * 2048 + 1024 + h * 64 + 32 * pt + 4 * hh; const bf16_t* zrow = U1 + m * 1024 + h * 64 + 32 * pt + 4 * hh;
            u32x2 xs4[4], z4[4]; float ssl = 0.f;
#pragma unroll
            for (int g4 = 0; g4 < 4; ++g4) { xs4[g4] = *(const u32x2*)(yrow + 8 * g4); z4[g4] = *(const u32x2*)(zrow + 8 * g4); }
            f32x16 ya;
#pragma unroll
            for (int i = 0; i < 16; ++i) ya[i] = 0.f;
            const LAS unsigned char* bp = lds + SD_MM + (32 * lt + r) * SD_MP + 16 * hh;
            const LAS unsigned char* ap = lds + SD_XT + (32 * pt + r) * SD_XP + 16 * hh;
            const int nks = 2 * (lt + 1);
            for (int ks = 0; ks < nks; ++ks) ya = MFMA32(*(const LAS bf16x8*)(ap + 32 * ks), *(const LAS bf16x8*)(bp + 32 * ks), ya);
#pragma unroll
            for (int ks = 8; ks < 12; ++ks) ya = MFMA32(*(const LAS bf16x8*)(ap + 32 * ks), *(const LAS bf16x8*)(bp + 32 * ks), ya);
#pragma unroll
            for (int g4 = 0; g4 < 4; ++g4) {
                const float xv[4] = {bflo(xs4[g4].x), bfhi(xs4[g4].x), bflo(xs4[g4].y), bfhi(xs4[g4].y)};
                const float zv[4] = {bflo(z4[g4].x), bfhi(z4[g4].x), bflo(z4[g4].y), bfhi(z4[g4].y)};
                float o[4];
#pragma unroll
                for (int e = 0; e < 4; ++e) o[e] = (ya[4 * g4 + e] + xv[e] * Dh) * (zv[e] * sigmoidf_(zv[e]));
                u32x2 w; w.x = cvt_pk_bf16(o[0], o[1]); w.y = cvt_pk_bf16(o[2], o[3]);
                *(u32x2*)(yrow + 8 * g4) = w;
                const float q0 = bflo(w.x), q1 = bfhi(w.x), q2 = bflo(w.y), q3 = bfhi(w.y);
                ssl += (q0 * q0 + q1 * q1) + (q2 * q2 + q3 * q3);
            }
            ssl += __shfl_xor(ssl, 32);
            if (hh == 0) ((float*)(ws + WS_SSQC))[m * 16 + h * 2 + pt] = ssl;
        }
        const int spt = wave >> 1, snt = wave & 1;
        if (wave < 4) {
            __builtin_amdgcn_iglp_opt(0);
            const float et = F[255];
#pragma unroll
            for (int i = 0; i < 16; ++i) S[i] *= et;
#pragma unroll
            for (int ks = 0; ks < 8; ++ks) {
                const bf16x8 a = *(const LAS bf16x8*)(lds + SD_XT + (32 * spt + r) * SD_XP + 32 * ks + 16 * hh);
                const bf16x8 bq = *(const LAS bf16x8*)(lds + SD_BDT + (32 * snt + r) * SD_DP + 32 * ks + 16 * hh);
                S = MFMA32(a, bq, S);
            }
        }
        __syncthreads();
        if (wave < 4) {
#pragma unroll
            for (int i = 0; i < 16; ++i) { const int pgl = 32 * spt + (i & 3) + 8 * (i >> 2) + 4 * hh;
                *(LAS unsigned short*)(lds + SD_XT + pgl * SD_XP + (128 + 32 * snt + r) * 2) = f2bf(S[i]); }
        }
        if (ck + 1 < 32) {
            SSD_STAGE(ck + 1);
            if (ck + 2 < 32) { SSD_LOAD(ck + 2); if (wave == 7) SSD_FCALC(ck + 2); }
        }
        __syncthreads();
    }
#undef SSD_LOAD
#undef SSD_FCALC
#undef SSD_STAGE
}

__device__ __forceinline__ void attn_naive(unsigned char* ws, int gw, int tid_) {
    asm volatile("" : "+v"(tid_)); const int lane = tid_ & 63;
    const bf16_t* Y = (const bf16_t*)(ws + WS_Y); const bf16_t* QR = (const bf16_t*)(ws + B_QR); const bf16_t* KV = (const bf16_t*)(ws + B_KV); const bf16_t* KR = (const bf16_t*)(ws + B_KR);
    bf16_t* YO = (bf16_t*)(ws + WS_Y);
    const int bh = gw >> 5, j = gw & 31, b = bh >> 3, h = bh & 7;
    for (int pass = 0; pass < 2; ++pass) {
        const int qb = pass ? 63 - j : j;
        const int t = qb * 64 + lane; const size_t m = (size_t)b * SEQ + t;
        unsigned q[48];
#pragma unroll
        for (int i = 0; i < 8; ++i) { const u32x4 w = *(const u32x4*)(Y + m * 2048 + h * 64 + i * 8); q[4 * i] = w.x; q[4 * i + 1] = w.y; q[4 * i + 2] = w.z; q[4 * i + 3] = w.w; }
#pragma unroll
        for (int i = 0; i < 4; ++i) { const u32x4 w = *(const u32x4*)(QR + m * 256 + h * 32 + i * 8); q[32 + 4 * i] = w.x; q[33 + 4 * i] = w.y; q[34 + 4 * i] = w.z; q[35 + 4 * i] = w.w; }
        float acc[64];
#pragma unroll
        for (int d = 0; d < 64; ++d) acc[d] = 0.f;
        float mx = -1e30f, lsum = 0.f;
        const int kend = qb * 64 + 64;
        for (int kv = 0; kv < kend; ++kv) {
            const size_t mk = (size_t)b * SEQ + kv;
            const u32x4* kn = (const u32x4*)(KV + mk * 1024 + h * 64); const u32x4* kr = (const u32x4*)(KR + mk * 32); const u32x4* vv = (const u32x4*)(KV + mk * 1024 + 512 + h * 64);
            float s0 = 0.f, s1 = 0.f;
#pragma unroll
            for (int i = 0; i < 8; ++i) { const u32x4 w = kn[i];
                s0 = dot2x(q[4 * i], w.x, s0);
                s1 = dot2x(q[4 * i + 1], w.y, s1);
                s0 = dot2x(q[4 * i + 2], w.z, s0);
                s1 = dot2x(q[4 * i + 3], w.w, s1); }
#pragma unroll
            for (int i = 0; i < 4; ++i) { const u32x4 w = kr[i];
                s0 = dot2x(q[32 + 4 * i], w.x, s0);
                s1 = dot2x(q[33 + 4 * i], w.y, s1);
                s0 = dot2x(q[34 + 4 * i], w.z, s0);
                s1 = dot2x(q[35 + 4 * i], w.w, s1); }
            float s = s0 + s1;
            if (kv > t) s = -1e30f;
            const float mn = fmaxf(mx, s);
            const float alpha = exp2f(mx - mn), p = (kv > t) ? 0.f : exp2f(s - mn);
            mx = mn; lsum = lsum * alpha + p;
#pragma unroll
            for (int i = 0; i < 8; ++i) { const u32x4 w = vv[i];
                acc[8 * i + 0] = acc[8 * i + 0] * alpha + p * bflo(w.x); acc[8 * i + 1] = acc[8 * i + 1] * alpha + p * bfhi(w.x);
                acc[8 * i + 2] = acc[8 * i + 2] * alpha + p * bflo(w.y); acc[8 * i + 3] = acc[8 * i + 3] * alpha + p * bfhi(w.y);
                acc[8 * i + 4] = acc[8 * i + 4] * alpha + p * bflo(w.z); acc[8 * i + 5] = acc[8 * i + 5] * alpha + p * bfhi(w.z);
                acc[8 * i + 6] = acc[8 * i + 6] * alpha + p * bflo(w.w); acc[8 * i + 7] = acc[8 * i + 7] * alpha + p * bfhi(w.w); }
        }
        const float inv = 1.f / lsum;
#pragma unroll
        for (int i = 0; i < 8; ++i) { u32x4 w; w.x = cvt_pk_bf16(acc[8 * i] * inv, acc[8 * i + 1] * inv); w.y = cvt_pk_bf16(acc[8 * i + 2] * inv, acc[8 * i + 3] * inv);
            w.z = cvt_pk_bf16(acc[8 * i + 4] * inv, acc[8 * i + 5] * inv); w.w = cvt_pk_bf16(acc[8 * i + 6] * inv, acc[8 * i + 7] * inv);
            *(u32x4*)(YO + m * 2048 + h * 64 + i * 8) = w; }
    }
}

__device__ __forceinline__ void ssd_naive(PP P, int l, unsigned char* ws, int unit, int wave, int tid_) {
    asm volatile("" : "+v"(tid_)); const int lane = tid_ & 63;
    const int b = unit >> 3, h = unit & 7, g = h >> 2;
    bf16_t* Y = (bf16_t*)(ws + WS_Y); const bf16_t* BC = (const bf16_t*)(ws + B_BC); const bf16_t* U1 = (const bf16_t*)(ws + B_U1); const float* DTF = (const float*)(ws + WS_DTF);
    const float Ah = -__expf(P->in[14][l * 8 + h]); const float Dh = P->in[15][l * 8 + h];
    const int p = wave * 8 + (lane >> 3), no = lane & 7;
    float S[8];
#pragma unroll
    for (int i = 0; i < 8; ++i) S[i] = 0.f;
    for (int t = 0; t < SEQ; ++t) {
        const size_t m = (size_t)b * SEQ + t;
        const float dt = DTF[m * 8 + h]; const float a = __expf(dt * Ah);
        bf16_t* xp = Y + m * 2048 + 1024 + h * 64 + p;
        const float xv = bf2f(*xp); const float xdt = xv * dt;
        f32x4 b0, b1, c0, c1; unpack8(*(const u32x4*)(BC + m * 256 + g * 64 + no * 8), b0, b1); unpack8(*(const u32x4*)(BC + m * 256 + 128 + g * 64 + no * 8), c0, c1);
        float y = 0.f;
#pragma unroll
        for (int i = 0; i < 4; ++i) { S[i] = a * S[i] + xdt * b0[i]; y += S[i] * c0[i]; S[4 + i] = a * S[4 + i] + xdt * b1[i]; y += S[4 + i] * c1[i]; }
        y += __shfl_xor(y, 1); y += __shfl_xor(y, 2); y += __shfl_xor(y, 4);
        const float z = bf2f(U1[m * 1024 + h * 64 + p]);
        y = (y + xv * Dh) * (z * sigmoidf_(z));
        if (no == 0) *xp = f2bf(y);
    }
}

__device__ __forceinline__ float gelu_tanh(float x) { const float u = 0.7978845608028654f * (x + 0.044715f * x * x * x); return x * sigmoidf_(2.f * u); }
__device__ __forceinline__ void lru_scan(unsigned char* ws, int unit, int wave, int tid_, LAS float* sm) {
    asm volatile("" : "+v"(tid_)); const int lane = tid_ & 63;
    const int b = unit >> 3, ch = (unit & 7) * 64 + lane;
    bf16_t* Y = (bf16_t*)(ws + WS_Y); const bf16_t* LA = (const bf16_t*)(ws + B_LA); const bf16_t* U1 = (const bf16_t*)(ws + B_U1);
    const int t0 = wave * 512;
    const size_t m0 = (size_t)b * SEQ + t0;
    const bf16_t* lap = LA + m0 * 512 + ch; bf16_t* up = Y + m0 * 2048 + 1536 + ch; const bf16_t* gp = U1 + m0 * 1024 + 512 + ch;
    float A = 1.f, H = 0.f;
    for (int t = 0; t < 512; t += 16) {
        bf16_t la[16], uu[16];
#pragma unroll
        for (int k = 0; k < 16; ++k) { la[k] = lap[(size_t)(t + k) * 512]; uu[k] = up[(size_t)(t + k) * 2048]; }
#pragma unroll
        for (int k = 0; k < 16; ++k) { const float a = __expf(bf2f(la[k])); H = a * H + bf2f(uu[k]); A *= a; }
    }
    sm[wave * 64 + lane] = A; sm[512 + wave * 64 + lane] = H;
    __syncthreads();
    float hcar = 0.f;
    for (int w = 0; w < wave; ++w) hcar = sm[w * 64 + lane] * hcar + sm[512 + w * 64 + lane];
    for (int t = 0; t < 512; t += 16) {
        bf16_t la[16], uu[16], gg[16];
#pragma unroll
        for (int k = 0; k < 16; ++k) { la[k] = lap[(size_t)(t + k) * 512]; uu[k] = up[(size_t)(t + k) * 2048]; gg[k] = gp[(size_t)(t + k) * 1024]; }
#pragma unroll
        for (int k = 0; k < 16; ++k) { const float a = __expf(bf2f(la[k])); hcar = a * hcar + bf2f(uu[k]); up[(size_t)(t + k) * 2048] = f2bf(bf2f(f2bf(hcar)) * gelu_tanh(bf2f(gg[k]))); }
    }
    __syncthreads();
}


#define RLX_AGENT __ATOMIC_RELAXED, __HIP_MEMORY_SCOPE_AGENT
#define XB_TMO      128
#define XB_XCNT(j)  (256  + 64 * (j))
#define XB_XSUB(j)  (1280 + 64 * (j))
#define XB_XGEN(j)  (2304 + 64 * (j))
#define XB_TOP      3328
#define XB_TOPGEN   3392
#define XCD_BAR_WORDS 3456
#define XB_SPIN_CAP (1u << 18)

__device__ __forceinline__ unsigned xb_ld(unsigned* p)              { return __hip_atomic_load(p, __ATOMIC_RELAXED, __HIP_MEMORY_SCOPE_AGENT); }
__device__ __forceinline__ unsigned xb_add(unsigned* p, unsigned v) { return __hip_atomic_fetch_add(p, v, __ATOMIC_RELAXED, __HIP_MEMORY_SCOPE_AGENT); }
__device__ __forceinline__ unsigned xb_xcc_id() { return (unsigned)__builtin_amdgcn_s_getreg((3 << 11) | 20) & 0xFu; }
#define XB_SPIN(cond, bar) do { unsigned _sp = 0; while (cond) { __builtin_amdgcn_s_sleep(1); \
    if ((++_sp & 255u) == 0u) { if (xb_ld(&(bar)[XB_TMO])) break; if (_sp > XB_SPIN_CAP) { atomicAdd(&(bar)[XB_TMO], 1u); break; } } } } while (0)

struct XcdBarrier {
    unsigned* bar; unsigned x;
    volatile LAS unsigned* st;
};

__device__ __forceinline__ XcdBarrier xcd_barrier_post(unsigned* bar, volatile LAS unsigned* st) {
    XcdBarrier b; b.bar = bar; b.x = xb_xcc_id(); b.st = st;
    if (threadIdx.x == 0) (void)xb_add(&bar[XB_XCNT(b.x)], 1u);
    return b;
}
__device__ __forceinline__ void xcd_barrier_complete(unsigned* bar, unsigned x, unsigned& nloc, unsigned& nx) {
    const unsigned G = gridDim.x * gridDim.y * gridDim.z;
    unsigned sum, cnt, mine, sp = 0u;
    for (;;) {
        sum = 0u; cnt = 0u; mine = 0u;
#pragma unroll
        for (unsigned j = 0; j < 16; ++j) { const unsigned c = xb_ld(&bar[XB_XCNT(j)]); sum += c; cnt += (c > 0u) ? 1u : 0u; mine = (j == x) ? c : mine; }
        if (sum == G) break;
        __builtin_amdgcn_s_sleep(1);
        if ((++sp & 255u) == 0u) { if (xb_ld(&bar[XB_TMO])) break; if (sp > XB_SPIN_CAP) { atomicAdd(&bar[XB_TMO], 1u); break; } }
    }
    nloc = mine > 0u ? mine : 1u; nx = cnt > 0u ? cnt : 1u;
}

__device__ __forceinline__ void xcd_barrier(const XcdBarrier& b) {
    asm volatile("s_waitcnt vmcnt(0)" ::: "memory");
    __syncthreads();
    if (threadIdx.x == 0) {
        unsigned* bar = b.bar;
        __builtin_amdgcn_s_waitcnt(0);
        unsigned nloc = b.st[0], nx = b.st[1];
        if (nloc == 0u) { xcd_barrier_complete(bar, b.x, nloc, nx); b.st[0] = nloc; b.st[1] = nx; }
        const unsigned old = xb_add(&bar[XB_XSUB(b.x)], 1u);
        const unsigned gen = old / nloc;
        if (old + 1u == (gen + 1u) * nloc) {
            __builtin_amdgcn_fence(__ATOMIC_RELEASE, "agent");
            asm volatile("s_waitcnt vmcnt(0)" ::: "memory");
            const unsigned og = xb_add(&bar[XB_TOP], 1u);
            const unsigned tg = og / nx;
            if (og + 1u == (tg + 1u) * nx) xb_add(&bar[XB_TOPGEN], 1u);
            else XB_SPIN(xb_ld(&bar[XB_TOPGEN]) == tg, bar);
            __builtin_amdgcn_fence(__ATOMIC_ACQUIRE, "agent");
            xb_add(&bar[XB_XGEN(b.x)], 1u);
            asm volatile("s_waitcnt vmcnt(0)" ::: "memory");
        } else {
            XB_SPIN(xb_ld(&bar[XB_XGEN(b.x)]) == gen, bar);
            __builtin_amdgcn_fence(__ATOMIC_ACQUIRE, "agent");
            asm volatile("s_waitcnt vmcnt(0)" ::: "memory");
        }
    }
    __syncthreads();
}


constexpr int LDS_BYTES = 147456;
#ifndef GMASK
#define GMASK 0xffffffffu
#endif
__global__ void __launch_bounds__(512, 2) mk_fwd(Params Pk) {
    extern __shared__ __attribute__((aligned(16))) unsigned char lds_raw[];
    LAS unsigned char* lds = (LAS unsigned char*)lds_raw;
    cg::grid_group grid = cg::this_grid();
    const int tid = threadIdx.x, wave = __builtin_amdgcn_readfirstlane(tid >> 6);
    const int G = gridDim.x, bid = blockIdx.x;
    const int gw = bid * 8 + wave, NGW = G * 8, NGT = G * 512;
    PP P = (PP)__builtin_amdgcn_kernarg_segment_ptr();
    unsigned char* ws = (unsigned char*)(__attribute__((address_space(1))) unsigned char*)P->ws;
    { volatile LAS unsigned* st0 = (volatile LAS unsigned*)(lds + 146000); if (tid == 0) { st0[0] = 0u; st0[1] = 0u; } __syncthreads(); }
    XcdBarrier xbar = xcd_barrier_post((unsigned*)P->ws + 4096, (volatile LAS unsigned*)(lds + 146000));
    if (G > 100000) grid.sync();
#define FRESH() do { asm volatile("" : "+s"(P)); { __attribute__((address_space(1))) unsigned char* g_ = (__attribute__((address_space(1))) unsigned char*)P->ws; asm volatile("" : "+s"(g_), "+s"(l)); ws = (unsigned char*)g_; } W = (bf16_t*)(ws + WS_W); XB = (bf16_t*)(ws + WS_XB); Y = (bf16_t*)(ws + WS_Y); } while (0)
#define GSYNC() do { xcd_barrier(xbar); } while (0)
    bf16_t* W = (bf16_t*)(ws + WS_W); bf16_t* XB = (bf16_t*)(ws + WS_XB); bf16_t* Y = (bf16_t*)(ws + WS_Y);
    #define SSQA ((float*)(ws + WS_SSQA))
#define SSQB ((float*)(ws + WS_SSQB))
#define SSQC_ (cur ? SSQB : SSQA)
#define SSQN_ (cur ? SSQA : SSQB)
    int cur = 0;
    using namespace pg8;

    for (int l = 0; l < DEPTH; ++l) {
        FRESH();
        conv_weights(P, l, W, tid, bid, NGT, lds);
        p0_rows(P, l == 0 ? P->in[0] : (const float*)P->out, l == 0, XB, SSQA, (f32x2*)(ws + WS_CS), gw, NGW, tid);
        GSYNC(); FRESH();
        { Gemm g{XB, W + W_IN, M, 3584, 1024, 1024, 0, 0}; StaticOrder S; S.init(M, 3584, G, bid);
          EpiInproj E{(bf16_t*)(ws + B_U1), (bf16_t*)(ws + B_UA), (bf16_t*)(ws + B_UB), lds};
          rstd_prepass(lds, SSQC_, S, tid); if (GMASK & (1u << 0)) gemm_phase(lds, g, S, E); }
        GSYNC(); FRESH();
        p2_prep(P, l, ws, gw, NGW, tid);
        GSYNC(); FRESH();
        { Gemm g{(const bf16_t*)(ws + B_UA), W + W_UQ, M, 768, 384, 768, 0, 0}; StaticOrder S; S.init(M, 768, G, bid);
          EpiQ E{Y, (bf16_t*)(ws + B_QR), (const float*)(ws + WS_RSQ), (const f32x2*)(ws + WS_CS)}; if (GMASK & (1u << 1)) gemm_phase(lds, g, S, E); }
        { Gemm g{(const bf16_t*)(ws + B_UA) + 384, W + W_UKV, M, 1024, 256, 768, 0, 0}; StaticOrder S; S.init(M, 1024, G, (bid + 128) % G);
          EpiRowScale E{(bf16_t*)(ws + B_KV), 1024, (const float*)(ws + WS_RSKV), 0}; if (GMASK & (1u << 2)) gemm_phase(lds, g, S, E); }
        { Gemm g{Y + 512, W + W_POOL, M, 512, 256, 2048, 256, 0}; StaticOrder S; S.init(M, 512, G, bid);
          EpiRowScale E{Y + 512, 2048, nullptr, 0}; if (GMASK & (1u << 3)) gemm_phase(lds, g, S, E); }
        { Gemm g{Y + 1536, W + W_LRU, M, 1024, 128, 2048, 128, 0}; StaticOrder S; S.init(M, 1024, G, bid);
          EpiLru E{Y + 1536, (bf16_t*)(ws + B_LA), P->in[20] + l * 512, P->in[22] + l * 512, P->in[23] + l * 512}; if (GMASK & (1u << 4)) gemm_phase(lds, g, S, E); }
        GSYNC(); FRESH();
#ifdef NAIVE_SSD
        if (bid < 64) ssd_naive(P, l, ws, bid, wave, tid);
#else
        if (bid < 64) ssd_mfma(P, l, ws, lds, bid, wave, tid);
#endif
#ifndef NO_LRU
        if (bid >= 64 && bid < 128) lru_scan(ws, bid - 64, wave, tid, (LAS float*)lds);
#endif
#ifdef NAIVE_ATTN
        if (gw < 2048) attn_naive(ws, gw, tid);
#else
#ifdef PROBE_ATTN
        attn_phase(ws, lds, (unsigned*)ws + 64 + 16 * l + 8, wave, tid, (bf16_t*)(ws + B_UA), 512);
#endif
        attn_phase(ws, lds, (unsigned*)ws + 64 + 16 * l, wave, tid, (bf16_t*)(ws + WS_Y), 2048);
#endif
        GSYNC(); FRESH();
#define TBUF(n) ((bf16_t*)(ws + WS_BIG + (size_t)(n) * 64 * MiB))
#define MB ((bf16_t*)(ws + WS_BIG + 64 * MiB))
        { MergeOrder S; S.base.init(M, 1024, G, bid); EpiMerge E{lds, TBUF(0), MB};
          merge_prepass(lds, SSQC_, (const float*)(ws + WS_SSQC), S, tid);
          if (GMASK & (1u << 5)) gemm_merge_fused(lds, Y, XB, W + W_BR, W + W_G, S, E); }
        GSYNC(); FRESH();
        { Gemm g{MB, W + W_OUT, M, 1024, 1024, 1024, 0, 0}; StaticOrder S; S.init(M, 1024, G, bid);
          EpiRes<0> E{l == 0 ? P->in[0] : P->out, P->out, XB, SSQN_, (const LAS unsigned char*)nullptr, nullptr}; if (GMASK & (1u << 8)) gemm_phase(lds, g, S, E); cur ^= 1; }
        GSYNC(); FRESH();
        conv_p(P, l, (bf16_t*)(ws + Y_PB), tid, bid, NGT);
        { Gemm g{XB, W + W_FF1, M, 4096, 1024, 1024, 0, 0}; StaticOrder S; S.init(M, 4096, G, bid);
          EpiFF1 E{(bf16_t*)(ws + B_H), lds}; rstd_prepass(lds, SSQC_, S, tid); if (GMASK & (1u << 9)) gemm_phase(lds, g, S, E); }
        GSYNC(); FRESH();
        { Gemm g{(const bf16_t*)(ws + B_H), W + W_FF2, M, 1024, 4096, 4096, 0, 0}; StaticOrder S; S.init(M, 1024, G, bid); S.rev = 1;
          EpiRes<0> E{P->out, P->out, XB, SSQN_, (const LAS unsigned char*)nullptr, nullptr}; if (GMASK & (1u << 10)) gemm_phase(lds, g, S, E); cur ^= 1; }
        { Gemm g{(const bf16_t*)(ws + Y_PB), W + W_PLE, M, 1024, 256, 256, 0, 0}; StaticOrder S; S.init(M, 1024, G, bid);
          EpiRowScale E{(bf16_t*)(ws + Y_TP), 1024, nullptr, 0}; if (GMASK & (1u << 11)) gemm_phase(lds, g, S, E); }
        GSYNC(); FRESH();
        { Gemm g{XB, W + W_PG, M, 1024, 1024, 1024, 0, 0}; StaticOrder S; S.init(M, 1024, G, bid);
          EpiRes<1> E{P->out, P->out, XB, SSQN_, lds, (const bf16_t*)(ws + Y_TP)}; rstd_prepass(lds, SSQC_, S, tid); if (GMASK & (1u << 12)) gemm_phase(lds, g, S, E); cur ^= 1; }
        GSYNC(); FRESH();
    }
    final_norm(P, SSQC_, gw, NGW, tid);
}

extern "C" void kernel_launch(void* const* d_in, const int* in_sizes, int n_in, void* d_out, int out_size, void* d_ws, size_t ws_size, hipStream_t stream) {
    static int grid = 0;
    if (grid == 0) {
        if (n_in != 33 || out_size != M * D || ws_size < WS_END) { fprintf(stderr, "kernel_launch: unexpected shapes (n_in %d out %d ws %zu)\n", n_in, out_size, ws_size); grid = -1; return; }
        int dev = 0, cus = 0, per_cu = 0;
        hipGetDevice(&dev); hipDeviceGetAttribute(&cus, hipDeviceAttributeMultiprocessorCount, dev);
        hipFuncSetAttribute((const void*)mk_fwd, hipFuncAttributeMaxDynamicSharedMemorySize, LDS_BYTES);
        hipOccupancyMaxActiveBlocksPerMultiprocessor(&per_cu, (const void*)mk_fwd, 512, LDS_BYTES);
        if (per_cu < 1) per_cu = 1;
        grid = cus >= 256 ? 256 : cus;
        (void)hipGetLastError();
    }
    if (grid < 0) return;
    if (hipMemsetAsync(d_ws, 0, 65536, stream) != hipSuccess) { fprintf(stderr, "memset failed\n"); return; }
    Params p{};
    for (int i = 0; i < 33; ++i) p.in[i] = (const float*)d_in[i];
    p.out = (float*)d_out; p.ws = (unsigned char*)d_ws;
    for (int i = 0; i < 16; ++i) p.inv_freq[i] = 1.0 / pow(10000.0, (double)i / 16.0);
    void* args[] = {&p};
    hipError_t e = hipLaunchCooperativeKernel((const void*)mk_fwd, dim3(grid), dim3(512), args, LDS_BYTES, stream);
    if (e != hipSuccess) fprintf(stderr, "cooperative launch failed: %s (grid %d)\n", hipGetErrorString(e), grid);
}
```

```cpp
#include <hip/hip_runtime.h>
#include <hip/hip_cooperative_groups.h>
#include <cstdio>
#include <cstdint>
#include <cmath>
namespace cg = cooperative_groups;

#define LAS __attribute__((address_space(3)))
typedef unsigned short bf16_t;
typedef short bf16x8 __attribute__((ext_vector_type(8)));
typedef float f32x4 __attribute__((ext_vector_type(4)));
typedef float f32x2 __attribute__((ext_vector_type(2)));
typedef unsigned u32x4 __attribute__((ext_vector_type(4)));
typedef unsigned u32x2 __attribute__((ext_vector_type(2)));
typedef __bf16 bf16x2_t __attribute__((ext_vector_type(2)));

constexpr int M = 32768, SEQ = 4096, NB = 8, D = 1024, DEPTH = 2;
constexpr int INC = 7592;
constexpr float EPS = 1e-6f;
constexpr float QSCALE = 0.10206207261596577f * 1.4426950408889634f;

constexpr size_t MiB = 1u << 20;
constexpr size_t WS_SSQA = 2 * MiB, WS_SSQB = 4 * MiB, WS_RSQ = 6 * MiB, WS_RSKV = WS_RSQ + 128 * 1024, WS_RSC = WS_RSKV + 128 * 1024;
constexpr size_t WS_DTF = 7 * MiB, WS_CS = 8 * MiB, WS_SSQC = 12 * MiB;
constexpr size_t WS_W = 16 * MiB, WS_XB = 60 * MiB, WS_Y = 124 * MiB, WS_BIG = 252 * MiB, WS_END = 512 * MiB;
constexpr size_t B_U1 = WS_BIG, B_UA = WS_BIG + 64 * MiB, B_UB = WS_BIG + 112 * MiB, B_BC = WS_BIG + 224 * MiB, B_KR = WS_BIG + 240 * MiB;
constexpr size_t B_QR = WS_BIG + 112 * MiB, B_KV = WS_BIG + 128 * MiB, B_LA = WS_BIG + 192 * MiB;
constexpr size_t B_T0 = WS_BIG, B_T1 = WS_BIG + 64 * MiB, B_MB = WS_BIG + 128 * MiB;
constexpr size_t B_H = WS_BIG;
constexpr size_t Y_TP = WS_Y, Y_PB = WS_Y + 64 * MiB;
constexpr size_t W_IN = 0, W_G = W_IN + 3584ull * 1024, W_UQ = W_G + 4096ull * 1024, W_UKV = W_UQ + 768ull * 384, W_POOL = W_UKV + 1024ull * 256,
                 W_LRU = W_POOL + 512ull * 256, W_BR = W_LRU + 1024ull * 128, W_OUT = W_BR + 4096ull * 512, W_FF1 = W_OUT + 1024ull * 1024,
                 W_FF2 = W_FF1 + 4096ull * 1024, W_PG = W_FF2 + 4096ull * 1024, W_PLE = W_PG + 1024ull * 1024, W_TOTAL = W_PLE + 1024ull * 256;
static_assert(W_TOTAL * 2 <= 44 * MiB, "weights fit");

struct Params {
    const float* in[33];
    float* out;
    unsigned char* ws;
    double inv_freq[16];
};

typedef const __attribute__((address_space(4))) Params* PP;
#if defined(__HIP_DEVICE_COMPILE__)
#define ASSUME_GLOBAL(p) do { __builtin_assume(!__builtin_amdgcn_is_shared((const __attribute__((address_space(0))) void*)(p))); __builtin_assume(!__builtin_amdgcn_is_private((const __attribute__((address_space(0))) void*)(p))); } while (0)
#else
#define ASSUME_GLOBAL(p) do { } while (0)
#endif
__device__ __forceinline__ unsigned cvt_pk_bf16(float lo, float hi) { unsigned r; asm("v_cvt_pk_bf16_f32 %0, %1, %2" : "=v"(r) : "v"(lo), "v"(hi)); return r; }
__device__ __forceinline__ float bflo(unsigned w) { return __uint_as_float(w << 16); }
__device__ __forceinline__ float bfhi(unsigned w) { return __uint_as_float(w & 0xffff0000u); }
__device__ __forceinline__ float bf2f(bf16_t h) { return __uint_as_float(((unsigned)h) << 16); }
__device__ __forceinline__ bf16_t f2bf(float f) { return (bf16_t)(cvt_pk_bf16(f, 0.f) & 0xffffu); }
__device__ __forceinline__ u32x4 pack8(f32x4 a, f32x4 b) { u32x4 w; w.x = cvt_pk_bf16(a[0], a[1]); w.y = cvt_pk_bf16(a[2], a[3]); w.z = cvt_pk_bf16(b[0], b[1]); w.w = cvt_pk_bf16(b[2], b[3]); return w; }
__device__ __forceinline__ void unpack8(u32x4 w, f32x4& a, f32x4& b) { a = (f32x4){bflo(w.x), bfhi(w.x), bflo(w.y), bfhi(w.y)}; b = (f32x4){bflo(w.z), bfhi(w.z), bflo(w.w), bfhi(w.w)}; }
__device__ __forceinline__ float dot2x(unsigned a, unsigned b, float c) { return c + bflo(a) * bflo(b) + bfhi(a) * bfhi(b); }
__device__ __forceinline__ float sigmoidf_(float x) { return __builtin_amdgcn_rcpf(1.f + __builtin_amdgcn_exp2f(-1.4426950408889634f * x)); }
__device__ __forceinline__ float one_minus_exp(float x) {
    const float p = -x * (1.f + x * (0.5f + x * (0.16666667f + x * (0.041666668f + x * (0.008333334f + x * (0.0013888889f + x * 0.0001984127f))))));
    return x < -0.25f ? 1.f - __expf(x) : p;
}
__device__ __forceinline__ float xhalf_sum(float v) { const auto r_ = __builtin_amdgcn_permlane32_swap(__float_as_uint(v), __float_as_uint(v), false, false); return __uint_as_float(r_[0]) + __uint_as_float(r_[1]); }
__device__ __forceinline__ float xhalf_max(float v) { const auto r_ = __builtin_amdgcn_permlane32_swap(__float_as_uint(v), __float_as_uint(v), false, false); return fmaxf(__uint_as_float(r_[0]), __uint_as_float(r_[1])); }
__device__ __forceinline__ float wave_sum(float v) {
#pragma unroll
    for (int o = 1; o < 64; o <<= 1) v += __shfl_xor(v, o);
    return v;
}
__device__ __forceinline__ float rstd16(const float* ssq, int row) {
    const f32x4* p = (const f32x4*)(ssq + (size_t)row * 16);
    f32x4 a = p[0], b = p[1], c = p[2], d = p[3];
    f32x4 s = (a + b) + (c + d);
    return rsqrtf(((s[0] + s[1]) + (s[2] + s[3])) * (1.f / 1024.f) + EPS);
}

namespace pg8 {
constexpr int BM = 256, BK = 64, HALF = 128, HTB = HALF * BK * 2, STAGE_BYTES = 8 * HTB, NXCD = 8, WGM = 8;
__host__ __device__ __forceinline__ int lds_byte(int r, int c) { const int st = (r >> 4) * 2 + (c >> 5), rr = r & 15, cc = c & 31, ob = rr * 64 + cc * 2; return st * 1024 + (ob ^ (((ob >> 9) & 1) << 5)); }
__host__ __device__ __forceinline__ void stage_rc(int b, int& R, int& C) { const int st = b / 1024, sb = b % 1024, swz = sb ^ (((sb >> 9) & 1) << 5); R = (st >> 1) * 16 + swz / 64; C = (st & 1) * 32 + (swz % 64) / 2; }
__host__ __device__ __forceinline__ int perm32(int rho) { const int n = rho >> 4, i = rho & 15; return 8 * (i >> 2) + 4 * n + (i & 3); }

struct Unit { int pm, pn, ui; };
struct Gemm { const bf16_t* A; const bf16_t* Bt; int M, N, K, lda, a_pn_off, a_sh; };

struct StaticOrder {
    int nM, nN, nwg, G, c, rev;
    __device__ __forceinline__ void init(int M_, int N_, int G_, int c_) { nM = M_ / BM; nN = N_ / BM; nwg = nM * nN; G = G_; c = c_; rev = 0; }
    __device__ __forceinline__ bool next(int i, Unit& u) const {
        const long L = (long)i * G + c; if (L >= nwg) return false;
        int wgid = (int)L; { const int q = nwg / NXCD, r = nwg % NXCD, xcd = wgid % NXCD, off = wgid / NXCD; wgid = (xcd < r ? xcd * (q + 1) : r * (q + 1) + (xcd - r) * q) + off; }
        const int nig = WGM * nN, gid = wgid / nig, fm = gid * WGM, gsz = (nM - fm) < WGM ? (nM - fm) : WGM;
        u.pm = fm + ((wgid % nig) % gsz); u.pn = (wgid % nig) / gsz; if (rev) u.pm = nM - 1 - u.pm; return true;
    }
};

struct GateOrder {
    StaticOrder base;
    __device__ __forceinline__ bool next(int i, Unit& u) const { Unit t; if (!base.next(i >> 2, t)) return false; u.pm = t.pm; u.pn = (i & 3) * 4 + t.pn; return true; }
};
constexpr int RSL_OFF = 135168;
template <class Sched>
__device__ __forceinline__ void rstd_prepass(LAS unsigned char* lds, const float* ssq, const Sched& S, int tid_) {
    asm volatile("" : "+v"(tid_));
    LAS float* rsl = (LAS float*)(lds + RSL_OFF); Unit u;
    for (int i = tid_ >> 8; i < 10 && S.next(i, u); i += 2) rsl[i * 256 + (tid_ & 255)] = rstd16(ssq, u.pm * 256 + (tid_ & 255));
    __syncthreads();
}
#define RSL(u_, row_) (((const LAS float*)(lds_rs + RSL_OFF))[(u_).ui * 256 + ((row_) & 255)])
template <class Epi, class Sched>
__device__ __forceinline__ void gemm_phase(LAS unsigned char* lds, const Gemm g, const Sched& S, const Epi& E) {
    int tid = threadIdx.x; asm volatile("" : "+v"(tid));
    const int wid = __builtin_amdgcn_readfirstlane(tid >> 6), lane = tid & 63, wr = wid >> 2, wc = wid & 3, fr = lane & 15, fq = lane >> 4;
    int K = g.K, lda = g.lda; asm volatile("" : "+s"(K), "+s"(lda));
    const int nt = K / BK;
    unsigned voffA[2], voffB[2];
#pragma unroll
    for (int i = 0; i < 2; ++i) { int R, C; stage_rc(tid * 16 + i * 8192, R, C); const int Rb = (R & ~31) + perm32(R & 31);
        voffA[i] = (unsigned)(R * lda + C) * 2u; voffB[i] = (unsigned)(Rb * K + C) * 2u; }
    const size_t kstep = (size_t)(BK * 2);
    const size_t hsA = (size_t)HALF * lda * 2, hsB = (size_t)HALF * K * 2;
    const size_t tsA = 2 * hsA, tsB = 2 * hsB, pnA = (size_t)g.a_pn_off * 2;
    const unsigned ldsw = (unsigned)wid * 1024u;
    const int aoff = lds_byte(wr * 64 + fr, fq * 8), boff = lds_byte(wc * 32 + fr, fq * 8);
#define PG8_SA(b, h) (((b) * 2 + (h)) * HTB)
#define PG8_SB(b, h) ((4 + (b) * 2 + (h)) * HTB)
#define PG8_STAGE(bufoff, gbase, voff) do { _Pragma("unroll") for (int _i = 0; _i < 2; ++_i) \
        __builtin_amdgcn_global_load_lds((const unsigned*)((const char*)(gbase) + (voff)[_i]), (LAS unsigned*)(lds + (bufoff) + ldsw + _i * 8192), 16, 0, 0); } while (0)
#define PG8_LDA(dst, b, h) do { _Pragma("unroll") for (int m = 0; m < 4; ++m) _Pragma("unroll") for (int k = 0; k < 2; ++k) dst[m][k] = *(const LAS bf16x8*)(lds + PG8_SA(b, h) + aoff + m * 2048 + k * 1024); } while (0)
#define PG8_LDB(dst, b, h) do { _Pragma("unroll") for (int n = 0; n < 2; ++n) _Pragma("unroll") for (int k = 0; k < 2; ++k) dst[n][k] = *(const LAS bf16x8*)(lds + PG8_SB(b, h) + boff + n * 2048 + k * 1024); } while (0)
#define PG8_MMA(ai, bj, At, Bt) do { __builtin_amdgcn_s_setprio(1); _Pragma("unroll") for (int m = 0; m < 4; ++m) _Pragma("unroll") for (int n = 0; n < 2; ++n) _Pragma("unroll") for (int k = 0; k < 2; ++k) \
        acc[ai][bj][m][n] = __builtin_amdgcn_mfma_f32_16x16x32_bf16(Bt[n][k], At[m][k], acc[ai][bj][m][n], 0, 0, 0); __builtin_amdgcn_s_setprio(0); } while (0)
#define PG8_WAIT_V(n) asm volatile("s_waitcnt vmcnt(" #n ")" ::: "memory")
#define PG8_WAIT_L(n) asm volatile("s_waitcnt lgkmcnt(" #n ")" ::: "memory")
#define PG8_BAR __builtin_amdgcn_s_barrier()
#define PG8_SCHED __builtin_amdgcn_sched_barrier(0)
    Unit cur, nxt; int ui = 0;
    if (!S.next(0, cur)) return;
    f32x4 acc[2][2][4][2];
#pragma unroll
    for (int a = 0; a < 2; ++a)
#pragma unroll
        for (int b = 0; b < 2; ++b)
#pragma unroll
            for (int m = 0; m < 4; ++m)
#pragma unroll
                for (int n = 0; n < 2; ++n) acc[a][b][m][n] = (f32x4){0.f, 0.f, 0.f, 0.f};
    bf16x8 At[4][2], B0[2][2], B1[2][2];
    const char* cA = (const char*)g.A + (size_t)cur.pm * tsA + (size_t)(cur.pn >> g.a_sh) * pnA; const char* cB = (const char*)g.Bt + (size_t)cur.pn * tsB;
    PG8_STAGE(PG8_SB(0, 0), cB, voffB); PG8_STAGE(PG8_SB(0, 1), cB + hsB, voffB); PG8_STAGE(PG8_SA(0, 0), cA, voffA); PG8_STAGE(PG8_SA(0, 1), cA + hsA, voffA);
    if (wr == 1) PG8_BAR;
    PG8_WAIT_V(2); PG8_BAR;
    PG8_STAGE(PG8_SB(1, 0), cB + kstep, voffB); PG8_STAGE(PG8_SA(1, 0), cA + kstep, voffA); PG8_STAGE(PG8_SB(1, 1), cB + hsB + kstep, voffB);
    PG8_WAIT_V(6); PG8_BAR;
    for (;;) {
        const bool has_next = S.next(ui + 1, nxt);
        const char* nA = has_next ? (const char*)g.A + (size_t)nxt.pm * tsA + (size_t)(nxt.pn >> g.a_sh) * pnA : cA; const char* nB = has_next ? (const char*)g.Bt + (size_t)nxt.pn * tsB : cB;
        for (int t = 0; t < nt; t += 2) {
            const bool last = (t == nt - 2);
            const char* a1 = cA + (size_t)(t + 1) * kstep;
            const char* a2 = last ? nA : cA + (size_t)(t + 2) * kstep; const char* b2 = last ? nB : cB + (size_t)(t + 2) * kstep;
            const char* a3 = a2 + kstep; const char* b3 = b2 + kstep;
            PG8_LDB(B0, 0, 0); PG8_LDB(B1, 0, 1); PG8_SCHED; PG8_LDA(At, 0, 0); PG8_STAGE(PG8_SA(1, 1), a1 + hsA, voffA);
            PG8_WAIT_V(8); PG8_WAIT_L(0); PG8_BAR; PG8_MMA(0, 0, At, B0); PG8_MMA(0, 1, At, B1); PG8_BAR; PG8_SCHED;
            PG8_LDA(At, 0, 1); PG8_STAGE(PG8_SB(0, 0), b2, voffB); PG8_STAGE(PG8_SB(0, 1), b2 + hsB, voffB); PG8_STAGE(PG8_SA(0, 0), a2, voffA);
            PG8_WAIT_V(8); PG8_WAIT_L(0); PG8_BAR; PG8_MMA(1, 0, At, B0); PG8_MMA(1, 1, At, B1); PG8_BAR; PG8_SCHED;
            PG8_LDB(B0, 1, 0); PG8_LDB(B1, 1, 1); PG8_SCHED; PG8_LDA(At, 1, 0); PG8_STAGE(PG8_SA(0, 1), a2 + hsA, voffA);
            PG8_WAIT_V(8); PG8_WAIT_L(0); PG8_BAR; PG8_MMA(0, 0, At, B0); PG8_MMA(0, 1, At, B1); PG8_BAR; PG8_SCHED;
            PG8_LDA(At, 1, 1); PG8_STAGE(PG8_SB(1, 0), b3, voffB); PG8_STAGE(PG8_SB(1, 1), b3 + hsB, voffB); PG8_STAGE(PG8_SA(1, 0), a3, voffA);
            PG8_WAIT_V(8); PG8_WAIT_L(0); PG8_BAR; PG8_MMA(1, 0, At, B0); PG8_MMA(1, 1, At, B1); PG8_BAR; PG8_SCHED;
        }
        if (wr == 0) PG8_BAR;
        cur.ui = ui; E(acc, cur, wr, wc, fr, fq);
        if (!has_next) break;
#pragma unroll
        for (int a = 0; a < 2; ++a)
#pragma unroll
            for (int b = 0; b < 2; ++b)
#pragma unroll
                for (int m = 0; m < 4; ++m)
#pragma unroll
                    for (int n = 0; n < 2; ++n) acc[a][b][m][n] = (f32x4){0.f, 0.f, 0.f, 0.f};
        cur = nxt; cA = nA; cB = nB; ++ui;
        if (wr == 1) PG8_BAR;
    }
    PG8_WAIT_V(0);
    PG8_BAR;
#undef PG8_SA
#undef PG8_SB
#undef PG8_STAGE
#undef PG8_LDA
#undef PG8_LDB
#undef PG8_MMA
#undef PG8_WAIT_V
#undef PG8_WAIT_L
#undef PG8_BAR
#undef PG8_SCHED
}

struct MUnit { int pm, pn, ui, kind, n; };
struct MergeOrder { StaticOrder base;
    __device__ __forceinline__ bool next(int i, MUnit& u) const { Unit t; if (!base.next(i >> 3, t)) return false; u.pm = t.pm; u.pn = t.pn; u.n = (i >> 1) & 3; u.kind = i & 1; u.ui = i; return true; } };
template <class Epi>
__device__ __forceinline__ void gemm_merge_fused(LAS unsigned char* lds, const bf16_t* Yb, const bf16_t* XBb, const bf16_t* WBR, const bf16_t* WG, const MergeOrder& S, const Epi& E) {
    int tid = threadIdx.x; asm volatile("" : "+v"(tid));
    const int wid = __builtin_amdgcn_readfirstlane(tid >> 6), lane = tid & 63, wr = wid >> 2, wc = wid & 3, fr = lane & 15, fq = lane >> 4;
    int R0, C0; stage_rc(tid * 16, R0, C0);
    const unsigned Rb0 = (unsigned)((R0 & ~31) + perm32(R0 & 31)), Ra0 = (unsigned)R0, C2 = (unsigned)C0 * 2u;
    int la0 = 4096, lb0 = 1024, la1_ = 2048, lb1 = 2048, nt0 = 8, nt1 = 16;
    asm volatile("" : "+s"(la0), "+s"(lb0), "+s"(la1_), "+s"(lb1), "+s"(nt0), "+s"(nt1));
#define MF_LA(k) ((unsigned)((k) ? la1_ : la0))
#define MF_LB(k) ((unsigned)((k) ? lb1 : lb0))
    const size_t kstep = (size_t)(BK * 2);
#define MF_ABASE(u_) ((u_).kind ? (const char*)XBb + (size_t)(u_).pm * 256 * 1024 * 2 : (const char*)Yb + (size_t)(u_).pm * 256 * 2048 * 2 + (size_t)(u_).n * 512 * 2)
#define MF_BBASE(u_) ((u_).kind ? (const char*)WG + ((size_t)(u_).n * 1024 + (size_t)(u_).pn * 256) * 1024 * 2 : (const char*)WBR + ((size_t)(u_).n * 1024 + (size_t)(u_).pn * 256) * 512 * 2)
    const unsigned ldsw = (unsigned)wid * 1024u;
    const int aoff = lds_byte(wr * 64 + fr, fq * 8), boff = lds_byte(wc * 32 + fr, fq * 8);
#define PG8_SA(b, h) (((b) * 2 + (h)) * HTB)
#define PG8_SB(b, h) ((4 + (b) * 2 + (h)) * HTB)
#define PG8_STAGE(bufoff, gbase, voff) do { _Pragma("unroll") for (int _i = 0; _i < 2; ++_i) \
        __builtin_amdgcn_global_load_lds((const unsigned*)((const char*)(gbase) + (voff)[_i]), (LAS unsigned*)(lds + (bufoff) + ldsw + _i * 8192), 16, 0, 0); } while (0)
#define PG8_LDA(dst, b, h) do { _Pragma("unroll") for (int m = 0; m < 4; ++m) _Pragma("unroll") for (int k = 0; k < 2; ++k) dst[m][k] = *(const LAS bf16x8*)(lds + PG8_SA(b, h) + aoff + m * 2048 + k * 1024); } while (0)
#define PG8_LDB(dst, b, h) do { _Pragma("unroll") for (int n = 0; n < 2; ++n) _Pragma("unroll") for (int k = 0; k < 2; ++k) dst[n][k] = *(const LAS bf16x8*)(lds + PG8_SB(b, h) + boff + n * 2048 + k * 1024); } while (0)
#define PG8_MMA(ai, bj, At, Bt) do { __builtin_amdgcn_s_setprio(1); _Pragma("unroll") for (int m = 0; m < 4; ++m) _Pragma("unroll") for (int n = 0; n < 2; ++n) _Pragma("unroll") for (int k = 0; k < 2; ++k) \
        acc[ai][bj][m][n] = __builtin_amdgcn_mfma_f32_16x16x32_bf16(Bt[n][k], At[m][k], acc[ai][bj][m][n], 0, 0, 0); __builtin_amdgcn_s_setprio(0); } while (0)
#define PG8_WAIT_V(n) asm volatile("s_waitcnt vmcnt(" #n ")" ::: "memory")
#define PG8_WAIT_L(n) asm volatile("s_waitcnt lgkmcnt(" #n ")" ::: "memory")
#define PG8_BAR __builtin_amdgcn_s_barrier()
#define PG8_SCHED __builtin_amdgcn_sched_barrier(0)
    MUnit cur, nxt; int ui = 0;
    if (!S.next(0, cur)) return;
    f32x4 acc[2][2][4][2];
#pragma unroll
    for (int a = 0; a < 2; ++a)
#pragma unroll
        for (int b = 0; b < 2; ++b)
#pragma unroll
            for (int m = 0; m < 4; ++m)
#pragma unroll
                for (int n = 0; n < 2; ++n) acc[a][b][m][n] = (f32x4){0.f, 0.f, 0.f, 0.f};
    bf16x8 At[4][2], B0[2][2], B1[2][2];
    const char* cA = MF_ABASE(cur); const char* cB = MF_BBASE(cur); int ck = cur.kind;
    { const unsigned la = MF_LA(ck), lb = MF_LB(ck); unsigned voffA[2] = {Ra0 * la + C2, Ra0 * la + C2 + 64u * la}, voffB[2] = {Rb0 * lb + C2, Rb0 * lb + C2 + 64u * lb}; const size_t hsA = (size_t)128 * la, hsB = (size_t)128 * lb;
    PG8_STAGE(PG8_SB(0, 0), cB, voffB); PG8_STAGE(PG8_SB(0, 1), cB + hsB, voffB); PG8_STAGE(PG8_SA(0, 0), cA, voffA); PG8_STAGE(PG8_SA(0, 1), cA + hsA, voffA);
    if (wr == 1) PG8_BAR;
    PG8_WAIT_V(2); PG8_BAR;
    PG8_STAGE(PG8_SB(1, 0), cB + kstep, voffB); PG8_STAGE(PG8_SA(1, 0), cA + kstep, voffA); PG8_STAGE(PG8_SB(1, 1), cB + hsB + kstep, voffB);
    PG8_WAIT_V(6); PG8_BAR; }
    for (;;) {
        const bool has_next = S.next(ui + 1, nxt);
        const char* nA = cA; const char* nB = cB; int nk = ck;
        if (has_next) { nA = MF_ABASE(nxt); nB = MF_BBASE(nxt); nk = nxt.kind; }
        const int nt = ck ? nt1 : nt0;
        for (int t = 0; t < nt; t += 2) {
            const bool last = (t == nt - 2);
            const int kx = last ? nk : ck;
            const unsigned la1 = MF_LA(ck), lax = MF_LA(kx), lbx = MF_LB(kx);
            unsigned voffA1[2] = {Ra0 * la1 + C2, Ra0 * la1 + C2 + 64u * la1};
            unsigned voffA[2] = {Ra0 * lax + C2, Ra0 * lax + C2 + 64u * lax};
            unsigned voffB[2] = {Rb0 * lbx + C2, Rb0 * lbx + C2 + 64u * lbx};
            const size_t hsA1 = (size_t)128 * la1, hsA = (size_t)128 * lax, hsB = (size_t)128 * lbx;
            const char* a1 = cA + (size_t)(t + 1) * kstep;
            const char* a2 = last ? nA : cA + (size_t)(t + 2) * kstep; const char* b2 = last ? nB : cB + (size_t)(t + 2) * kstep;
            const char* a3 = a2 + kstep; const char* b3 = b2 + kstep;
            PG8_LDB(B0, 0, 0); PG8_LDB(B1, 0, 1); PG8_SCHED; PG8_LDA(At, 0, 0); PG8_STAGE(PG8_SA(1, 1), a1 + hsA1, voffA1);
            PG8_WAIT_V(8); PG8_WAIT_L(0); PG8_BAR; PG8_MMA(0, 0, At, B0); PG8_MMA(0, 1, At, B1); PG8_BAR; PG8_SCHED;
            PG8_LDA(At, 0, 1); PG8_STAGE(PG8_SB(0, 0), b2, voffB); PG8_STAGE(PG8_SB(0, 1), b2 + hsB, voffB); PG8_STAGE(PG8_SA(0, 0), a2, voffA);
            PG8_WAIT_V(8); PG8_WAIT_L(0); PG8_BAR; PG8_MMA(1, 0, At, B0); PG8_MMA(1, 1, At, B1); PG8_BAR; PG8_SCHED;
            PG8_LDB(B0, 1, 0); PG8_LDB(B1, 1, 1); PG8_SCHED; PG8_LDA(At, 1, 0); PG8_STAGE(PG8_SA(0, 1), a2 + hsA, voffA);
            PG8_WAIT_V(8); PG8_WAIT_L(0); PG8_BAR; PG8_MMA(0, 0, At, B0); PG8_MMA(0, 1, At, B1); PG8_BAR; PG8_SCHED;
            PG8_LDA(At, 1, 1); PG8_STAGE(PG8_SB(1, 0), b3, voffB); PG8_STAGE(PG8_SB(1, 1), b3 + hsB, voffB); PG8_STAGE(PG8_SA(1, 0), a3, voffA);
            PG8_WAIT_V(8); PG8_WAIT_L(0); PG8_BAR; PG8_MMA(1, 0, At, B0); PG8_MMA(1, 1, At, B1); PG8_BAR; PG8_SCHED;
        }
        if (wr == 0) PG8_BAR;
        cur.ui = ui; E(acc, cur, wr, wc, fr, fq);
        if (!has_next) break;
#pragma unroll
        for (int a = 0; a < 2; ++a)
#pragma unroll
            for (int b = 0; b < 2; ++b)
#pragma unroll
                for (int m = 0; m < 4; ++m)
#pragma unroll
                    for (int n = 0; n < 2; ++n) acc[a][b][m][n] = (f32x4){0.f, 0.f, 0.f, 0.f};
        cur = nxt; cA = nA; cB = nB; ck = nk; ++ui;
        if (wr == 1) PG8_BAR;
    }
    PG8_WAIT_V(0);
    PG8_BAR;
#undef MF_ABASE
#undef MF_BBASE
#undef MF_LA
#undef MF_LB
#undef PG8_SA
#undef PG8_SB
#undef PG8_STAGE
#undef PG8_LDA
#undef PG8_LDB
#undef PG8_MMA
#undef PG8_WAIT_V
#undef PG8_WAIT_L
#undef PG8_BAR
#undef PG8_SCHED
}

#define EPI_ROWS_BEGIN _Pragma("unroll") for (int ai = 0; ai < 2; ++ai) _Pragma("unroll") for (int m = 0; m < 4; ++m) { const int row = u.pm * 256 + ai * 128 + wr * 64 + m * 16 + fr;
#define EPI_ROWS_END if (m & 1) asm volatile("" ::: "memory"); }
typedef const f32x4 (&AccRef)[2][2][4][2];

struct EpiInproj {
    bf16_t *u1, *ua, *ub; const LAS unsigned char* lds_rs;
    __device__ __forceinline__ void operator()(AccRef acc, const Unit& u, int wr, int wc, int fr, int fq) const {
        bf16_t* base; int ld, ct; const int pn = u.pn;
        if (pn < 4) { base = u1; ld = 1024; ct = pn; } else if (pn < 7) { base = ua; ld = 768; ct = pn - 4; } else { base = ub; ld = 1792; ct = pn - 7; }
        const int col0 = ct * 256 + wc * 32 + 8 * fq;
        EPI_ROWS_BEGIN
            const float r = RSL(u, row);
#pragma unroll
            for (int bj = 0; bj < 2; ++bj) *(u32x4*)(base + (size_t)row * ld + col0 + bj * 128) = pack8(acc[ai][bj][m][0] * r, acc[ai][bj][m][1] * r);
        EPI_ROWS_END
    }
};
struct EpiQ {
    bf16_t *y, *qr; const float* rsq; const f32x2* cs;
    __device__ __forceinline__ void operator()(AccRef acc, const Unit& u, int wr, int wc, int fr, int fq) const {
        const int pn = u.pn;
        EPI_ROWS_BEGIN
            const float r = rsq[row] * QSCALE;
#pragma unroll
            for (int bj = 0; bj < 2; ++bj) {
                f32x4 v0 = acc[ai][bj][m][0] * r, v1 = acc[ai][bj][m][1] * r;
                if (pn < 2) { *(u32x4*)(y + (size_t)row * 2048 + pn * 256 + bj * 128 + wc * 32 + 8 * fq) = pack8(v0, v1); }
                else {
                    const int c0 = bj * 128 + wc * 32 + 8 * fq, i0 = (c0 & 31) >> 1;
                    const f32x4* cp = (const f32x4*)(cs + (size_t)row * 16 + i0);
                    const f32x4 t0 = cp[0], t1 = cp[1];
                    f32x4 o0, o1;
                    o0[0] = v0[0] * t0[0] - v0[1] * t0[1]; o0[1] = v0[1] * t0[0] + v0[0] * t0[1];
                    o0[2] = v0[2] * t0[2] - v0[3] * t0[3]; o0[3] = v0[3] * t0[2] + v0[2] * t0[3];
                    o1[0] = v1[0] * t1[0] - v1[1] * t1[1]; o1[1] = v1[1] * t1[0] + v1[0] * t1[1];
                    o1[2] = v1[2] * t1[2] - v1[3] * t1[3]; o1[3] = v1[3] * t1[2] + v1[2] * t1[3];
                    *(u32x4*)(qr + (size_t)row * 256 + c0) = pack8(o0, o1);
                }
            }
        EPI_ROWS_END
    }
};
struct EpiRowScale {
    bf16_t* o0; int ld; const float* rs; size_t split;
    __device__ __forceinline__ void operator()(AccRef acc, const Unit& u, int wr, int wc, int fr, int fq) const {
        bf16_t* o = split ? o0 + (size_t)(u.pn >> 2) * split : o0;
        const int col0 = (split ? (u.pn & 3) : u.pn) * 256 + wc * 32 + 8 * fq;
        EPI_ROWS_BEGIN
            const float r = rs ? rs[row] : 1.f;
#pragma unroll
            for (int bj = 0; bj < 2; ++bj) *(u32x4*)(o + (size_t)row * ld + col0 + bj * 128) = pack8(acc[ai][bj][m][0] * r, acc[ai][bj][m][1] * r);
        EPI_ROWS_END
    }
};
struct EpiLru {
    bf16_t* y3; bf16_t* la; const float *b_a, *b_i, *lam;
    __device__ __forceinline__ void operator()(AccRef acc, const Unit& u, int wr, int wc, int fr, int fq) const {
#pragma unroll
        for (int n = 0; n < 2; ++n) {
            const int ch0 = u.pn * 128 + wc * 32 + 8 * fq + 4 * n;
            const f32x4 ba = *(const f32x4*)(b_a + ch0), bi = *(const f32x4*)(b_i + ch0), lm = *(const f32x4*)(lam + ch0);
            f32x4 sp;
#pragma unroll
            for (int e = 0; e < 4; ++e) sp[e] = -8.f * log1pf(__expf(-lm[e]));
            EPI_ROWS_BEGIN
                bf16_t* xp = y3 + (size_t)row * 2048 + ch0;
                const u32x2 xw = *(const u32x2*)xp;
                const f32x4 xc = (f32x4){bflo(xw.x), bfhi(xw.x), bflo(xw.y), bfhi(xw.y)};
                f32x4 uo, lo;
#pragma unroll
                for (int e = 0; e < 4; ++e) {
                    const float rr = acc[ai][0][m][n][e] + ba[e], ii = acc[ai][1][m][n][e] + bi[e];
                    const float log_a = sp[e] * sigmoidf_(rr);
                    const float mult = sqrtf(one_minus_exp(2.f * log_a));
                    uo[e] = xc[e] * sigmoidf_(ii) * mult; lo[e] = log_a;
                }
                u32x2 w0, w1; w0.x = cvt_pk_bf16(uo[0], uo[1]); w0.y = cvt_pk_bf16(uo[2], uo[3]); w1.x = cvt_pk_bf16(lo[0], lo[1]); w1.y = cvt_pk_bf16(lo[2], lo[3]);
                *(u32x2*)xp = w0;
                *(u32x2*)(la + (size_t)row * 512 + ch0) = w1;
                asm volatile("" ::: "memory");
            EPI_ROWS_END
        }
    }
};
struct EpiGate {
    const LAS unsigned char* lds_rs; const bf16_t* tall; bf16_t* mb; const float* rsc;
    __device__ __forceinline__ void operator()(AccRef acc, const Unit& u, int wr, int wc, int fr, int fq) const {
        const int n = u.pn >> 2; const bf16_t* tn = tall + (size_t)n * 64 * MiB / 2; const float* trs = (n == 2) ? rsc : nullptr;
        const int col0 = (u.pn & 3) * 256 + wc * 32 + 8 * fq;
        u32x4 tq[2][4][2];
#pragma unroll
        for (int ai = 0; ai < 2; ++ai)
#pragma unroll
            for (int m = 0; m < 4; ++m)
#pragma unroll
                for (int bj = 0; bj < 2; ++bj) tq[ai][m][bj] = *(const u32x4*)(tn + (size_t)(u.pm * 256 + ai * 128 + wr * 64 + m * 16 + fr) * 1024 + col0 + bj * 128);
        EPI_ROWS_BEGIN
            const float r = RSL(u, row); const float ts = trs ? trs[row] : 1.f;
#pragma unroll
            for (int bj = 0; bj < 2; ++bj) {
                const size_t off = (size_t)row * 1024 + col0 + bj * 128;
                f32x4 t0, t1; unpack8(tq[ai][m][bj], t0, t1); t0 = t0 * ts; t1 = t1 * ts;
                f32x4 g0 = acc[ai][bj][m][0] * r, g1 = acc[ai][bj][m][1] * r;
#pragma unroll
                for (int e = 0; e < 4; ++e) { g0[e] = sigmoidf_(g0[e]) * t0[e]; g1[e] = sigmoidf_(g1[e]) * t1[e]; }
                if (n > 0) { f32x4 p0, p1; unpack8(*(const u32x4*)(mb + off), p0, p1); g0 += p0; g1 += p1; }
                *(u32x4*)(mb + off) = pack8(g0, g1);
            }
        EPI_ROWS_END
    }
};
struct EpiMerge {
    const LAS unsigned char* lds_rs; bf16_t* tall; bf16_t* mb;
    __device__ __forceinline__ void operator()(AccRef acc, const MUnit& u, int wr, int wc, int fr, int fq) const {
        const int n = u.n; bf16_t* tn = tall;
        const int col0 = u.pn * 256 + wc * 32 + 8 * fq;
        if (u.kind == 0) {
            EPI_ROWS_BEGIN
#pragma unroll
                for (int bj = 0; bj < 2; ++bj) *(u32x4*)(tn + (size_t)row * 1024 + col0 + bj * 128) = pack8(acc[ai][bj][m][0], acc[ai][bj][m][1]);
            EPI_ROWS_END
        } else {
            const LAS float* rsl = (const LAS float*)(lds_rs + RSL_OFF) + (u.ui >> 3) * 256;
            u32x4 tq[2][4][2];
#pragma unroll
            for (int ai = 0; ai < 2; ++ai)
#pragma unroll
                for (int m = 0; m < 4; ++m)
#pragma unroll
                    for (int bj = 0; bj < 2; ++bj) tq[ai][m][bj] = *(const u32x4*)(tn + (size_t)(u.pm * 256 + ai * 128 + wr * 64 + m * 16 + fr) * 1024 + col0 + bj * 128);
            EPI_ROWS_BEGIN
                const float r = rsl[row & 255]; const float ts = (n == 2) ? rsl[1024 + (row & 255)] : 1.f;
#pragma unroll
                for (int bj = 0; bj < 2; ++bj) {
                    const size_t off = (size_t)row * 1024 + col0 + bj * 128;
                    f32x4 t0, t1; unpack8(tq[ai][m][bj], t0, t1); t0 = t0 * ts; t1 = t1 * ts;
                    f32x4 g0 = acc[ai][bj][m][0] * r, g1 = acc[ai][bj][m][1] * r;
#pragma unroll
                    for (int e = 0; e < 4; ++e) { g0[e] = sigmoidf_(g0[e]) * t0[e]; g1[e] = sigmoidf_(g1[e]) * t1[e]; }
                    if (n > 0) { f32x4 p0, p1; unpack8(*(const u32x4*)(mb + off), p0, p1); g0 += p0; g1 += p1; }
                    *(u32x4*)(mb + off) = pack8(g0, g1);
                }
            EPI_ROWS_END
        }
    }
};
__device__ __forceinline__ void merge_prepass(LAS unsigned char* lds, const float* ssq, const float* ssqc, const MergeOrder& S, int tid_) {
    asm volatile("" : "+v"(tid_));
    LAS float* rsl = (LAS float*)(lds + RSL_OFF); Unit t;
    const int ti = tid_ >> 8, rr = tid_ & 255;
    if (S.base.next(ti, t)) { const int row = t.pm * 256 + rr; rsl[ti * 256 + rr] = rstd16(ssq, row);
        const f32x4* p = (const f32x4*)(ssqc + (size_t)row * 16); const f32x4 a = p[0], b = p[1], c = p[2], d = p[3]; const f32x4 q = (a + b) + (c + d);
        rsl[1024 + ti * 256 + rr] = rsqrtf(((q[0] + q[1]) + (q[2] + q[3])) * (1.f / 512.f) + EPS); }
    __syncthreads();
}
template <int MODE  > struct EpiRes {
    const float* xold; float* xf; bf16_t* xb; float* ssq_out; const LAS unsigned char* lds_rs; const bf16_t* tp;
    __device__ __forceinline__ void operator()(AccRef acc, const Unit& u, int wr, int wc, int fr, int fq) const {
        const int col0 = u.pn * 256 + wc * 32 + 8 * fq;
        EPI_ROWS_BEGIN
            float r = 1.f; if (MODE == 1) r = RSL(u, row);
            float ss = 0.f;
#pragma unroll
            for (int bj = 0; bj < 2; ++bj) {
                const size_t off = (size_t)row * 1024 + col0 + bj * 128;
                f32x4 a0 = acc[ai][bj][m][0], a1 = acc[ai][bj][m][1];
                if (MODE == 1) { f32x4 t0, t1; unpack8(*(const u32x4*)(tp + off), t0, t1);
#pragma unroll
                    for (int e = 0; e < 4; ++e) { a0[e] = sigmoidf_(a0[e] * r) * t0[e]; a1[e] = sigmoidf_(a1[e] * r) * t1[e]; } }
                const f32x4 n0 = *(const f32x4*)(xold + off) + a0, n1 = *(const f32x4*)(xold + off + 4) + a1;
                *(f32x4*)(xf + off) = n0; *(f32x4*)(xf + off + 4) = n1;
                if (MODE == 0) *(u32x4*)(xb + off) = pack8(n0, n1);
                ss += (n0[0] * n0[0] + n0[1] * n0[1]) + (n0[2] * n0[2] + n0[3] * n0[3]) + (n1[0] * n1[0] + n1[1] * n1[1]) + (n1[2] * n1[2] + n1[3] * n1[3]);
            }
            ss += __shfl_xor(ss, 16); ss = xhalf_sum(ss);
            if (fq == 0) ssq_out[(size_t)row * 16 + u.pn * 4 + wc] = ss;
        EPI_ROWS_END
    }
};
struct EpiFF1 {
    bf16_t* h; const LAS unsigned char* lds_rs;
    __device__ __forceinline__ void operator()(AccRef acc, const Unit& u, int wr, int wc, int fr, int fq) const {
        const int col0 = u.pn * 256 + wc * 32 + 8 * fq;
        EPI_ROWS_BEGIN
            const float r = RSL(u, row);
#pragma unroll
            for (int bj = 0; bj < 2; ++bj) {
                f32x4 a0 = acc[ai][bj][m][0] * r, a1 = acc[ai][bj][m][1] * r;
#pragma unroll
                for (int e = 0; e < 4; ++e) { const float p = fmaxf(a0[e], 0.f), q = fmaxf(a1[e], 0.f); a0[e] = p * p; a1[e] = q * q; }
                *(u32x4*)(h + (size_t)row * 4096 + col0 + bj * 128) = pack8(a0, a1);
            }
        EPI_ROWS_END
    }
};
}

__device__ __forceinline__ void conv_weights(PP P, int l, bf16_t* W, int tid_, int bid_, int ngt, LAS unsigned char* lds) {
    asm volatile("" : "+v"(tid_)); const int gt = bid_ * 512 + tid_;
    if (l == 0 && gt < 64) ((unsigned*)P->ws)[64 + gt] = 0u;
    const float* g_mix = P->in[3] + l * 1024; const float* w_in = P->in[4] + (size_t)l * 1024 * INC;
    const float* q_norm = P->in[5] + l * 384; const float* w_uq = P->in[6] + (size_t)l * 384 * 768;
    const float* kv_norm = P->in[7] + l * 256; const float* w_ukv = P->in[8] + (size_t)l * 256 * 1024;
    const float* w_pool = P->in[9] + (size_t)l * 4 * 128 * 128; const float* pool_scale = P->in[10] + l * 512;
    const float* ssd_norm = P->in[16] + l * 512;
    const float* w_a = P->in[19] + (size_t)l * 8 * 64 * 64; const float* w_i = P->in[21] + (size_t)l * 8 * 64 * 64;
    const float* w_branch = P->in[24] + (size_t)l * 4 * 512 * 1024; const float* w_out = P->in[25] + (size_t)l * 1024 * 1024;
    const float* g_mlp = P->in[26] + l * 1024; const float* w_ff1 = P->in[27] + (size_t)l * 1024 * 4096; const float* w_ff2 = P->in[28] + (size_t)l * 4096 * 1024;
    const float* g_ple = P->in[29] + l * 1024; const float* w_pg = P->in[30] + (size_t)l * 1024 * 1024; const float* w_ple = P->in[31] + (size_t)l * 256 * 1024;
    constexpr int TOTAL_ITEMS = (int)(W_TOTAL / 2048);
    const int wave_ = tid_ >> 6, lane = tid_ & 63;
    LAS float* scr = (LAS float*)(lds + wave_ * 8448);
    for (int item = bid_ * 8 + wave_; item < TOTAL_ITEMS; item += ngt / 64) {
        const long e = (long)item * 2048;
        int N, K; size_t base; int mat;
        if (e < (long)W_G) { mat = 0; base = W_IN; N = 3584; K = 1024; }
        else if (e < (long)W_UQ) { mat = 1; base = W_G; N = 4096; K = 1024; }
        else if (e < (long)W_UKV) { mat = 2; base = W_UQ; N = 768; K = 384; }
        else if (e < (long)W_POOL) { mat = 3; base = W_UKV; N = 1024; K = 256; }
        else if (e < (long)W_LRU) { mat = 4; base = W_POOL; N = 512; K = 256; }
        else if (e < (long)W_BR) { mat = 5; base = W_LRU; N = 1024; K = 128; }
        else if (e < (long)W_OUT) { mat = 6; base = W_BR; N = 4096; K = 512; }
        else if (e < (long)W_FF1) { mat = 7; base = W_OUT; N = 1024; K = 1024; }
        else if (e < (long)W_FF2) { mat = 8; base = W_FF1; N = 4096; K = 1024; }
        else if (e < (long)W_PG) { mat = 9; base = W_FF2; N = 1024; K = 4096; }
        else if (e < (long)W_PLE) { mat = 10; base = W_PG; N = 1024; K = 1024; }
        else { mat = 11; base = W_PLE; N = 1024; K = 256; }
        const int idx = item - (int)(base / 2048), nblk = N / 32, n0 = (idx % nblk) * 32, k0 = (idx / nblk) * 64;
        const int n = n0 + (lane & 31);
        const float* ptr = nullptr; int stride = 0; const float* gk = nullptr; float sn = 1.f; bool valid = true;
        switch (mat) {
        case 0: { int sc;
            if (n < 512) sc = 1184 + n; else if (n < 1024) sc = 2472 + (n - 512);
            else if (n < 1408) sc = n - 1024; else if (n < 1664) sc = 384 + (n - 1408); else if (n < 1696) sc = 640 + (n - 1664);
            else if (n < 1704) sc = 2464 + (n - 1696); else if (n < 1792) { sc = 0; valid = false; }
            else { const int q = n - 1792; if (q < 512) sc = 672 + q; else if (q < 1280) sc = 1696 + (q - 512); else sc = 2984 + (q - 1280); }
            ptr = w_in + (size_t)k0 * INC + sc; stride = INC; gk = g_mix + k0; } break;
        case 1: ptr = w_in + (size_t)k0 * INC + 3496 + n; stride = INC; gk = g_mix + k0; break;
        case 2: { int sc; if (n < 512) sc = (n >> 6) * 96 + (n & 63); else { const int q = n - 512, hd = q >> 5, jj = q & 31; sc = hd * 96 + 64 + (jj & 1) * 16 + (jj >> 1); }
            ptr = w_uq + (size_t)k0 * 768 + sc; stride = 768; gk = q_norm + k0; } break;
        case 3: { int sc; if (n < 512) sc = (n >> 6) * 128 + (n & 63); else { const int q = n - 512; sc = (q >> 6) * 128 + 64 + (q & 63); }
            ptr = w_ukv + (size_t)k0 * 1024 + sc; stride = 1024; gk = kv_norm + k0; } break;
        case 4: { const int g = n >> 7, j = n & 127, pn = n >> 8, gk_ = 2 * pn + (k0 >> 7), i0 = k0 & 127; valid = (gk_ == g);
            ptr = w_pool + (size_t)g * 16384 + i0 * 128 + j; stride = 128; sn = pool_scale[n]; } break;
        case 5: { const int pn = n >> 8, bj = (n & 255) >> 7, ch = 128 * pn + (n & 127), hb = ch >> 6, j = ch & 63, hbk = 2 * pn + (k0 >> 6), i0 = k0 & 63; valid = (hbk == hb);
            ptr = (bj ? w_i : w_a) + (size_t)hb * 4096 + i0 * 64 + j; stride = 64; } break;
        case 6: { const int br = n >> 10, nn = n & 1023; ptr = w_branch + (size_t)br * 512 * 1024 + (size_t)k0 * 1024 + nn; stride = 1024; if (br == 2) gk = ssd_norm + k0; } break;
        case 7: ptr = w_out + (size_t)k0 * 1024 + n; stride = 1024; break;
        case 8: ptr = w_ff1 + (size_t)k0 * 4096 + n; stride = 4096; gk = g_mlp + k0; break;
        case 9: ptr = w_ff2 + (size_t)k0 * 1024 + n; stride = 1024; break;
        case 10: ptr = w_pg + (size_t)k0 * 1024 + n; stride = 1024; gk = g_ple + k0; break;
        default: ptr = w_ple + (size_t)k0 * 1024 + n; stride = 1024; break;
        }
        const int kh = lane >> 5;
#pragma unroll 8
        for (int i = 0; i < 32; ++i) { const int kk = 2 * i + kh; float x = 0.f; if (valid) { x = ptr[(size_t)kk * stride] * sn; if (gk) x *= gk[kk]; } scr[kk * 33 + (lane & 31)] = x; }
        asm volatile("s_waitcnt lgkmcnt(0)" ::: "memory");
        const int c = lane & 7;
#pragma unroll
        for (int jj = 0; jj < 4; ++jj) { const int nn = (lane >> 3) + 8 * jj; const LAS float* sp_ = scr + (8 * c) * 33 + nn;
            u32x4 o; o.x = cvt_pk_bf16(sp_[0], sp_[33]); o.y = cvt_pk_bf16(sp_[66], sp_[99]); o.z = cvt_pk_bf16(sp_[132], sp_[165]); o.w = cvt_pk_bf16(sp_[198], sp_[231]);
            *(u32x4*)(W + base + (size_t)(n0 + nn) * K + k0 + 8 * c) = o; }
        asm volatile("s_waitcnt lgkmcnt(0)" ::: "memory");
    }
}

__device__ __forceinline__ void p0_rows(PP P, const float* x, bool first, bf16_t* XB, float* ssq, f32x2* CS, int gw, int ngw, int tid_) {
    asm volatile("" : "+v"(tid_)); const int lane = tid_ & 63;
    const int* pos = (const int*)P->in[2];
    for (int mb = gw; mb < M; mb += 4 * ngw) {
        f32x4 v[4][4];
#pragma unroll
        for (int u = 0; u < 4; ++u) { const f32x4* xr = (const f32x4*)(x + (size_t)(mb + u * ngw) * D) + lane;
#pragma unroll
            for (int j = 0; j < 4; ++j) v[u][j] = xr[64 * j]; }
#pragma unroll
        for (int u = 0; u < 4; ++u) { const int m = mb + u * ngw; u32x2* o = (u32x2*)(XB + (size_t)m * D) + lane; float s = 0.f;
#pragma unroll
            for (int j = 0; j < 4; ++j) { const f32x4 t = v[u][j]; s += (t[0] * t[0] + t[1] * t[1]) + (t[2] * t[2] + t[3] * t[3]); u32x2 w; w.x = cvt_pk_bf16(t[0], t[1]); w.y = cvt_pk_bf16(t[2], t[3]); o[64 * j] = w; }
            if (first) {
                s = wave_sum(s);
                if (lane < 16) {
                    ssq[(size_t)m * 16 + lane] = (lane == 0) ? s : 0.f;
                    const double ang = (double)pos[m] * P->inv_freq[lane];
                    const double k = rint(ang * 0.15915494309189535);
                    const float r = (float)(ang - k * 6.283185307179586);
                    f32x2 cs_; cs_[0] = cosf(r); cs_[1] = sinf(r);
                    CS[(size_t)m * 16 + lane] = cs_;
                }
            }
        }
    }
}

__device__ __forceinline__ void p2_pool_block(const bf16_t* UB, bf16_t* Y, int m0, int lane) {
    const int g = lane >> 4, w = 2 << g, t0 = m0 & (SEQ - 1);
    const bf16_t* base = UB + (size_t)m0 * 1792 + lane * 8;
    bf16_t* ob = Y + (size_t)m0 * 2048 + 512 + lane * 8;
    u32x4 prev[16];
#pragma unroll
    for (int j = 0; j < 16; ++j) { prev[j] = (u32x4){0u, 0u, 0u, 0u}; if (t0 > 0) prev[j] = *(const u32x4*)(base - (size_t)(16 - j) * 1792); }
    f32x4 s0 = {0.f, 0.f, 0.f, 0.f}, s1 = {0.f, 0.f, 0.f, 0.f};
#pragma unroll
    for (int j = 0; j < 16; ++j) { f32x4 a, b; unpack8(prev[j], a, b); const float mk = (16 - j <= w) ? 1.f : 0.f; s0 += a * mk; s1 += b * mk; }
    for (int bt = 0; bt < 4; ++bt) {
        u32x4 cur[16];
#pragma unroll
        for (int j = 0; j < 16; ++j) cur[j] = *(const u32x4*)(base + (size_t)(bt * 16 + j) * 1792);
#pragma unroll
        for (int j = 0; j < 16; ++j) {
            const u32x4 o2 = (j >= 2) ? cur[j >= 2 ? j - 2 : 0] : prev[14 + j < 16 ? 14 + j : 15];
            const u32x4 o4 = (j >= 4) ? cur[j >= 4 ? j - 4 : 0] : prev[12 + j < 16 ? 12 + j : 15];
            const u32x4 o8 = (j >= 8) ? cur[j >= 8 ? j - 8 : 0] : prev[8 + j < 16 ? 8 + j : 15];
            const u32x4 o16 = prev[j];
            u32x4 os;
            os.x = g == 0 ? o2.x : g == 1 ? o4.x : g == 2 ? o8.x : o16.x; os.y = g == 0 ? o2.y : g == 1 ? o4.y : g == 2 ? o8.y : o16.y;
            os.z = g == 0 ? o2.z : g == 1 ? o4.z : g == 2 ? o8.z : o16.z; os.w = g == 0 ? o2.w : g == 1 ? o4.w : g == 2 ? o8.w : o16.w;
            f32x4 c0, c1, q0, q1; unpack8(cur[j], c0, c1); unpack8(os, q0, q1);
            s0 += c0 - q0; s1 += c1 - q1;
            const int t = t0 + bt * 16 + j; const int cnt = (t + 1) < w ? (t + 1) : w; const float inv = __builtin_amdgcn_rcpf((float)cnt);
            *(u32x4*)(ob + (size_t)(bt * 16 + j) * 2048) = pack8(s0 * inv - c0, s1 * inv - c1);
        }
#pragma unroll
        for (int j = 0; j < 16; ++j) prev[j] = cur[j];
    }
}
__device__ __forceinline__ void p2_conv_block(const bf16_t* src, int m0, bool active, const float* wgt, int wp, const float* bias, bool silu, bf16_t* out, int opitch) {
    if (!active) return;
    const int t0 = m0 & (SEQ - 1);
    const bf16_t* base = src + (size_t)m0 * 1792; bf16_t* ob = out + (size_t)m0 * opitch;
    f32x4 w0[4], w1[4];
#pragma unroll
    for (int k = 0; k < 4; ++k) { w0[k] = *(const f32x4*)(wgt + k * wp); w1[k] = *(const f32x4*)(wgt + k * wp + 4); }
    const f32x4 b0 = *(const f32x4*)bias, b1 = *(const f32x4*)(bias + 4);
    u32x4 p3[3];
#pragma unroll
    for (int j = 0; j < 3; ++j) { p3[j] = (u32x4){0u, 0u, 0u, 0u}; if (t0 > 0) p3[j] = *(const u32x4*)(base - (size_t)(3 - j) * 1792); }
    for (int bt = 0; bt < 4; ++bt) {
        u32x4 cur[16];
#pragma unroll
        for (int j = 0; j < 16; ++j) cur[j] = *(const u32x4*)(base + (size_t)(bt * 16 + j) * 1792);
#pragma unroll
        for (int j = 0; j < 16; ++j) {
            f32x4 a0 = b0, a1 = b1;
#pragma unroll
            for (int k = 0; k < 4; ++k) { const int jj = j - 3 + k; const u32x4 rw = (jj >= 0) ? cur[jj >= 0 ? jj : 0] : p3[jj < 0 ? 3 + jj : 0];
                f32x4 x0, x1; unpack8(rw, x0, x1); a0 += x0 * w0[k]; a1 += x1 * w1[k]; }
            if (silu) {
#pragma unroll
                for (int e = 0; e < 4; ++e) { a0[e] = a0[e] * sigmoidf_(a0[e]); a1[e] = a1[e] * sigmoidf_(a1[e]); } }
            *(u32x4*)(ob + (size_t)(bt * 16 + j) * opitch) = pack8(a0, a1);
        }
        p3[0] = cur[13]; p3[1] = cur[14]; p3[2] = cur[15];
    }
}
__device__ __forceinline__ void p2_prep(PP P, int l, unsigned char* ws, int gw, int ngw, int tid_) {
    asm volatile("" : "+v"(tid_)); const int lane = tid_ & 63;
    const bf16_t* UA = (const bf16_t*)(ws + B_UA); const bf16_t* UB = (const bf16_t*)(ws + B_UB);
    bf16_t* Y = (bf16_t*)(ws + WS_Y); bf16_t* BC = (bf16_t*)(ws + B_BC); bf16_t* KR = (bf16_t*)(ws + B_KR);
    float* RSQ = (float*)(ws + WS_RSQ); float* RSKV = (float*)(ws + WS_RSKV); float* DTF = (float*)(ws + WS_DTF); const f32x2* CS = (const f32x2*)(ws + WS_CS);
    const float* scw = P->in[11] + l * 4 * 768; const float* scb = P->in[12] + l * 768; const float* dtb = P->in[13] + l * 8;
    const float* lcw = P->in[17] + l * 4 * 512; const float* lcb = P->in[18] + l * 512;
    for (int mb = gw; mb < M; mb += 4 * ngw) {
        u32x4 q4[4], k4[4]; float x1[4], x2[4], dtr[4]; f32x2 cc[4];
#pragma unroll
        for (int u = 0; u < 4; ++u) { const int m = M - 1 - (mb + u * ngw); const bf16_t* ua = UA + (size_t)m * 768;
            q4[u] = (u32x4){0u, 0u, 0u, 0u}; k4[u] = (u32x4){0u, 0u, 0u, 0u}; x1[u] = 0.f; x2[u] = 0.f; dtr[u] = 0.f; cc[u] = (f32x2){0.f, 0.f};
            if (lane < 48) q4[u] = *(const u32x4*)(ua + lane * 8);
            if (lane < 32) k4[u] = *(const u32x4*)(ua + 384 + lane * 8);
            if (lane < 16) { x1[u] = bf2f(ua[640 + lane]); x2[u] = bf2f(ua[656 + lane]); cc[u] = CS[(size_t)m * 16 + lane]; }
            if (lane < 8) dtr[u] = bf2f(ua[672 + lane]); }
#pragma unroll
        for (int u = 0; u < 4; ++u) { const int m = M - 1 - (mb + u * ngw);
            f32x4 a, b; unpack8(q4[u], a, b); float s = (a[0]*a[0]+a[1]*a[1])+(a[2]*a[2]+a[3]*a[3])+(b[0]*b[0]+b[1]*b[1])+(b[2]*b[2]+b[3]*b[3]);
            unpack8(k4[u], a, b); float s2 = (a[0]*a[0]+a[1]*a[1])+(a[2]*a[2]+a[3]*a[3])+(b[0]*b[0]+b[1]*b[1])+(b[2]*b[2]+b[3]*b[3]);
            s = wave_sum(s); s2 = wave_sum(s2);
            if (lane == 0) { RSQ[m] = rsqrtf(s * (1.f / 384.f) + EPS); RSKV[m] = rsqrtf(s2 * (1.f / 256.f) + EPS); }
            if (lane < 16) *(unsigned*)(KR + (size_t)m * 32 + 2 * lane) = cvt_pk_bf16(x1[u] * cc[u][0] - x2[u] * cc[u][1], x2[u] * cc[u][0] + x1[u] * cc[u][1]);
            if (lane < 8) { const float v = dtr[u] + dtb[lane]; DTF[(size_t)m * 8 + lane] = v > 20.f ? v : log1pf(__expf(v)); } }
    }
    for (int wt = gw; wt < 2048; wt += ngw) {
        const int rb = 511 - (wt >> 2), cgp = wt & 3, m0 = rb * 64;
        if (cgp == 0) p2_pool_block(UB, Y, m0, lane);
        else if (cgp == 1) p2_conv_block(UB + 512 + 8 * lane, m0, true, scw + 8 * lane, 768, scb + 8 * lane, true, Y + 1024 + 8 * lane, 2048);
        else if (cgp == 2) p2_conv_block(UB + 1024 + 8 * (lane & 31), m0, lane < 32, scw + 512 + 8 * (lane & 31), 768, scb + 512 + 8 * (lane & 31), true, BC + 8 * (lane & 31), 256);
        else p2_conv_block(UB + 1280 + 8 * lane, m0, true, lcw + 8 * lane, 512, lcb + 8 * lane, false, Y + 1536 + 8 * lane, 2048);
    }
}

__device__ __forceinline__ void rstd_c_rows(unsigned char* ws, int gw, int ngw, int tid_) {
    asm volatile("" : "+v"(tid_)); const int lane = tid_ & 63;
    const bf16_t* Y = (const bf16_t*)(ws + WS_Y); float* RSC = (float*)(ws + WS_RSC);
    for (int m = gw; m < M; m += ngw) { f32x4 a, b; unpack8(*(const u32x4*)(Y + (size_t)m * 2048 + 1024 + lane * 8), a, b);
        float s = (a[0]*a[0]+a[1]*a[1])+(a[2]*a[2]+a[3]*a[3])+(b[0]*b[0]+b[1]*b[1])+(b[2]*b[2]+b[3]*b[3]); s = wave_sum(s);
        if (lane == 0) RSC[m] = rsqrtf(s * (1.f / 512.f) + EPS); }
}
__device__ __forceinline__ void conv_p(PP P, int l, bf16_t* PB, int tid_, int bid_, int ngt) {
    asm volatile("" : "+v"(tid_)); const int gt = bid_ * 512 + tid_;
    const f32x4* src = (const f32x4*)(P->in[1] + (size_t)l * M * 256);
    for (long c = gt; c < (long)M * 256 / 8; c += ngt) { const f32x4 a = src[2 * c], b = src[2 * c + 1]; *(u32x4*)(PB + c * 8) = pack8(a, b); }
}
__device__ __forceinline__ void final_norm(PP P, const float* ssq, int gw, int ngw, int tid_) {
    asm volatile("" : "+v"(tid_)); const int lane = tid_ & 63;
    const f32x4* gf = (const f32x4*)P->in[32];
    f32x4 g4[4];
#pragma unroll
    for (int j = 0; j < 4; ++j) g4[j] = gf[64 * j + lane];
    for (int mb = gw; mb < M; mb += 4 * ngw) {
        f32x4 v[4][4]; float r[4];
#pragma unroll
        for (int u = 0; u < 4; ++u) { const int m = mb + u * ngw; r[u] = 0.f;
            if (m < M) { const f32x4* xr = (const f32x4*)(P->out + (size_t)m * D) + lane; r[u] = rstd16(ssq, m);
#pragma unroll
                for (int j = 0; j < 4; ++j) v[u][j] = xr[64 * j]; } }
#pragma unroll
        for (int u = 0; u < 4; ++u) { const int m = mb + u * ngw;
            if (m < M) { f32x4* xr = (f32x4*)(P->out + (size_t)m * D) + lane;
#pragma unroll
                for (int j = 0; j < 4; ++j) xr[64 * j] = v[u][j] * r[u] * g4[j]; } }
    }
}


typedef float f32x16 __attribute__((ext_vector_type(16)));
__device__ __forceinline__ unsigned pk2c(float lo, float hi) { f32x2 v = {lo, hi}; bf16x2_t b = __builtin_convertvector(v, bf16x2_t); return __builtin_bit_cast(unsigned, b); }
constexpr int AT_KP = 208, AT_VP = 192, AT_KB = 64 * AT_KP, AT_VB = 64 * AT_VP, AT_BUF = AT_KB + AT_VB;
typedef short v4i16_t __attribute__((ext_vector_type(4)));
__device__ __forceinline__ void attn_unit(unsigned char* ws, LAS unsigned char* lds, int b, int h, int qb, int wave, int tid_, bf16_t* Obase, int opitch) {
    asm volatile("" : "+v"(tid_));
    const int lane = tid_ & 63, r = lane & 31, hh = lane >> 5;
    bf16_t* Y = (bf16_t*)(ws + WS_Y); const bf16_t* QR = (const bf16_t*)(ws + B_QR); const bf16_t* KV = (const bf16_t*)(ws + B_KV); const bf16_t* KR = (const bf16_t*)(ws + B_KR);
    const int q0 = qb * 256, qw0 = q0 + wave * 32;
    const size_t mrow = (size_t)b * SEQ + qw0 + r;
    bf16x8 qf[6];
#pragma unroll
    for (int ks = 0; ks < 4; ++ks) qf[ks] = *(const bf16x8*)(Y + mrow * 2048 + h * 64 + 16 * ks + 8 * hh);
#pragma unroll
    for (int ks = 0; ks < 2; ++ks) qf[4 + ks] = *(const bf16x8*)(QR + mrow * 256 + h * 32 + 16 * ks + 8 * hh);
    f32x16 o0, o1;
#pragma unroll
    for (int i = 0; i < 16; ++i) { o0[i] = 0.f; o1[i] = 0.f; }
    float mx = -1e30f, lsum = 0.f;
    const int nkt = (q0 + 256) / 64;
    const int skv = tid_ >> 3, sc = tid_ & 7;
    const int rkv = tid_ >> 2, rc = tid_ & 3;
    const bf16_t* gk = KV + ((size_t)b * SEQ + skv) * 1024 + h * 64 + sc * 8;
    const bf16_t* gv = gk + 512;
    const bf16_t* gr = KR + ((size_t)b * SEQ + rkv) * 32 + rc * 8;
    u32x4 rk, rv, rr;
    rk = *(const u32x4*)gk; rv = *(const u32x4*)gv; if (tid_ < 256) rr = *(const u32x4*)gr;
    __syncthreads();
    {
        LAS unsigned char* kb = lds; LAS unsigned char* vb = lds + AT_KB;
        *(LAS u32x4*)(kb + skv * AT_KP + sc * 16) = rk;
        if (tid_ < 256) *(LAS u32x4*)(kb + rkv * AT_KP + 128 + rc * 16) = rr;
        *(LAS u32x4*)(vb + skv * AT_VP + sc * 16) = rv;
    }
    __syncthreads();
    for (int kt = 0; kt < nkt; ++kt) {
        const bool more = (kt + 1 < nkt);
        if (more) { const size_t adv = (size_t)(kt + 1) * 64;
            rk = *(const u32x4*)(gk + adv * 1024); rv = *(const u32x4*)(gv + adv * 1024); if (tid_ < 256) rr = *(const u32x4*)(gr + adv * 32); }
        LAS unsigned char* kb = lds + (kt & 1) * AT_BUF; LAS unsigned char* vb = kb + AT_KB;
        const int kv0 = kt * 64;
        if (kv0 <= qw0 + 31) {
            __builtin_amdgcn_iglp_opt(0);
            f32x16 p0, p1;
#pragma unroll
            for (int i = 0; i < 16; ++i) { p0[i] = 0.f; p1[i] = 0.f; }
            bf16x8 kf0[6], kf1[6];
#pragma unroll
            for (int ks = 0; ks < 6; ++ks) {
                kf0[ks] = *(const LAS bf16x8*)(kb + r * AT_KP + (16 * ks + 8 * hh) * 2);
                kf1[ks] = *(const LAS bf16x8*)(kb + (32 + r) * AT_KP + (16 * ks + 8 * hh) * 2);
            }
#pragma unroll
            for (int ks = 0; ks < 6; ++ks) {
                p0 = __builtin_amdgcn_mfma_f32_32x32x16_bf16(kf0[ks], qf[ks], p0, 0, 0, 0);
                p1 = __builtin_amdgcn_mfma_f32_32x32x16_bf16(kf1[ks], qf[ks], p1, 0, 0, 0);
            }
            if (kv0 + 63 > qw0) {
                const int qg = qw0 + r;
#pragma unroll
                for (int i = 0; i < 16; ++i) { const int kvl = kv0 + (i & 3) + 8 * (i >> 2) + 4 * hh; if (kvl > qg) p0[i] = -1e30f; if (kvl + 32 > qg) p1[i] = -1e30f; }
            }
            float tm = fmaxf(p0[0], p1[0]);
#pragma unroll
            for (int i = 1; i < 16; ++i) tm = fmaxf(tm, fmaxf(p0[i], p1[i]));
            tm = xhalf_max(tm);
            if (__any(tm > mx + 8.f)) {
                const float mn = fmaxf(mx, tm);
                const float alpha = __builtin_amdgcn_exp2f(mx - mn);
                mx = mn; lsum *= alpha;
#pragma unroll
                for (int i = 0; i < 16; ++i) { o0[i] *= alpha; o1[i] *= alpha; }
            }
            float ps = 0.f;
#pragma unroll
            for (int i = 0; i < 16; ++i) { p0[i] = __builtin_amdgcn_exp2f(p0[i] - mx); p1[i] = __builtin_amdgcn_exp2f(p1[i] - mx); ps += p0[i] + p1[i]; }
            lsum += ps;
            u32x4 vw0[4], vw1[4];
            {
                const int li = lane & 15, tq = li >> 2, tp = li & 3, dblk = (lane >> 4) & 1;
                const LAS unsigned char* vbase = vb + (4 * hh + tq) * AT_VP + (16 * dblk + 4 * tp) * 2;
#pragma unroll
                for (int f = 0; f < 4; ++f) {
                    const v4i16_t lo0 = __builtin_amdgcn_ds_read_tr16_b64_v4i16((LAS v4i16_t*)(vbase + (16 * f) * AT_VP));
                    const v4i16_t hi0 = __builtin_amdgcn_ds_read_tr16_b64_v4i16((LAS v4i16_t*)(vbase + (16 * f + 8) * AT_VP));
                    const v4i16_t lo1 = __builtin_amdgcn_ds_read_tr16_b64_v4i16((LAS v4i16_t*)(vbase + (16 * f) * AT_VP + 64));
                    const v4i16_t hi1 = __builtin_amdgcn_ds_read_tr16_b64_v4i16((LAS v4i16_t*)(vbase + (16 * f + 8) * AT_VP + 64));
                    const u32x2 a = __builtin_bit_cast(u32x2, lo0), b2 = __builtin_bit_cast(u32x2, hi0), c = __builtin_bit_cast(u32x2, lo1), d2 = __builtin_bit_cast(u32x2, hi1);
                    vw0[f].x = a.x; vw0[f].y = a.y; vw0[f].z = b2.x; vw0[f].w = b2.y; vw1[f].x = c.x; vw1[f].y = c.y; vw1[f].z = d2.x; vw1[f].w = d2.y;
                }
            }
            u32x4 pw[4];
#pragma unroll
            for (int s2 = 0; s2 < 2; ++s2) {
                pw[s2].x = pk2c(p0[8 * s2 + 0], p0[8 * s2 + 1]); pw[s2].y = pk2c(p0[8 * s2 + 2], p0[8 * s2 + 3]); pw[s2].z = pk2c(p0[8 * s2 + 4], p0[8 * s2 + 5]); pw[s2].w = pk2c(p0[8 * s2 + 6], p0[8 * s2 + 7]);
                pw[2 + s2].x = pk2c(p1[8 * s2 + 0], p1[8 * s2 + 1]); pw[2 + s2].y = pk2c(p1[8 * s2 + 2], p1[8 * s2 + 3]); pw[2 + s2].z = pk2c(p1[8 * s2 + 4], p1[8 * s2 + 5]); pw[2 + s2].w = pk2c(p1[8 * s2 + 6], p1[8 * s2 + 7]); }
#pragma unroll
            for (int f = 0; f < 4; ++f) {
                const bf16x8 pf = __builtin_bit_cast(bf16x8, pw[f]);
                o0 = __builtin_amdgcn_mfma_f32_32x32x16_bf16(__builtin_bit_cast(bf16x8, vw0[f]), pf, o0, 0, 0, 0);
                o1 = __builtin_amdgcn_mfma_f32_32x32x16_bf16(__builtin_bit_cast(bf16x8, vw1[f]), pf, o1, 0, 0, 0);
            }
        }
        if (more) {
            LAS unsigned char* kb2 = lds + ((kt + 1) & 1) * AT_BUF; LAS unsigned char* vb2 = kb2 + AT_KB;
            *(LAS u32x4*)(kb2 + skv * AT_KP + sc * 16) = rk;
            if (tid_ < 256) *(LAS u32x4*)(kb2 + rkv * AT_KP + 128 + rc * 16) = rr;
            *(LAS u32x4*)(vb2 + skv * AT_VP + sc * 16) = rv;
        }
        __syncthreads();
    }
    lsum = xhalf_sum(lsum);
    const float inv = 1.f / lsum;
    bf16_t* orow = Obase + mrow * opitch + h * 64;
#pragma unroll
    for (int g = 0; g < 4; ++g) {
        u32x2 w0, w1;
        w0.x = pk2c(o0[4 * g] * inv, o0[4 * g + 1] * inv); w0.y = pk2c(o0[4 * g + 2] * inv, o0[4 * g + 3] * inv);
        w1.x = pk2c(o1[4 * g] * inv, o1[4 * g + 1] * inv); w1.y = pk2c(o1[4 * g + 2] * inv, o1[4 * g + 3] * inv);
        *(u32x2*)(orow + 8 * g + 4 * hh) = w0;
        *(u32x2*)(orow + 32 + 8 * g + 4 * hh) = w1;
    }
}
__device__ __forceinline__ void attn_phase(unsigned char* ws, LAS unsigned char* lds, unsigned* ctr, int wave, int tid_, bf16_t* Obase, int opitch) {
    LAS unsigned* slot = (LAS unsigned*)(lds + 2 * AT_BUF + 64);
    for (;;) {
        if (tid_ == 0) *slot = atomicAdd(ctr, 1u);
        __syncthreads();
        const unsigned u = *slot;
        if (u >= 1024u) break;
        const int qb = 15 - (int)(u >> 6), bh = (int)(u & 63u);
        attn_unit(ws, lds, bh >> 3, bh & 7, qb, wave, tid_, Obase, opitch);
    }
}

constexpr int SD_CS = 0, SD_BS = 18432, SD_XT = 36864, SD_BDT = 62464, SD_MM = 79872, SD_F = 131072;
constexpr int SD_CP = 144, SD_XP = 400, SD_DP = 272, SD_MP = 400;
#define MFMA32(a, b, c) __builtin_amdgcn_mfma_f32_32x32x16_bf16((a), (b), (c), 0, 0, 0)
__device__ __forceinline__ void ssd_mfma(PP P, int l, unsigned char* ws, LAS unsigned char* lds, int unit, int wave, int tid_) {
    asm volatile("" : "+v"(tid_));
    const int lane = tid_ & 63, r = lane & 31, hh = lane >> 5;
    const int b = unit >> 3, h = unit & 7, g = h >> 2;
    bf16_t* Y = (bf16_t*)(ws + WS_Y); const bf16_t* BC = (const bf16_t*)(ws + B_BC); const bf16_t* U1 = (const bf16_t*)(ws + B_U1); const float* DTF = (const float*)(ws + WS_DTF);
    const float Ah = -__expf(P->in[14][l * 8 + h]); const float Dh = P->in[15][l * 8 + h];
    LAS float* F0 = (LAS float*)(lds + SD_F);
    for (int idx = tid_; idx < 64 * 32; idx += 512) { const int p = idx >> 5, c = idx & 31; *(LAS unsigned*)(lds + SD_XT + p * SD_XP + 256 + c * 4) = 0u; }
    f32x16 S;
#pragma unroll
    for (int i = 0; i < 16; ++i) S[i] = 0.f;
    const int l_ = tid_ >> 2, qd = tid_ & 3;
    const size_t mb0 = (size_t)b * SEQ;
    u32x4 c0, c1, b0, b1, x0, x1;
#define SSD_LOAD(ck_) do { const size_t m_ = mb0 + (size_t)(ck_) * 128 + l_; \
        c0 = *(const u32x4*)(BC + m_ * 256 + 128 + g * 64 + 16 * qd); c1 = *(const u32x4*)(BC + m_ * 256 + 128 + g * 64 + 16 * qd + 8); \
        b0 = *(const u32x4*)(BC + m_ * 256 + g * 64 + 16 * qd); b1 = *(const u32x4*)(BC + m_ * 256 + g * 64 + 16 * qd + 8); \
        x0 = *(const u32x4*)(Y + m_ * 2048 + 1024 + h * 64 + 16 * qd); x1 = *(const u32x4*)(Y + m_ * 2048 + 1024 + h * 64 + 16 * qd + 8); } while (0)
#define SSD_FCALC(ck_) do { LAS float* F_ = F0 + ((ck_) & 1) * 512; const size_t m_ = mb0 + (size_t)(ck_) * 128; \
        const float d0 = DTF[(m_ + lane) * 8 + h], d1 = DTF[(m_ + 64 + lane) * 8 + h]; float s0 = d0 * Ah, s1 = d1 * Ah; \
        _Pragma("unroll") for (int o = 1; o < 64; o <<= 1) { const float t0 = __shfl_up(s0, o), t1 = __shfl_up(s1, o); if (lane >= o) { s0 += t0; s1 += t1; } } \
        const float tot0 = __shfl(s0, 63); s1 += tot0; const float tot = __shfl(s1, 63); \
        F_[lane] = s0; F_[64 + lane] = s1; F_[128 + lane] = __expf(s0); F_[192 + lane] = __expf(s1); \
        F_[256 + lane] = __expf(tot - s0); F_[320 + lane] = __expf(tot - s1); F_[384 + lane] = d0; F_[448 + lane] = d1; } while (0)
#define SSD_STAGE(ck_) do { const LAS float* F_ = F0 + ((ck_) & 1) * 512; const float ea = F_[128 + l_], dec = F_[256 + l_], dt = F_[384 + l_]; \
        *(LAS u32x4*)(lds + SD_CS + l_ * SD_CP + qd * 32) = c0; *(LAS u32x4*)(lds + SD_CS + l_ * SD_CP + qd * 32 + 16) = c1; \
        *(LAS u32x4*)(lds + SD_BS + l_ * SD_CP + qd * 32) = b0; *(LAS u32x4*)(lds + SD_BS + l_ * SD_CP + qd * 32 + 16) = b1; \
        f32x4 ca, cb, cc, cd; unpack8(c0, ca, cb); unpack8(c1, cc, cd); \
        *(LAS u32x4*)(lds + SD_MM + l_ * SD_MP + 256 + qd * 32) = pack8(ca * ea, cb * ea); *(LAS u32x4*)(lds + SD_MM + l_ * SD_MP + 256 + qd * 32 + 16) = pack8(cc * ea, cd * ea); \
        f32x4 ba, bb, bc, bd; unpack8(b0, ba, bb); unpack8(b1, bc, bd); f32x4 xa, xb, xc, xd; unpack8(x0, xa, xb); unpack8(x1, xc, xd); \
        LAS unsigned short* bdt = (LAS unsigned short*)(lds + SD_BDT + (16 * qd) * SD_DP + l_ * 2); LAS unsigned short* xt = (LAS unsigned short*)(lds + SD_XT + (16 * qd) * SD_XP + l_ * 2); \
        _Pragma("unroll") for (int e = 0; e < 4; ++e) { \
            bdt[(e) * (SD_DP / 2)] = f2bf(ba[e] * dec); bdt[(4 + e) * (SD_DP / 2)] = f2bf(bb[e] * dec); bdt[(8 + e) * (SD_DP / 2)] = f2bf(bc[e] * dec); bdt[(12 + e) * (SD_DP / 2)] = f2bf(bd[e] * dec); \
            xt[(e) * (SD_XP / 2)] = f2bf(xa[e] * dt); xt[(4 + e) * (SD_XP / 2)] = f2bf(xb[e] * dt); xt[(8 + e) * (SD_XP / 2)] = f2bf(xc[e] * dt); xt[(12 + e) * (SD_XP / 2)] = f2bf(xd[e] * dt); } } while (0)
    SSD_LOAD(0);
    if (wave == 0) SSD_FCALC(0);
    __syncthreads();
    SSD_STAGE(0);
    SSD_LOAD(1);
    if (wave == 7) SSD_FCALC(1);
    __syncthreads();
    for (int ck = 0; ck < 32; ++ck) {
        const size_t m0 = mb0 + (size_t)ck * 128;
        const LAS float* F = F0 + (ck & 1) * 512;
        {
            const int lt = wave & 3;
#pragma unroll
            for (int sti = 0; sti < 2; ++sti) {
                const int st = 2 * (wave >> 2) + sti;
                if (st <= lt) {
                    f32x16 ga;
#pragma unroll
                    for (int i = 0; i < 16; ++i) ga[i] = 0.f;
#pragma unroll
                    for (int ks = 0; ks < 4; ++ks) {
                        const bf16x8 a = *(const LAS bf16x8*)(lds + SD_CS + (32 * lt + r) * SD_CP + 32 * ks + 16 * hh);
                        const bf16x8 bq = *(const LAS bf16x8*)(lds + SD_BS + (32 * st + r) * SD_CP + 32 * ks + 16 * hh);
                        ga = MFMA32(a, bq, ga);
                    }
                    const int sg = 32 * st + r; const float acs_s = F[sg];
#pragma unroll
                    for (int i = 0; i < 16; ++i) { const int lg = 32 * lt + (i & 3) + 8 * (i >> 2) + 4 * hh;
                        const float v = (sg <= lg) ? ga[i] * __expf(F[lg] - acs_s) : 0.f;
                        *(LAS unsigned short*)(lds + SD_MM + lg * SD_MP + sg * 2) = f2bf(v); }
                }
            }
        }
        __syncthreads();
        {
            const int lt = wave >> 1, pt = wave & 1;
            const size_t m = m0 + 32 * lt + r;
            bf16_t* yrow = Y + m * 2048 + 1024 + h * 64 + 32 * pt + 4 * hh; const bf16_t* zrow = U1 + m * 1024 + h * 64 + 32 * pt + 4 * hh;
            u32x2 xs4[4], z4[4]; float ssl = 0.f;
#pragma unroll
            for (int g4 = 0; g4 < 4; ++g4) { xs4[g4] = *(const u32x2*)(yrow + 8 * g4); z4[g4] = *(const u32x2*)(zrow + 8 * g4); }
            f32x16 ya;
#pragma unroll
            for (int i = 0; i < 16; ++i) ya[i] = 0.f;
            const LAS unsigned char* bp = lds + SD_MM + (32 * lt + r) * SD_MP + 16 * hh;
            const LAS unsigned char* ap = lds + SD_XT + (32 * pt + r) * SD_XP + 16 * hh;
            const int nks = 2 * (lt + 1);
            for (int ks = 0; ks < nks; ++ks) ya = MFMA32(*(const LAS bf16x8*)(ap + 32 * ks), *(const LAS bf16x8*)(bp + 32 * ks), ya);
#pragma unroll
            for (int ks = 8; ks < 12; ++ks) ya = MFMA32(*(const LAS bf16x8*)(ap + 32 * ks), *(const LAS bf16x8*)(bp + 32 * ks), ya);
#pragma unroll
            for (int g4 = 0; g4 < 4; ++g4) {
                const float xv[4] = {bflo(xs4[g4].x), bfhi(xs4[g4].x), bflo(xs4[g4].y), bfhi(xs4[g4].y)};
                const float zv[4] = {bflo(z4[g4].x), bfhi(z4[g4].x), bflo(z4[g4].y), bfhi(z4[g4].y)};
                float o[4];
#pragma unroll
                for (int e = 0; e < 4; ++e) o[e] = (ya[4 * g4 + e] + xv[e] * Dh) * (zv[e] * sigmoidf_(zv[e]));
                u32x2 w; w.x = cvt_pk_bf16(o[0], o[1]); w.y = cvt_pk_bf16(o[2], o[3]);
                *(u32x2*)(yrow + 8 * g4) = w;
                const float q0 = bflo(w.x), q1 = bfhi(w.x), q2 = bflo(w.y), q3 = bfhi(w.y);
                ssl += (q0 * q0 + q1 * q1) + (q2 * q2 + q3 * q3);
            }
            ssl = xhalf_sum(ssl);
            if (hh == 0) ((float*)(ws + WS_SSQC))[m * 16 + h * 2 + pt] = ssl;
        }
        const int spt = wave >> 1, snt = wave & 1;
        if (wave < 4) {
            const float et = F[255];
#pragma unroll
            for (int i = 0; i < 16; ++i) S[i] *= et;
#pragma unroll
            for (int ks = 0; ks < 8; ++ks) {
                const bf16x8 a = *(const LAS bf16x8*)(lds + SD_XT + (32 * spt + r) * SD_XP + 32 * ks + 16 * hh);
                const bf16x8 bq = *(const LAS bf16x8*)(lds + SD_BDT + (32 * snt + r) * SD_DP + 32 * ks + 16 * hh);
                S = MFMA32(a, bq, S);
            }
        }
        __syncthreads();
        if (wave < 4) {
#pragma unroll
            for (int i = 0; i < 16; ++i) { const int pgl = 32 * spt + (i & 3) + 8 * (i >> 2) + 4 * hh;
                *(LAS unsigned short*)(lds + SD_XT + pgl * SD_XP + (128 + 32 * snt + r) * 2) = f2bf(S[i]); }
        }
        if (ck + 1 < 32) {
            SSD_STAGE(ck + 1);
            if (ck + 2 < 32) { SSD_LOAD(ck + 2); if (wave == 7) SSD_FCALC(ck + 2); }
        }
        __syncthreads();
    }
#undef SSD_LOAD
#undef SSD_FCALC
#undef SSD_STAGE
}

__device__ __forceinline__ void attn_naive(unsigned char* ws, int gw, int tid_) {
    asm volatile("" : "+v"(tid_)); const int lane = tid_ & 63;
    const bf16_t* Y = (const bf16_t*)(ws + WS_Y); const bf16_t* QR = (const bf16_t*)(ws + B_QR); const bf16_t* KV = (const bf16_t*)(ws + B_KV); const bf16_t* KR = (const bf16_t*)(ws + B_KR);
    bf16_t* YO = (bf16_t*)(ws + WS_Y);
    const int bh = gw >> 5, j = gw & 31, b = bh >> 3, h = bh & 7;
    for (int pass = 0; pass < 2; ++pass) {
        const int qb = pass ? 63 - j : j;
        const int t = qb * 64 + lane; const size_t m = (size_t)b * SEQ + t;
        unsigned q[48];
#pragma unroll
        for (int i = 0; i < 8; ++i) { const u32x4 w = *(const u32x4*)(Y + m * 2048 + h * 64 + i * 8); q[4 * i] = w.x; q[4 * i + 1] = w.y; q[4 * i + 2] = w.z; q[4 * i + 3] = w.w; }
#pragma unroll
        for (int i = 0; i < 4; ++i) { const u32x4 w = *(const u32x4*)(QR + m * 256 + h * 32 + i * 8); q[32 + 4 * i] = w.x; q[33 + 4 * i] = w.y; q[34 + 4 * i] = w.z; q[35 + 4 * i] = w.w; }
        float acc[64];
#pragma unroll
        for (int d = 0; d < 64; ++d) acc[d] = 0.f;
        float mx = -1e30f, lsum = 0.f;
        const int kend = qb * 64 + 64;
        for (int kv = 0; kv < kend; ++kv) {
            const size_t mk = (size_t)b * SEQ + kv;
            const u32x4* kn = (const u32x4*)(KV + mk * 1024 + h * 64); const u32x4* kr = (const u32x4*)(KR + mk * 32); const u32x4* vv = (const u32x4*)(KV + mk * 1024 + 512 + h * 64);
            float s0 = 0.f, s1 = 0.f;
#pragma unroll
            for (int i = 0; i < 8; ++i) { const u32x4 w = kn[i];
                s0 = dot2x(q[4 * i], w.x, s0);
                s1 = dot2x(q[4 * i + 1], w.y, s1);
                s0 = dot2x(q[4 * i + 2], w.z, s0);
                s1 = dot2x(q[4 * i + 3], w.w, s1); }
#pragma unroll
            for (int i = 0; i < 4; ++i) { const u32x4 w = kr[i];
                s0 = dot2x(q[32 + 4 * i], w.x, s0);
                s1 = dot2x(q[33 + 4 * i], w.y, s1);
                s0 = dot2x(q[34 + 4 * i], w.z, s0);
                s1 = dot2x(q[35 + 4 * i], w.w, s1); }
            float s = s0 + s1;
            if (kv > t) s = -1e30f;
            const float mn = fmaxf(mx, s);
            const float alpha = exp2f(mx - mn), p = (kv > t) ? 0.f : exp2f(s - mn);
            mx = mn; lsum = lsum * alpha + p;
#pragma unroll
            for (int i = 0; i < 8; ++i) { const u32x4 w = vv[i];
                acc[8 * i + 0] = acc[8 * i + 0] * alpha + p * bflo(w.x); acc[8 * i + 1] = acc[8 * i + 1] * alpha + p * bfhi(w.x);
                acc[8 * i + 2] = acc[8 * i + 2] * alpha + p * bflo(w.y); acc[8 * i + 3] = acc[8 * i + 3] * alpha + p * bfhi(w.y);
                acc[8 * i + 4] = acc[8 * i + 4] * alpha + p * bflo(w.z); acc[8 * i + 5] = acc[8 * i + 5] * alpha + p * bfhi(w.z);
                acc[8 * i + 6] = acc[8 * i + 6] * alpha + p * bflo(w.w); acc[8 * i + 7] = acc[8 * i + 7] * alpha + p * bfhi(w.w); }
        }
        const float inv = 1.f / lsum;
#pragma unroll
        for (int i = 0; i < 8; ++i) { u32x4 w; w.x = cvt_pk_bf16(acc[8 * i] * inv, acc[8 * i + 1] * inv); w.y = cvt_pk_bf16(acc[8 * i + 2] * inv, acc[8 * i + 3] * inv);
            w.z = cvt_pk_bf16(acc[8 * i + 4] * inv, acc[8 * i + 5] * inv); w.w = cvt_pk_bf16(acc[8 * i + 6] * inv, acc[8 * i + 7] * inv);
            *(u32x4*)(YO + m * 2048 + h * 64 + i * 8) = w; }
    }
}

__device__ __forceinline__ void ssd_naive(PP P, int l, unsigned char* ws, int unit, int wave, int tid_) {
    asm volatile("" : "+v"(tid_)); const int lane = tid_ & 63;
    const int b = unit >> 3, h = unit & 7, g = h >> 2;
    bf16_t* Y = (bf16_t*)(ws + WS_Y); const bf16_t* BC = (const bf16_t*)(ws + B_BC); const bf16_t* U1 = (const bf16_t*)(ws + B_U1); const float* DTF = (const float*)(ws + WS_DTF);
    const float Ah = -__expf(P->in[14][l * 8 + h]); const float Dh = P->in[15][l * 8 + h];
    const int p = wave * 8 + (lane >> 3), no = lane & 7;
    float S[8];
#pragma unroll
    for (int i = 0; i < 8; ++i) S[i] = 0.f;
    for (int t = 0; t < SEQ; ++t) {
        const size_t m = (size_t)b * SEQ + t;
        const float dt = DTF[m * 8 + h]; const float a = __expf(dt * Ah);
        bf16_t* xp = Y + m * 2048 + 1024 + h * 64 + p;
        const float xv = bf2f(*xp); const float xdt = xv * dt;
        f32x4 b0, b1, c0, c1; unpack8(*(const u32x4*)(BC + m * 256 + g * 64 + no * 8), b0, b1); unpack8(*(const u32x4*)(BC + m * 256 + 128 + g * 64 + no * 8), c0, c1);
        float y = 0.f;
#pragma unroll
        for (int i = 0; i < 4; ++i) { S[i] = a * S[i] + xdt * b0[i]; y += S[i] * c0[i]; S[4 + i] = a * S[4 + i] + xdt * b1[i]; y += S[4 + i] * c1[i]; }
        y += __shfl_xor(y, 1); y += __shfl_xor(y, 2); y += __shfl_xor(y, 4);
        const float z = bf2f(U1[m * 1024 + h * 64 + p]);
        y = (y + xv * Dh) * (z * sigmoidf_(z));
        if (no == 0) *xp = f2bf(y);
    }
}

__device__ __forceinline__ float gelu_tanh(float x) { const float u = 0.7978845608028654f * (x + 0.044715f * x * x * x); return x * sigmoidf_(2.f * u); }
__device__ __forceinline__ void lru_scan(unsigned char* ws, int unit, int wave, int tid_, LAS float* sm) {
    asm volatile("" : "+v"(tid_)); const int lane = tid_ & 63;
    const int b = unit >> 3, ch = (unit & 7) * 64 + lane;
    bf16_t* Y = (bf16_t*)(ws + WS_Y); const bf16_t* LA = (const bf16_t*)(ws + B_LA); const bf16_t* U1 = (const bf16_t*)(ws + B_U1);
    const int t0 = wave * 512;
    const size_t m0 = (size_t)b * SEQ + t0;
    const bf16_t* lap = LA + m0 * 512 + ch; bf16_t* up = Y + m0 * 2048 + 1536 + ch; const bf16_t* gp = U1 + m0 * 1024 + 512 + ch;
    float A = 1.f, H = 0.f;
    for (int t = 0; t < 512; t += 16) {
        bf16_t la[16], uu[16];
#pragma unroll
        for (int k = 0; k < 16; ++k) { la[k] = lap[(size_t)(t + k) * 512]; uu[k] = up[(size_t)(t + k) * 2048]; }
#pragma unroll
        for (int k = 0; k < 16; ++k) { const float a = __expf(bf2f(la[k])); H = a * H + bf2f(uu[k]); A *= a; }
    }
    sm[wave * 64 + lane] = A; sm[512 + wave * 64 + lane] = H;
    __syncthreads();
    float hcar = 0.f;
    for (int w = 0; w < wave; ++w) hcar = sm[w * 64 + lane] * hcar + sm[512 + w * 64 + lane];
    for (int t = 0; t < 512; t += 16) {
        bf16_t la[16], uu[16], gg[16];
#pragma unroll
        for (int k = 0; k < 16; ++k) { la[k] = lap[(size_t)(t + k) * 512]; uu[k] = up[(size_t)(t + k) * 2048]; gg[k] = gp[(size_t)(t + k) * 1024]; }
#pragma unroll
        for (int k = 0; k < 16; ++k) { const float a = __expf(bf2f(la[k])); hcar = a * hcar + bf2f(uu[k]); up[(size_t)(t + k) * 2048] = f2bf(bf2f(f2bf(hcar)) * gelu_tanh(bf2f(gg[k]))); }
    }
    __syncthreads();
}


#define RLX_AGENT __ATOMIC_RELAXED, __HIP_MEMORY_SCOPE_AGENT
#define XB_TMO      128
#define XB_XCNT(j)  (256  + 64 * (j))
#define XB_XSUB(j)  (1280 + 64 * (j))
#define XB_XGEN(j)  (2304 + 64 * (j))
#define XB_TOP      3328
#define XB_TOPGEN   3392
#define XCD_BAR_WORDS 3456
#define XB_SPIN_CAP (1u << 18)

__device__ __forceinline__ unsigned xb_ld(unsigned* p)              { return __hip_atomic_load(p, __ATOMIC_RELAXED, __HIP_MEMORY_SCOPE_AGENT); }
__device__ __forceinline__ unsigned xb_add(unsigned* p, unsigned v) { return __hip_atomic_fetch_add(p, v, __ATOMIC_RELAXED, __HIP_MEMORY_SCOPE_AGENT); }
__device__ __forceinline__ unsigned xb_xcc_id() { return (unsigned)__builtin_amdgcn_s_getreg((3 << 11) | 20) & 0xFu; }
#define XB_SPIN(cond, bar) do { unsigned _sp = 0; while (cond) { __builtin_amdgcn_s_sleep(1); \
    if ((++_sp & 255u) == 0u) { if (xb_ld(&(bar)[XB_TMO])) break; if (_sp > XB_SPIN_CAP) { atomicAdd(&(bar)[XB_TMO], 1u); break; } } } } while (0)

struct XcdBarrier {
    unsigned* bar; unsigned x;
    volatile LAS unsigned* st;
};

__device__ __forceinline__ XcdBarrier xcd_barrier_post(unsigned* bar, volatile LAS unsigned* st) {
    XcdBarrier b; b.bar = bar; b.x = xb_xcc_id(); b.st = st;
    if (threadIdx.x == 0) (void)xb_add(&bar[XB_XCNT(b.x)], 1u);
    return b;
}
__device__ __forceinline__ void xcd_barrier_complete(unsigned* bar, unsigned x, unsigned& nloc, unsigned& nx) {
    const unsigned G = gridDim.x * gridDim.y * gridDim.z;
    unsigned sum, cnt, mine, sp = 0u;
    for (;;) {
        sum = 0u; cnt = 0u; mine = 0u;
#pragma unroll
        for (unsigned j = 0; j < 16; ++j) { const unsigned c = xb_ld(&bar[XB_XCNT(j)]); sum += c; cnt += (c > 0u) ? 1u : 0u; mine = (j == x) ? c : mine; }
        if (sum == G) break;
        __builtin_amdgcn_s_sleep(1);
        if ((++sp & 255u) == 0u) { if (xb_ld(&bar[XB_TMO])) break; if (sp > XB_SPIN_CAP) { atomicAdd(&bar[XB_TMO], 1u); break; } }
    }
    nloc = mine > 0u ? mine : 1u; nx = cnt > 0u ? cnt : 1u;
}

__device__ __forceinline__ void xcd_barrier(const XcdBarrier& b) {
    asm volatile("s_waitcnt vmcnt(0)" ::: "memory");
    __syncthreads();
    if (threadIdx.x == 0) {
        unsigned* bar = b.bar;
        __builtin_amdgcn_s_waitcnt(0);
        unsigned nloc = b.st[0], nx = b.st[1];
        if (nloc == 0u) { xcd_barrier_complete(bar, b.x, nloc, nx); b.st[0] = nloc; b.st[1] = nx; }
        const unsigned old = xb_add(&bar[XB_XSUB(b.x)], 1u);
        const unsigned gen = old / nloc;
        if (old + 1u == (gen + 1u) * nloc) {
            __builtin_amdgcn_fence(__ATOMIC_RELEASE, "agent");
            asm volatile("s_waitcnt vmcnt(0)" ::: "memory");
            const unsigned og = xb_add(&bar[XB_TOP], 1u);
            const unsigned tg = og / nx;
            if (og + 1u == (tg + 1u) * nx) xb_add(&bar[XB_TOPGEN], 1u);
            else XB_SPIN(xb_ld(&bar[XB_TOPGEN]) == tg, bar);
            __builtin_amdgcn_fence(__ATOMIC_ACQUIRE, "agent");
            xb_add(&bar[XB_XGEN(b.x)], 1u);
            asm volatile("s_waitcnt vmcnt(0)" ::: "memory");
        } else {
            XB_SPIN(xb_ld(&bar[XB_XGEN(b.x)]) == gen, bar);
            __builtin_amdgcn_fence(__ATOMIC_ACQUIRE, "agent");
            asm volatile("s_waitcnt vmcnt(0)" ::: "memory");
        }
    }
    __syncthreads();
}


constexpr int LDS_BYTES = 147456;
#ifndef GMASK
#define GMASK 0xffffffffu
#endif
__global__ void __launch_bounds__(512, 2) mk_fwd(Params Pk) {
    extern __shared__ __attribute__((aligned(16))) unsigned char lds_raw[];
    LAS unsigned char* lds = (LAS unsigned char*)lds_raw;
    cg::grid_group grid = cg::this_grid();
    const int tid = threadIdx.x, wave = __builtin_amdgcn_readfirstlane(tid >> 6);
    const int G = gridDim.x, bid = blockIdx.x;
    const int gw = bid * 8 + wave, NGW = G * 8, NGT = G * 512;
    PP P = (PP)__builtin_amdgcn_kernarg_segment_ptr();
    unsigned char* ws = (unsigned char*)(__attribute__((address_space(1))) unsigned char*)P->ws;
    { volatile LAS unsigned* st0 = (volatile LAS unsigned*)(lds + 146000); if (tid == 0) { st0[0] = 0u; st0[1] = 0u; } __syncthreads(); }
    XcdBarrier xbar = xcd_barrier_post((unsigned*)P->ws + 4096, (volatile LAS unsigned*)(lds + 146000));
    if (G > 100000) grid.sync();
#define FRESH() do { asm volatile("" : "+s"(P)); { __attribute__((address_space(1))) unsigned char* g_ = (__attribute__((address_space(1))) unsigned char*)P->ws; asm volatile("" : "+s"(g_), "+s"(l)); ws = (unsigned char*)g_; } W = (bf16_t*)(ws + WS_W); XB = (bf16_t*)(ws + WS_XB); Y = (bf16_t*)(ws + WS_Y); } while (0)
#define GSYNC() do { xcd_barrier(xbar); } while (0)
    bf16_t* W = (bf16_t*)(ws + WS_W); bf16_t* XB = (bf16_t*)(ws + WS_XB); bf16_t* Y = (bf16_t*)(ws + WS_Y);
    #define SSQA ((float*)(ws + WS_SSQA))
#define SSQB ((float*)(ws + WS_SSQB))
#define SSQC_ (cur ? SSQB : SSQA)
#define SSQN_ (cur ? SSQA : SSQB)
    int cur = 0;
    using namespace pg8;

    for (int l = 0; l < DEPTH; ++l) {
        FRESH();
        conv_weights(P, l, W, tid, bid, NGT, lds);
        p0_rows(P, l == 0 ? P->in[0] : (const float*)P->out, l == 0, XB, SSQA, (f32x2*)(ws + WS_CS), gw, NGW, tid);
        GSYNC(); FRESH();
        { Gemm g{XB, W + W_IN, M, 3584, 1024, 1024, 0, 0}; StaticOrder S; S.init(M, 3584, G, bid);
          EpiInproj E{(bf16_t*)(ws + B_U1), (bf16_t*)(ws + B_UA), (bf16_t*)(ws + B_UB), lds};
          rstd_prepass(lds, SSQC_, S, tid); if (GMASK & (1u << 0)) gemm_phase(lds, g, S, E); }
        GSYNC(); FRESH();
        p2_prep(P, l, ws, gw, NGW, tid);
        GSYNC(); FRESH();
        { Gemm g{(const bf16_t*)(ws + B_UA), W + W_UQ, M, 768, 384, 768, 0, 0}; StaticOrder S; S.init(M, 768, G, bid);
          EpiQ E{Y, (bf16_t*)(ws + B_QR), (const float*)(ws + WS_RSQ), (const f32x2*)(ws + WS_CS)}; if (GMASK & (1u << 1)) gemm_phase(lds, g, S, E); }
        { Gemm g{(const bf16_t*)(ws + B_UA) + 384, W + W_UKV, M, 1024, 256, 768, 0, 0}; StaticOrder S; S.init(M, 1024, G, (bid + 128) % G);
          EpiRowScale E{(bf16_t*)(ws + B_KV), 1024, (const float*)(ws + WS_RSKV), 0}; if (GMASK & (1u << 2)) gemm_phase(lds, g, S, E); }
        { Gemm g{Y + 512, W + W_POOL, M, 512, 256, 2048, 256, 0}; StaticOrder S; S.init(M, 512, G, bid);
          EpiRowScale E{Y + 512, 2048, nullptr, 0}; if (GMASK & (1u << 3)) gemm_phase(lds, g, S, E); }
        { Gemm g{Y + 1536, W + W_LRU, M, 1024, 128, 2048, 128, 0}; StaticOrder S; S.init(M, 1024, G, bid);
          EpiLru E{Y + 1536, (bf16_t*)(ws + B_LA), P->in[20] + l * 512, P->in[22] + l * 512, P->in[23] + l * 512}; if (GMASK & (1u << 4)) gemm_phase(lds, g, S, E); }
        GSYNC(); FRESH();
#ifdef NAIVE_SSD
        if (bid < 64) ssd_naive(P, l, ws, bid, wave, tid);
#else
        if (bid < 64) ssd_mfma(P, l, ws, lds, bid, wave, tid);
#endif
#ifndef NO_LRU
        if (bid >= 64 && bid < 128) lru_scan(ws, bid - 64, wave, tid, (LAS float*)lds);
#endif
#ifdef NAIVE_ATTN
        if (gw < 2048) attn_naive(ws, gw, tid);
#else
#ifdef PROBE_ATTN
        attn_phase(ws, lds, (unsigned*)ws + 64 + 16 * l + 8, wave, tid, (bf16_t*)(ws + B_UA), 512);
#endif
        attn_phase(ws, lds, (unsigned*)ws + 64 + 16 * l, wave, tid, (bf16_t*)(ws + WS_Y), 2048);
#endif
        GSYNC(); FRESH();
#define TBUF(n) ((bf16_t*)(ws + WS_BIG + (size_t)(n) * 64 * MiB))
#define MB ((bf16_t*)(ws + WS_BIG + 64 * MiB))
        { MergeOrder S; S.base.init(M, 1024, G, bid); EpiMerge E{lds, TBUF(0), MB};
          merge_prepass(lds, SSQC_, (const float*)(ws + WS_SSQC), S, tid);
          if (GMASK & (1u << 5)) gemm_merge_fused(lds, Y, XB, W + W_BR, W + W_G, S, E); }
        GSYNC(); FRESH();
        { Gemm g{MB, W + W_OUT, M, 1024, 1024, 1024, 0, 0}; StaticOrder S; S.init(M, 1024, G, bid);
          EpiRes<0> E{l == 0 ? P->in[0] : P->out, P->out, XB, SSQN_, (const LAS unsigned char*)nullptr, nullptr}; if (GMASK & (1u << 8)) gemm_phase(lds, g, S, E); cur ^= 1; }
        GSYNC(); FRESH();
        conv_p(P, l, (bf16_t*)(ws + Y_PB), tid, bid, NGT);
        { Gemm g{XB, W + W_FF1, M, 4096, 1024, 1024, 0, 0}; StaticOrder S; S.init(M, 4096, G, bid);
          EpiFF1 E{(bf16_t*)(ws + B_H), lds}; rstd_prepass(lds, SSQC_, S, tid); if (GMASK & (1u << 9)) gemm_phase(lds, g, S, E); }
        GSYNC(); FRESH();
        { Gemm g{(const bf16_t*)(ws + B_H), W + W_FF2, M, 1024, 4096, 4096, 0, 0}; StaticOrder S; S.init(M, 1024, G, bid); S.rev = 1;
          EpiRes<0> E{P->out, P->out, XB, SSQN_, (const LAS unsigned char*)nullptr, nullptr}; if (GMASK & (1u << 10)) gemm_phase(lds, g, S, E); cur ^= 1; }
        { Gemm g{(const bf16_t*)(ws + Y_PB), W + W_PLE, M, 1024, 256, 256, 0, 0}; StaticOrder S; S.init(M, 1024, G, bid);
          EpiRowScale E{(bf16_t*)(ws + Y_TP), 1024, nullptr, 0}; if (GMASK & (1u << 11)) gemm_phase(lds, g, S, E); }
        GSYNC(); FRESH();
        { Gemm g{XB, W + W_PG, M, 1024, 1024, 1024, 0, 0}; StaticOrder S; S.init(M, 1024, G, bid);
          EpiRes<1> E{P->out, P->out, XB, SSQN_, lds, (const bf16_t*)(ws + Y_TP)}; rstd_prepass(lds, SSQC_, S, tid); if (GMASK & (1u << 12)) gemm_phase(lds, g, S, E); cur ^= 1; }
        GSYNC(); FRESH();
    }
    final_norm(P, SSQC_, gw, NGW, tid);
}

extern "C" void kernel_launch(void* const* d_in, const int* in_sizes, int n_in, void* d_out, int out_size, void* d_ws, size_t ws_size, hipStream_t stream) {
    static int grid = 0;
    if (grid == 0) {
        if (n_in != 33 || out_size != M * D || ws_size < WS_END) { fprintf(stderr, "kernel_launch: unexpected shapes (n_in %d out %d ws %zu)\n", n_in, out_size, ws_size); grid = -1; return; }
        int dev = 0, cus = 0, per_cu = 0;
        hipGetDevice(&dev); hipDeviceGetAttribute(&cus, hipDeviceAttributeMultiprocessorCount, dev);
        hipFuncSetAttribute((const void*)mk_fwd, hipFuncAttributeMaxDynamicSharedMemorySize, LDS_BYTES);
        hipOccupancyMaxActiveBlocksPerMultiprocessor(&per_cu, (const void*)mk_fwd, 512, LDS_BYTES);
        if (per_cu < 1) per_cu = 1;
        grid = cus >= 256 ? 256 : cus;
        (void)hipGetLastError();
    }
    if (grid < 0) return;
    if (hipMemsetAsync(d_ws, 0, 65536, stream) != hipSuccess) { fprintf(stderr, "memset failed\n"); return; }
    Params p{};
    for (int i = 0; i < 33; ++i) p.in[i] = (const float*)d_in[i];
    p.out = (float*)d_out; p.ws = (unsigned char*)d_ws;
    for (int i = 0; i < 16; ++i) p.inv_freq[i] = 1.0 / pow(10000.0, (double)i / 16.0);
    void* args[] = {&p};
    hipError_t e = hipLaunchCooperativeKernel((const void*)mk_fwd, dim3(grid), dim3(512), args, LDS_BYTES, stream);
    if (e != hipSuccess) fprintf(stderr, "cooperative launch failed: %s (grid %d)\n", hipGetErrorString(e), grid);
}
```

```cpp
#include <hip/hip_runtime.h>
#include <hip/hip_cooperative_groups.h>
#include <cstdio>
#include <cstdint>
#include <cmath>
namespace cg = cooperative_groups;

#define LAS __attribute__((address_space(3)))
typedef unsigned short bf16_t;
typedef short bf16x8 __attribute__((ext_vector_type(8)));
typedef float f32x4 __attribute__((ext_vector_type(4)));
typedef float f32x2 __attribute__((ext_vector_type(2)));
typedef unsigned u32x4 __attribute__((ext_vector_type(4)));
typedef unsigned u32x2 __attribute__((ext_vector_type(2)));
typedef __bf16 bf16x2_t __attribute__((ext_vector_type(2)));

constexpr int M = 32768, SEQ = 4096, NB = 8, D = 1024, DEPTH = 2;
constexpr int INC = 7592;
constexpr float EPS = 1e-6f;
constexpr float QSCALE = 0.10206207261596577f * 1.4426950408889634f;

constexpr size_t MiB = 1u << 20;
constexpr size_t WS_SSQA = 2 * MiB, WS_SSQB = 4 * MiB, WS_RSQ = 6 * MiB, WS_RSKV = WS_RSQ + 128 * 1024, WS_RSC = WS_RSKV + 128 * 1024;
constexpr size_t WS_DTF = 7 * MiB, WS_CS = 8 * MiB, WS_SSQC = 12 * MiB;
constexpr size_t WS_W = 16 * MiB, WS_XB = 60 * MiB, WS_Y = 124 * MiB, WS_BIG = 252 * MiB, WS_END = 512 * MiB;
constexpr size_t B_U1 = WS_BIG, B_UA = WS_BIG + 64 * MiB, B_UB = WS_BIG + 112 * MiB, B_BC = WS_BIG + 224 * MiB, B_KR = WS_BIG + 240 * MiB;
constexpr size_t B_QR = WS_BIG + 112 * MiB, B_KV = WS_BIG + 128 * MiB, B_LA = WS_BIG + 192 * MiB;
constexpr size_t B_T0 = WS_BIG, B_T1 = WS_BIG + 64 * MiB, B_MB = WS_BIG + 128 * MiB;
constexpr size_t B_H = WS_BIG;
constexpr size_t Y_TP = WS_Y, Y_PB = WS_Y + 64 * MiB;
constexpr size_t W_IN = 0, W_G = W_IN + 3584ull * 1024, W_UQ = W_G + 4096ull * 1024, W_UKV = W_UQ + 768ull * 384, W_POOL = W_UKV + 1024ull * 256,
                 W_LRU = W_POOL + 512ull * 256, W_BR = W_LRU + 1024ull * 128, W_OUT = W_BR + 4096ull * 512, W_FF1 = W_OUT + 1024ull * 1024,
                 W_FF2 = W_FF1 + 4096ull * 1024, W_PG = W_FF2 + 4096ull * 1024, W_PLE = W_PG + 1024ull * 1024, W_TOTAL = W_PLE + 1024ull * 256;
static_assert(W_TOTAL * 2 <= 44 * MiB, "weights fit");

struct Params {
    const float* in[33];
    float* out;
    unsigned char* ws;
    double inv_freq[16];
};

typedef const __attribute__((address_space(4))) Params* PP;
#if defined(__HIP_DEVICE_COMPILE__)
#define ASSUME_GLOBAL(p) do { __builtin_assume(!__builtin_amdgcn_is_shared((const __attribute__((address_space(0))) void*)(p))); __builtin_assume(!__builtin_amdgcn_is_private((const __attribute__((address_space(0))) void*)(p))); } while (0)
#else
#define ASSUME_GLOBAL(p) do { } while (0)
#endif
__device__ __forceinline__ unsigned cvt_pk_bf16(float lo, float hi) { unsigned r; asm("v_cvt_pk_bf16_f32 %0, %1, %2" : "=v"(r) : "v"(lo), "v"(hi)); return r; }
__device__ __forceinline__ float bflo(unsigned w) { return __uint_as_float(w << 16); }
__device__ __forceinline__ float bfhi(unsigned w) { return __uint_as_float(w & 0xffff0000u); }
__device__ __forceinline__ float bf2f(bf16_t h) { return __uint_as_float(((unsigned)h) << 16); }
__device__ __forceinline__ bf16_t f2bf(float f) { return (bf16_t)(cvt_pk_bf16(f, 0.f) & 0xffffu); }
__device__ __forceinline__ u32x4 pack8(f32x4 a, f32x4 b) { u32x4 w; w.x = cvt_pk_bf16(a[0], a[1]); w.y = cvt_pk_bf16(a[2], a[3]); w.z = cvt_pk_bf16(b[0], b[1]); w.w = cvt_pk_bf16(b[2], b[3]); return w; }
__device__ __forceinline__ void unpack8(u32x4 w, f32x4& a, f32x4& b) { a = (f32x4){bflo(w.x), bfhi(w.x), bflo(w.y), bfhi(w.y)}; b = (f32x4){bflo(w.z), bfhi(w.z), bflo(w.w), bfhi(w.w)}; }
__device__ __forceinline__ float dot2x(unsigned a, unsigned b, float c) { return c + bflo(a) * bflo(b) + bfhi(a) * bfhi(b); }
__device__ __forceinline__ float sigmoidf_(float x) { return __builtin_amdgcn_rcpf(1.f + __builtin_amdgcn_exp2f(-1.4426950408889634f * x)); }
__device__ __forceinline__ float one_minus_exp(float x) {
    const float p = -x * (1.f + x * (0.5f + x * (0.16666667f + x * (0.041666668f + x * (0.008333334f + x * (0.0013888889f + x * 0.0001984127f))))));
    return x < -0.25f ? 1.f - __expf(x) : p;
}
__device__ __forceinline__ float xhalf_sum(float v) { const auto r_ = __builtin_amdgcn_permlane32_swap(__float_as_uint(v), __float_as_uint(v), false, false); return __uint_as_float(r_[0]) + __uint_as_float(r_[1]); }
__device__ __forceinline__ float xhalf_max(float v) { const auto r_ = __builtin_amdgcn_permlane32_swap(__float_as_uint(v), __float_as_uint(v), false, false); return fmaxf(__uint_as_float(r_[0]), __uint_as_float(r_[1])); }
__device__ __forceinline__ float wave_sum(float v) {
#pragma unroll
    for (int o = 1; o < 64; o <<= 1) v += __shfl_xor(v, o);
    return v;
}
__device__ __forceinline__ float rstd16(const float* ssq, int row) {
    const f32x4* p = (const f32x4*)(ssq + (size_t)row * 16);
    f32x4 a = p[0], b = p[1], c = p[2], d = p[3];
    f32x4 s = (a + b) + (c + d);
    return rsqrtf(((s[0] + s[1]) + (s[2] + s[3])) * (1.f / 1024.f) + EPS);
}

namespace pg8 {
constexpr int BM = 256, BK = 64, HALF = 128, HTB = HALF * BK * 2, STAGE_BYTES = 8 * HTB, NXCD = 8, WGM = 8;
__host__ __device__ __forceinline__ int lds_byte(int r, int c) { const int st = (r >> 4) * 2 + (c >> 5), rr = r & 15, cc = c & 31, ob = rr * 64 + cc * 2; return st * 1024 + (ob ^ (((ob >> 9) & 1) << 5)); }
__host__ __device__ __forceinline__ void stage_rc(int b, int& R, int& C) { const int st = b / 1024, sb = b % 1024, swz = sb ^ (((sb >> 9) & 1) << 5); R = (st >> 1) * 16 + swz / 64; C = (st & 1) * 32 + (swz % 64) / 2; }
__host__ __device__ __forceinline__ int perm32(int rho) { const int n = rho >> 4, i = rho & 15; return 8 * (i >> 2) + 4 * n + (i & 3); }

struct Unit { int pm, pn, ui; };
struct Gemm { const bf16_t* A; const bf16_t* Bt; int M, N, K, lda, a_pn_off, a_sh; };

struct StaticOrder {
    int nM, nN, nwg, G, c, rev;
    __device__ __forceinline__ void init(int M_, int N_, int G_, int c_) { nM = M_ / BM; nN = N_ / BM; nwg = nM * nN; G = G_; c = c_; rev = 0; }
    __device__ __forceinline__ bool next(int i, Unit& u) const {
        const long L = (long)i * G + c; if (L >= nwg) return false;
        int wgid = (int)L; { const int q = nwg / NXCD, r = nwg % NXCD, xcd = wgid % NXCD, off = wgid / NXCD; wgid = (xcd < r ? xcd * (q + 1) : r * (q + 1) + (xcd - r) * q) + off; }
        const int nig = WGM * nN, gid = wgid / nig, fm = gid * WGM, gsz = (nM - fm) < WGM ? (nM - fm) : WGM;
        u.pm = fm + ((wgid % nig) % gsz); u.pn = (wgid % nig) / gsz; if (rev) u.pm = nM - 1 - u.pm; return true;
    }
};

struct GateOrder {
    StaticOrder base;
    __device__ __forceinline__ bool next(int i, Unit& u) const { Unit t; if (!base.next(i >> 2, t)) return false; u.pm = t.pm; u.pn = (i & 3) * 4 + t.pn; return true; }
};
constexpr int RSL_OFF = 135168;
template <class Sched>
__device__ __forceinline__ void rstd_prepass(LAS unsigned char* lds, const float* ssq, const Sched& S, int tid_) {
    asm volatile("" : "+v"(tid_));
    LAS float* rsl = (LAS float*)(lds + RSL_OFF); Unit u;
    for (int i = tid_ >> 8; i < 10 && S.next(i, u); i += 2) rsl[i * 256 + (tid_ & 255)] = rstd16(ssq, u.pm * 256 + (tid_ & 255));
    __syncthreads();
}
#define RSL(u_, row_) (((const LAS float*)(lds_rs + RSL_OFF))[(u_).ui * 256 + ((row_) & 255)])
template <class Epi, class Sched>
__device__ __forceinline__ void gemm_phase(LAS unsigned char* lds, const Gemm g, const Sched& S, const Epi& E) {
    int tid = threadIdx.x; asm volatile("" : "+v"(tid));
    const int wid = __builtin_amdgcn_readfirstlane(tid >> 6), lane = tid & 63, wr = wid >> 2, wc = wid & 3, fr = lane & 15, fq = lane >> 4;
    int K = g.K, lda = g.lda; asm volatile("" : "+s"(K), "+s"(lda));
    const int nt = K / BK;
    unsigned voffA[2], voffB[2];
#pragma unroll
    for (int i = 0; i < 2; ++i) { int R, C; stage_rc(tid * 16 + i * 8192, R, C); const int Rb = (R & ~31) + perm32(R & 31);
        voffA[i] = (unsigned)(R * lda + C) * 2u; voffB[i] = (unsigned)(Rb * K + C) * 2u; }
    const size_t kstep = (size_t)(BK * 2);
    const size_t hsA = (size_t)HALF * lda * 2, hsB = (size_t)HALF * K * 2;
    const size_t tsA = 2 * hsA, tsB = 2 * hsB, pnA = (size_t)g.a_pn_off * 2;
    const unsigned ldsw = (unsigned)wid * 1024u;
    const int aoff = lds_byte(wr * 64 + fr, fq * 8), boff = lds_byte(wc * 32 + fr, fq * 8);
#define PG8_SA(b, h) (((b) * 2 + (h)) * HTB)
#define PG8_SB(b, h) ((4 + (b) * 2 + (h)) * HTB)
#define PG8_STAGE(bufoff, gbase, voff) do { _Pragma("unroll") for (int _i = 0; _i < 2; ++_i) \
        __builtin_amdgcn_global_load_lds((const unsigned*)((const char*)(gbase) + (voff)[_i]), (LAS unsigned*)(lds + (bufoff) + ldsw + _i * 8192), 16, 0, 0); } while (0)
#define PG8_LDA(dst, b, h) do { _Pragma("unroll") for (int m = 0; m < 4; ++m) _Pragma("unroll") for (int k = 0; k < 2; ++k) dst[m][k] = *(const LAS bf16x8*)(lds + PG8_SA(b, h) + aoff + m * 2048 + k * 1024); } while (0)
#define PG8_LDB(dst, b, h) do { _Pragma("unroll") for (int n = 0; n < 2; ++n) _Pragma("unroll") for (int k = 0; k < 2; ++k) dst[n][k] = *(const LAS bf16x8*)(lds + PG8_SB(b, h) + boff + n * 2048 + k * 1024); } while (0)
#define PG8_MMA(ai, bj, At, Bt) do { __builtin_amdgcn_s_setprio(1); _Pragma("unroll") for (int m = 0; m < 4; ++m) _Pragma("unroll") for (int n = 0; n < 2; ++n) _Pragma("unroll") for (int k = 0; k < 2; ++k) \
        acc[ai][bj][m][n] = __builtin_amdgcn_mfma_f32_16x16x32_bf16(Bt[n][k], At[m][k], acc[ai][bj][m][n], 0, 0, 0); __builtin_amdgcn_s_setprio(0); } while (0)
#define PG8_WAIT_V(n) asm volatile("s_waitcnt vmcnt(" #n ")" ::: "memory")
#define PG8_WAIT_L(n) asm volatile("s_waitcnt lgkmcnt(" #n ")" ::: "memory")
#define PG8_BAR __builtin_amdgcn_s_barrier()
#define PG8_SCHED __builtin_amdgcn_sched_barrier(0)
    Unit cur, nxt; int ui = 0;
    if (!S.next(0, cur)) return;
    f32x4 acc[2][2][4][2];
#pragma unroll
    for (int a = 0; a < 2; ++a)
#pragma unroll
        for (int b = 0; b < 2; ++b)
#pragma unroll
            for (int m = 0; m < 4; ++m)
#pragma unroll
                for (int n = 0; n < 2; ++n) acc[a][b][m][n] = (f32x4){0.f, 0.f, 0.f, 0.f};
    bf16x8 At[4][2], B0[2][2], B1[2][2];
    const char* cA = (const char*)g.A + (size_t)cur.pm * tsA + (size_t)(cur.pn >> g.a_sh) * pnA; const char* cB = (const char*)g.Bt + (size_t)cur.pn * tsB;
    PG8_STAGE(PG8_SB(0, 0), cB, voffB); PG8_STAGE(PG8_SB(0, 1), cB + hsB, voffB); PG8_STAGE(PG8_SA(0, 0), cA, voffA); PG8_STAGE(PG8_SA(0, 1), cA + hsA, voffA);
    if (wr == 1) PG8_BAR;
    PG8_WAIT_V(2); PG8_BAR;
    PG8_STAGE(PG8_SB(1, 0), cB + kstep, voffB); PG8_STAGE(PG8_SA(1, 0), cA + kstep, voffA); PG8_STAGE(PG8_SB(1, 1), cB + hsB + kstep, voffB);
    PG8_WAIT_V(6); PG8_BAR;
    for (;;) {
        const bool has_next = S.next(ui + 1, nxt);
        const char* nA = has_next ? (const char*)g.A + (size_t)nxt.pm * tsA + (size_t)(nxt.pn >> g.a_sh) * pnA : cA; const char* nB = has_next ? (const char*)g.Bt + (size_t)nxt.pn * tsB : cB;
        for (int t = 0; t < nt; t += 2) {
            const bool last = (t == nt - 2);
            const char* a1 = cA + (size_t)(t + 1) * kstep;
            const char* a2 = last ? nA : cA + (size_t)(t + 2) * kstep; const char* b2 = last ? nB : cB + (size_t)(t + 2) * kstep;
            const char* a3 = a2 + kstep; const char* b3 = b2 + kstep;
            PG8_LDB(B0, 0, 0); PG8_LDB(B1, 0, 1); PG8_SCHED; PG8_LDA(At, 0, 0); PG8_STAGE(PG8_SA(1, 1), a1 + hsA, voffA);
            PG8_WAIT_V(8); PG8_WAIT_L(0); PG8_BAR; PG8_MMA(0, 0, At, B0); PG8_MMA(0, 1, At, B1); PG8_BAR; PG8_SCHED;
            PG8_LDA(At, 0, 1); PG8_STAGE(PG8_SB(0, 0), b2, voffB); PG8_STAGE(PG8_SB(0, 1), b2 + hsB, voffB); PG8_STAGE(PG8_SA(0, 0), a2, voffA);
            PG8_WAIT_V(8); PG8_WAIT_L(0); PG8_BAR; PG8_MMA(1, 0, At, B0); PG8_MMA(1, 1, At, B1); PG8_BAR; PG8_SCHED;
            PG8_LDB(B0, 1, 0); PG8_LDB(B1, 1, 1); PG8_SCHED; PG8_LDA(At, 1, 0); PG8_STAGE(PG8_SA(0, 1), a2 + hsA, voffA);
            PG8_WAIT_V(8); PG8_WAIT_L(0); PG8_BAR; PG8_MMA(0, 0, At, B0); PG8_MMA(0, 1, At, B1); PG8_BAR; PG8_SCHED;
            PG8_LDA(At, 1, 1); PG8_STAGE(PG8_SB(1, 0), b3, voffB); PG8_STAGE(PG8_SB(1, 1), b3 + hsB, voffB); PG8_STAGE(PG8_SA(1, 0), a3, voffA);
            PG8_WAIT_V(8); PG8_WAIT_L(0); PG8_BAR; PG8_MMA(1, 0, At, B0); PG8_MMA(1, 1, At, B1); PG8_BAR; PG8_SCHED;
        }
        if (wr == 0) PG8_BAR;
        cur.ui = ui; E(acc, cur, wr, wc, fr, fq);
        if (!has_next) break;
#pragma unroll
        for (int a = 0; a < 2; ++a)
#pragma unroll
            for (int b = 0; b < 2; ++b)
#pragma unroll
                for (int m = 0; m < 4; ++m)
#pragma unroll
                    for (int n = 0; n < 2; ++n) acc[a][b][m][n] = (f32x4){0.f, 0.f, 0.f, 0.f};
        cur = nxt; cA = nA; cB = nB; ++ui;
        if (wr == 1) PG8_BAR;
    }
    PG8_WAIT_V(0);
    PG8_BAR;
#undef PG8_SA
#undef PG8_SB
#undef PG8_STAGE
#undef PG8_LDA
#undef PG8_LDB
#undef PG8_MMA
#undef PG8_WAIT_V
#undef PG8_WAIT_L
#undef PG8_BAR
#undef PG8_SCHED
}

struct MUnit { int pm, pn, ui, kind, n; };
struct MergeOrder { StaticOrder base;
    __device__ __forceinline__ bool next(int i, MUnit& u) const { Unit t; if (!base.next(i >> 3, t)) return false; u.pm = t.pm; u.pn = t.pn; u.n = (i >> 1) & 3; u.kind = i & 1; u.ui = i; return true; } };
template <class Epi>
__device__ __forceinline__ void gemm_merge_fused(LAS unsigned char* lds, const bf16_t* Yb, const bf16_t* XBb, const bf16_t* WBR, const bf16_t* WG, const MergeOrder& S, const Epi& E) {
    int tid = threadIdx.x; asm volatile("" : "+v"(tid));
    const int wid = __builtin_amdgcn_readfirstlane(tid >> 6), lane = tid & 63, wr = wid >> 2, wc = wid & 3, fr = lane & 15, fq = lane >> 4;
    int R0, C0; stage_rc(tid * 16, R0, C0);
    const unsigned Rb0 = (unsigned)((R0 & ~31) + perm32(R0 & 31)), Ra0 = (unsigned)R0, C2 = (unsigned)C0 * 2u;
    int la0 = 4096, lb0 = 1024, la1_ = 2048, lb1 = 2048, nt0 = 8, nt1 = 16;
    asm volatile("" : "+s"(la0), "+s"(lb0), "+s"(la1_), "+s"(lb1), "+s"(nt0), "+s"(nt1));
#define MF_LA(k) ((unsigned)((k) ? la1_ : la0))
#define MF_LB(k) ((unsigned)((k) ? lb1 : lb0))
    const size_t kstep = (size_t)(BK * 2);
#define MF_ABASE(u_) ((u_).kind ? (const char*)XBb + (size_t)(u_).pm * 256 * 1024 * 2 : (const char*)Yb + (size_t)(u_).pm * 256 * 2048 * 2 + (size_t)(u_).n * 512 * 2)
#define MF_BBASE(u_) ((u_).kind ? (const char*)WG + ((size_t)(u_).n * 1024 + (size_t)(u_).pn * 256) * 1024 * 2 : (const char*)WBR + ((size_t)(u_).n * 1024 + (size_t)(u_).pn * 256) * 512 * 2)
    const unsigned ldsw = (unsigned)wid * 1024u;
    const int aoff = lds_byte(wr * 64 + fr, fq * 8), boff = lds_byte(wc * 32 + fr, fq * 8);
#define PG8_SA(b, h) (((b) * 2 + (h)) * HTB)
#define PG8_SB(b, h) ((4 + (b) * 2 + (h)) * HTB)
#define PG8_STAGE(bufoff, gbase, voff) do { _Pragma("unroll") for (int _i = 0; _i < 2; ++_i) \
        __builtin_amdgcn_global_load_lds((const unsigned*)((const char*)(gbase) + (voff)[_i]), (LAS unsigned*)(lds + (bufoff) + ldsw + _i * 8192), 16, 0, 0); } while (0)
#define PG8_LDA(dst, b, h) do { _Pragma("unroll") for (int m = 0; m < 4; ++m) _Pragma("unroll") for (int k = 0; k < 2; ++k) dst[m][k] = *(const LAS bf16x8*)(lds + PG8_SA(b, h) + aoff + m * 2048 + k * 1024); } while (0)
#define PG8_LDB(dst, b, h) do { _Pragma("unroll") for (int n = 0; n < 2; ++n) _Pragma("unroll") for (int k = 0; k < 2; ++k) dst[n][k] = *(const LAS bf16x8*)(lds + PG8_SB(b, h) + boff + n * 2048 + k * 1024); } while (0)
#define PG8_MMA(ai, bj, At, Bt) do { __builtin_amdgcn_s_setprio(1); _Pragma("unroll") for (int m = 0; m < 4; ++m) _Pragma("unroll") for (int n = 0; n < 2; ++n) _Pragma("unroll") for (int k = 0; k < 2; ++k) \
        acc[ai][bj][m][n] = __builtin_amdgcn_mfma_f32_16x16x32_bf16(Bt[n][k], At[m][k], acc[ai][bj][m][n], 0, 0, 0); __builtin_amdgcn_s_setprio(0); } while (0)
#define PG8_WAIT_V(n) asm volatile("s_waitcnt vmcnt(" #n ")" ::: "memory")
#define PG8_WAIT_L(n) asm volatile("s_waitcnt lgkmcnt(" #n ")" ::: "memory")
#define PG8_BAR __builtin_amdgcn_s_barrier()
#define PG8_SCHED __builtin_amdgcn_sched_barrier(0)
    MUnit cur, nxt; int ui = 0;
    if (!S.next(0, cur)) return;
    f32x4 acc[2][2][4][2];
#pragma unroll
    for (int a = 0; a < 2; ++a)
#pragma unroll
        for (int b = 0; b < 2; ++b)
#pragma unroll
            for (int m = 0; m < 4; ++m)
#pragma unroll
                for (int n = 0; n < 2; ++n) acc[a][b][m][n] = (f32x4){0.f, 0.f, 0.f, 0.f};
    bf16x8 At[4][2], B0[2][2], B1[2][2];
    const char* cA = MF_ABASE(cur); const char* cB = MF_BBASE(cur); int ck = cur.kind;
    { const unsigned la = MF_LA(ck), lb = MF_LB(ck); unsigned voffA[2] = {Ra0 * la + C2, Ra0 * la + C2 + 64u * la}, voffB[2] = {Rb0 * lb + C2, Rb0 * lb + C2 + 64u * lb}; const size_t hsA = (size_t)128 * la, hsB = (size_t)128 * lb;
    PG8_STAGE(PG8_SB(0, 0), cB, voffB); PG8_STAGE(PG8_SB(0, 1), cB + hsB, voffB); PG8_STAGE(PG8_SA(0, 0), cA, voffA); PG8_STAGE(PG8_SA(0, 1), cA + hsA, voffA);
    if (wr == 1) PG8_BAR;
    PG8_WAIT_V(2); PG8_BAR;
    PG8_STAGE(PG8_SB(1, 0), cB + kstep, voffB); PG8_STAGE(PG8_SA(1, 0), cA + kstep, voffA); PG8_STAGE(PG8_SB(1, 1), cB + hsB + kstep, voffB);
    PG8_WAIT_V(6); PG8_BAR; }
    for (;;) {
        const bool has_next = S.next(ui + 1, nxt);
        const char* nA = cA; const char* nB = cB; int nk = ck;
        if (has_next) { nA = MF_ABASE(nxt); nB = MF_BBASE(nxt); nk = nxt.kind; }
        const int nt = ck ? nt1 : nt0;
        for (int t = 0; t < nt; t += 2) {
            const bool last = (t == nt - 2);
            const int kx = last ? nk : ck;
            const unsigned la1 = MF_LA(ck), lax = MF_LA(kx), lbx = MF_LB(kx);
            unsigned voffA1[2] = {Ra0 * la1 + C2, Ra0 * la1 + C2 + 64u * la1};
            unsigned voffA[2] = {Ra0 * lax + C2, Ra0 * lax + C2 + 64u * lax};
            unsigned voffB[2] = {Rb0 * lbx + C2, Rb0 * lbx + C2 + 64u * lbx};
            const size_t hsA1 = (size_t)128 * la1, hsA = (size_t)128 * lax, hsB = (size_t)128 * lbx;
            const char* a1 = cA + (size_t)(t + 1) * kstep;
            const char* a2 = last ? nA : cA + (size_t)(t + 2) * kstep; const char* b2 = last ? nB : cB + (size_t)(t + 2) * kstep;
            const char* a3 = a2 + kstep; const char* b3 = b2 + kstep;
            PG8_LDB(B0, 0, 0); PG8_LDB(B1, 0, 1); PG8_SCHED; PG8_LDA(At, 0, 0); PG8_STAGE(PG8_SA(1, 1), a1 + hsA1, voffA1);
            PG8_WAIT_V(8); PG8_WAIT_L(0); PG8_BAR; PG8_MMA(0, 0, At, B0); PG8_MMA(0, 1, At, B1); PG8_BAR; PG8_SCHED;
            PG8_LDA(At, 0, 1); PG8_STAGE(PG8_SB(0, 0), b2, voffB); PG8_STAGE(PG8_SB(0, 1), b2 + hsB, voffB); PG8_STAGE(PG8_SA(0, 0), a2, voffA);
            PG8_WAIT_V(8); PG8_WAIT_L(0); PG8_BAR; PG8_MMA(1, 0, At, B0); PG8_MMA(1, 1, At, B1); PG8_BAR; PG8_SCHED;
            PG8_LDB(B0, 1, 0); PG8_LDB(B1, 1, 1); PG8_SCHED; PG8_LDA(At, 1, 0); PG8_STAGE(PG8_SA(0, 1), a2 + hsA, voffA);
            PG8_WAIT_V(8); PG8_WAIT_L(0); PG8_BAR; PG8_MMA(0, 0, At, B0); PG8_MMA(0, 1, At, B1); PG8_BAR; PG8_SCHED;
            PG8_LDA(At, 1, 1); PG8_STAGE(PG8_SB(1, 0), b3, voffB); PG8_STAGE(PG8_SB(1, 1), b3 + hsB, voffB); PG8_STAGE(PG8_SA(1, 0), a3, voffA);
            PG8_WAIT_V(8); PG8_WAIT_L(0); PG8_BAR; PG8_MMA(1, 0, At, B0); PG8_MMA(1, 1, At, B1); PG8_BAR; PG8_SCHED;
        }
        if (wr == 0) PG8_BAR;
        cur.ui = ui; E(acc, cur, wr, wc, fr, fq);
        if (!has_next) break;
#pragma unroll
        for (int a = 0; a < 2; ++a)
#pragma unroll
            for (int b = 0; b < 2; ++b)
#pragma unroll
                for (int m = 0; m < 4; ++m)
#pragma unroll
                    for (int n = 0; n < 2; ++n) acc[a][b][m][n] = (f32x4){0.f, 0.f, 0.f, 0.f};
        cur = nxt; cA = nA; cB = nB; ck = nk; ++ui;
        if (wr == 1) PG8_BAR;
    }
    PG8_WAIT_V(0);
    PG8_BAR;
#undef MF_ABASE
#undef MF_BBASE
#undef MF_LA
#undef MF_LB
#undef PG8_SA
#undef PG8_SB
#undef PG8_STAGE
#undef PG8_LDA
#undef PG8_LDB
#undef PG8_MMA
#undef PG8_WAIT_V
#undef PG8_WAIT_L
#undef PG8_BAR
#undef PG8_SCHED
}

#define EPI_ROWS_BEGIN _Pragma("unroll") for (int ai = 0; ai < 2; ++ai) _Pragma("unroll") for (int m = 0; m < 4; ++m) { const int row = u.pm * 256 + ai * 128 + wr * 64 + m * 16 + fr;
#define EPI_ROWS_END if (m & 1) asm volatile("" ::: "memory"); }
typedef const f32x4 (&AccRef)[2][2][4][2];

struct EpiInproj {
    bf16_t *u1, *ua, *ub; const LAS unsigned char* lds_rs;
    __device__ __forceinline__ void operator()(AccRef acc, const Unit& u, int wr, int wc, int fr, int fq) const {
        bf16_t* base; int ld, ct; const int pn = u.pn;
        if (pn < 4) { base = u1; ld = 1024; ct = pn; } else if (pn < 7) { base = ua; ld = 768; ct = pn - 4; } else { base = ub; ld = 1792; ct = pn - 7; }
        const int col0 = ct * 256 + wc * 32 + 8 * fq;
        EPI_ROWS_BEGIN
            const float r = RSL(u, row);
#pragma unroll
            for (int bj = 0; bj < 2; ++bj) *(u32x4*)(base + (size_t)row * ld + col0 + bj * 128) = pack8(acc[ai][bj][m][0] * r, acc[ai][bj][m][1] * r);
        EPI_ROWS_END
    }
};
struct EpiQ {
    bf16_t *y, *qr; const float* rsq; const f32x2* cs;
    __device__ __forceinline__ void operator()(AccRef acc, const Unit& u, int wr, int wc, int fr, int fq) const {
        const int pn = u.pn;
        EPI_ROWS_BEGIN
            const float r = rsq[row] * QSCALE;
#pragma unroll
            for (int bj = 0; bj < 2; ++bj) {
                f32x4 v0 = acc[ai][bj][m][0] * r, v1 = acc[ai][bj][m][1] * r;
                if (pn < 2) { *(u32x4*)(y + (size_t)row * 2048 + pn * 256 + bj * 128 + wc * 32 + 8 * fq) = pack8(v0, v1); }
                else {
                    const int c0 = bj * 128 + wc * 32 + 8 * fq, i0 = (c0 & 31) >> 1;
                    const f32x4* cp = (const f32x4*)(cs + (size_t)row * 16 + i0);
                    const f32x4 t0 = cp[0], t1 = cp[1];
                    f32x4 o0, o1;
                    o0[0] = v0[0] * t0[0] - v0[1] * t0[1]; o0[1] = v0[1] * t0[0] + v0[0] * t0[1];
                    o0[2] = v0[2] * t0[2] - v0[3] * t0[3]; o0[3] = v0[3] * t0[2] + v0[2] * t0[3];
                    o1[0] = v1[0] * t1[0] - v1[1] * t1[1]; o1[1] = v1[1] * t1[0] + v1[0] * t1[1];
                    o1[2] = v1[2] * t1[2] - v1[3] * t1[3]; o1[3] = v1[3] * t1[2] + v1[2] * t1[3];
                    *(u32x4*)(qr + (size_t)row * 256 + c0) = pack8(o0, o1);
                }
            }
        EPI_ROWS_END
    }
};
struct EpiRowScale {
    bf16_t* o0; int ld; const float* rs; size_t split;
    __device__ __forceinline__ void operator()(AccRef acc, const Unit& u, int wr, int wc, int fr, int fq) const {
        bf16_t* o = split ? o0 + (size_t)(u.pn >> 2) * split : o0;
        const int col0 = (split ? (u.pn & 3) : u.pn) * 256 + wc * 32 + 8 * fq;
        EPI_ROWS_BEGIN
            const float r = rs ? rs[row] : 1.f;
#pragma unroll
            for (int bj = 0; bj < 2; ++bj) *(u32x4*)(o + (size_t)row * ld + col0 + bj * 128) = pack8(acc[ai][bj][m][0] * r, acc[ai][bj][m][1] * r);
        EPI_ROWS_END
    }
};
struct EpiLru {
    bf16_t* y3; bf16_t* la; const float *b_a, *b_i, *lam;
    __device__ __forceinline__ void operator()(AccRef acc, const Unit& u, int wr, int wc, int fr, int fq) const {
#pragma unroll
        for (int n = 0; n < 2; ++n) {
            const int ch0 = u.pn * 128 + wc * 32 + 8 * fq + 4 * n;
            const f32x4 ba = *(const f32x4*)(b_a + ch0), bi = *(const f32x4*)(b_i + ch0), lm = *(const f32x4*)(lam + ch0);
            f32x4 sp;
#pragma unroll
            for (int e = 0; e < 4; ++e) sp[e] = -8.f * log1pf(__expf(-lm[e]));
            EPI_ROWS_BEGIN
                bf16_t* xp = y3 + (size_t)row * 2048 + ch0;
                const u32x2 xw = *(const u32x2*)xp;
                const f32x4 xc = (f32x4){bflo(xw.x), bfhi(xw.x), bflo(xw.y), bfhi(xw.y)};
                f32x4 uo, lo;
#pragma unroll
                for (int e = 0; e < 4; ++e) {
                    const float rr = acc[ai][0][m][n][e] + ba[e], ii = acc[ai][1][m][n][e] + bi[e];
                    const float log_a = sp[e] * sigmoidf_(rr);
                    const float mult = sqrtf(one_minus_exp(2.f * log_a));
                    uo[e] = xc[e] * sigmoidf_(ii) * mult; lo[e] = log_a;
                }
                u32x2 w0, w1; w0.x = cvt_pk_bf16(uo[0], uo[1]); w0.y = cvt_pk_bf16(uo[2], uo[3]); w1.x = cvt_pk_bf16(lo[0], lo[1]); w1.y = cvt_pk_bf16(lo[2], lo[3]);
                *(u32x2*)xp = w0;
                *(u32x2*)(la + (size_t)row * 512 + ch0) = w1;
                asm volatile("" ::: "memory");
            EPI_ROWS_END
        }
    }
};
struct EpiGate {
    const LAS unsigned char* lds_rs; const bf16_t* tall; bf16_t* mb; const float* rsc;
    __device__ __forceinline__ void operator()(AccRef acc, const Unit& u, int wr, int wc, int fr, int fq) const {
        const int n = u.pn >> 2; const bf16_t* tn = tall + (size_t)n * 64 * MiB / 2; const float* trs = (n == 2) ? rsc : nullptr;
        const int col0 = (u.pn & 3) * 256 + wc * 32 + 8 * fq;
        u32x4 tq[2][4][2];
#pragma unroll
        for (int ai = 0; ai < 2; ++ai)
#pragma unroll
            for (int m = 0; m < 4; ++m)
#pragma unroll
                for (int bj = 0; bj < 2; ++bj) tq[ai][m][bj] = *(const u32x4*)(tn + (size_t)(u.pm * 256 + ai * 128 + wr * 64 + m * 16 + fr) * 1024 + col0 + bj * 128);
        EPI_ROWS_BEGIN
            const float r = RSL(u, row); const float ts = trs ? trs[row] : 1.f;
#pragma unroll
            for (int bj = 0; bj < 2; ++bj) {
                const size_t off = (size_t)row * 1024 + col0 + bj * 128;
                f32x4 t0, t1; unpack8(tq[ai][m][bj], t0, t1); t0 = t0 * ts; t1 = t1 * ts;
                f32x4 g0 = acc[ai][bj][m][0] * r, g1 = acc[ai][bj][m][1] * r;
#pragma unroll
                for (int e = 0; e < 4; ++e) { g0[e] = sigmoidf_(g0[e]) * t0[e]; g1[e] = sigmoidf_(g1[e]) * t1[e]; }
                if (n > 0) { f32x4 p0, p1; unpack8(*(const u32x4*)(mb + off), p0, p1); g0 += p0; g1 += p1; }
                *(u32x4*)(mb + off) = pack8(g0, g1);
            }
        EPI_ROWS_END
    }
};
struct EpiMerge {
    const LAS unsigned char* lds_rs; bf16_t* tall; bf16_t* mb;
    __device__ __forceinline__ void operator()(AccRef acc, const MUnit& u, int wr, int wc, int fr, int fq) const {
        const int n = u.n; bf16_t* tn = tall;
        const int col0 = u.pn * 256 + wc * 32 + 8 * fq;
        if (u.kind == 0) {
            EPI_ROWS_BEGIN
#pragma unroll
                for (int bj = 0; bj < 2; ++bj) *(u32x4*)(tn + (size_t)row * 1024 + col0 + bj * 128) = pack8(acc[ai][bj][m][0], acc[ai][bj][m][1]);
            EPI_ROWS_END
        } else {
            const LAS float* rsl = (const LAS float*)(lds_rs + RSL_OFF) + (u.ui >> 3) * 256;
            u32x4 tq[2][4][2];
#pragma unroll
            for (int ai = 0; ai < 2; ++ai)
#pragma unroll
                for (int m = 0; m < 4; ++m)
#pragma unroll
                    for (int bj = 0; bj < 2; ++bj) tq[ai][m][bj] = *(const u32x4*)(tn + (size_t)(u.pm * 256 + ai * 128 + wr * 64 + m * 16 + fr) * 1024 + col0 + bj * 128);
            EPI_ROWS_BEGIN
                const float r = rsl[row & 255]; const float ts = (n == 2) ? rsl[1024 + (row & 255)] : 1.f;
#pragma unroll
                for (int bj = 0; bj < 2; ++bj) {
                    const size_t off = (size_t)row * 1024 + col0 + bj * 128;
                    f32x4 t0, t1; unpack8(tq[ai][m][bj], t0, t1); t0 = t0 * ts; t1 = t1 * ts;
                    f32x4 g0 = acc[ai][bj][m][0] * r, g1 = acc[ai][bj][m][1] * r;
#pragma unroll
                    for (int e = 0; e < 4; ++e) { g0[e] = sigmoidf_(g0[e]) * t0[e]; g1[e] = sigmoidf_(g1[e]) * t1[e]; }
                    if (n > 0) { f32x4 p0, p1; unpack8(*(const u32x4*)(mb + off), p0, p1); g0 += p0; g1 += p1; }
                    *(u32x4*)(mb + off) = pack8(g0, g1);
                }
            EPI_ROWS_END
        }
    }
};
__device__ __forceinline__ void merge_prepass(LAS unsigned char* lds, const float* ssq, const float* ssqc, const MergeOrder& S, int tid_) {
    asm volatile("" : "+v"(tid_));
    LAS float* rsl = (LAS float*)(lds + RSL_OFF); Unit t;
    const int ti = tid_ >> 8, rr = tid_ & 255;
    if (S.base.next(ti, t)) { const int row = t.pm * 256 + rr; rsl[ti * 256 + rr] = rstd16(ssq, row);
        const f32x4* p = (const f32x4*)(ssqc + (size_t)row * 16); const f32x4 a = p[0], b = p[1], c = p[2], d = p[3]; const f32x4 q = (a + b) + (c + d);
        rsl[1024 + ti * 256 + rr] = rsqrtf(((q[0] + q[1]) + (q[2] + q[3])) * (1.f / 512.f) + EPS); }
    __syncthreads();
}
template <int MODE  > struct EpiRes {
    const float* xold; float* xf; bf16_t* xb; float* ssq_out; const LAS unsigned char* lds_rs; const bf16_t* tp;
    __device__ __forceinline__ void operator()(AccRef acc, const Unit& u, int wr, int wc, int fr, int fq) const {
        const int col0 = u.pn * 256 + wc * 32 + 8 * fq;
        EPI_ROWS_BEGIN
            float r = 1.f; if (MODE == 1) r = RSL(u, row);
            float ss = 0.f;
#pragma unroll
            for (int bj = 0; bj < 2; ++bj) {
                const size_t off = (size_t)row * 1024 + col0 + bj * 128;
                f32x4 a0 = acc[ai][bj][m][0], a1 = acc[ai][bj][m][1];
                if (MODE == 1) { f32x4 t0, t1; unpack8(*(const u32x4*)(tp + off), t0, t1);
#pragma unroll
                    for (int e = 0; e < 4; ++e) { a0[e] = sigmoidf_(a0[e] * r) * t0[e]; a1[e] = sigmoidf_(a1[e] * r) * t1[e]; } }
                const f32x4 n0 = *(const f32x4*)(xold + off) + a0, n1 = *(const f32x4*)(xold + off + 4) + a1;
                *(f32x4*)(xf + off) = n0; *(f32x4*)(xf + off + 4) = n1;
                if (MODE == 0) *(u32x4*)(xb + off) = pack8(n0, n1);
                ss += (n0[0] * n0[0] + n0[1] * n0[1]) + (n0[2] * n0[2] + n0[3] * n0[3]) + (n1[0] * n1[0] + n1[1] * n1[1]) + (n1[2] * n1[2] + n1[3] * n1[3]);
            }
            ss += __shfl_xor(ss, 16); ss = xhalf_sum(ss);
            if (fq == 0) ssq_out[(size_t)row * 16 + u.pn * 4 + wc] = ss;
        EPI_ROWS_END
    }
};
struct EpiFF1 {
    bf16_t* h; const LAS unsigned char* lds_rs;
    __device__ __forceinline__ void operator()(AccRef acc, const Unit& u, int wr, int wc, int fr, int fq) const {
        const int col0 = u.pn * 256 + wc * 32 + 8 * fq;
        EPI_ROWS_BEGIN
            const float r = RSL(u, row);
#pragma unroll
            for (int bj = 0; bj < 2; ++bj) {
                f32x4 a0 = acc[ai][bj][m][0] * r, a1 = acc[ai][bj][m][1] * r;
#pragma unroll
                for (int e = 0; e < 4; ++e) { const float p = fmaxf(a0[e], 0.f), q = fmaxf(a1[e], 0.f); a0[e] = p * p; a1[e] = q * q; }
                *(u32x4*)(h + (size_t)row * 4096 + col0 + bj * 128) = pack8(a0, a1);
            }
        EPI_ROWS_END
    }
};
}

__device__ __forceinline__ void conv_weights(PP P, int l, bf16_t* W, int tid_, int bid_, int ngt, LAS unsigned char* lds) {
    asm volatile("" : "+v"(tid_)); const int gt = bid_ * 512 + tid_;
    if (l == 0 && gt < 64) ((unsigned*)P->ws)[64 + gt] = 0u;
    const float* g_mix = P->in[3] + l * 1024; const float* w_in = P->in[4] + (size_t)l * 1024 * INC;
    const float* q_norm = P->in[5] + l * 384; const float* w_uq = P->in[6] + (size_t)l * 384 * 768;
    const float* kv_norm = P->in[7] + l * 256; const float* w_ukv = P->in[8] + (size_t)l * 256 * 1024;
    const float* w_pool = P->in[9] + (size_t)l * 4 * 128 * 128; const float* pool_scale = P->in[10] + l * 512;
    const float* ssd_norm = P->in[16] + l * 512;
    const float* w_a = P->in[19] + (size_t)l * 8 * 64 * 64; const float* w_i = P->in[21] + (size_t)l * 8 * 64 * 64;
    const float* w_branch = P->in[24] + (size_t)l * 4 * 512 * 1024; const float* w_out = P->in[25] + (size_t)l * 1024 * 1024;
    const float* g_mlp = P->in[26] + l * 1024; const float* w_ff1 = P->in[27] + (size_t)l * 1024 * 4096; const float* w_ff2 = P->in[28] + (size_t)l * 4096 * 1024;
    const float* g_ple = P->in[29] + l * 1024; const float* w_pg = P->in[30] + (size_t)l * 1024 * 1024; const float* w_ple = P->in[31] + (size_t)l * 256 * 1024;
    constexpr int TOTAL_ITEMS = (int)(W_TOTAL / 2048);
    const int wave_ = tid_ >> 6, lane = tid_ & 63;
    LAS float* scr = (LAS float*)(lds + wave_ * 8448);
    for (int item = bid_ * 8 + wave_; item < TOTAL_ITEMS; item += ngt / 64) {
        const long e = (long)item * 2048;
        int N, K; size_t base; int mat;
        if (e < (long)W_G) { mat = 0; base = W_IN; N = 3584; K = 1024; }
        else if (e < (long)W_UQ) { mat = 1; base = W_G; N = 4096; K = 1024; }
        else if (e < (long)W_UKV) { mat = 2; base = W_UQ; N = 768; K = 384; }
        else if (e < (long)W_POOL) { mat = 3; base = W_UKV; N = 1024; K = 256; }
        else if (e < (long)W_LRU) { mat = 4; base = W_POOL; N = 512; K = 256; }
        else if (e < (long)W_BR) { mat = 5; base = W_LRU; N = 1024; K = 128; }
        else if (e < (long)W_OUT) { mat = 6; base = W_BR; N = 4096; K = 512; }
        else if (e < (long)W_FF1) { mat = 7; base = W_OUT; N = 1024; K = 1024; }
        else if (e < (long)W_FF2) { mat = 8; base = W_FF1; N = 4096; K = 1024; }
        else if (e < (long)W_PG) { mat = 9; base = W_FF2; N = 1024; K = 4096; }
        else if (e < (long)W_PLE) { mat = 10; base = W_PG; N = 1024; K = 1024; }
        else { mat = 11; base = W_PLE; N = 1024; K = 256; }
        const int idx = item - (int)(base / 2048), nblk = N / 32, n0 = (idx % nblk) * 32, k0 = (idx / nblk) * 64;
        const int n = n0 + (lane & 31);
        const float* ptr = nullptr; int stride = 0; const float* gk = nullptr; float sn = 1.f; bool valid = true;
        switch (mat) {
        case 0: { int sc;
            if (n < 512) sc = 1184 + n; else if (n < 1024) sc = 2472 + (n - 512);
            else if (n < 1408) sc = n - 1024; else if (n < 1664) sc = 384 + (n - 1408); else if (n < 1696) sc = 640 + (n - 1664);
            else if (n < 1704) sc = 2464 + (n - 1696); else if (n < 1792) { sc = 0; valid = false; }
            else { const int q = n - 1792; if (q < 512) sc = 672 + q; else if (q < 1280) sc = 1696 + (q - 512); else sc = 2984 + (q - 1280); }
            ptr = w_in + (size_t)k0 * INC + sc; stride = INC; gk = g_mix + k0; } break;
        case 1: ptr = w_in + (size_t)k0 * INC + 3496 + n; stride = INC; gk = g_mix + k0; break;
        case 2: { int sc; if (n < 512) sc = (n >> 6) * 96 + (n & 63); else { const int q = n - 512, hd = q >> 5, jj = q & 31; sc = hd * 96 + 64 + (jj & 1) * 16 + (jj >> 1); }
            ptr = w_uq + (size_t)k0 * 768 + sc; stride = 768; gk = q_norm + k0; } break;
        case 3: { int sc; if (n < 512) sc = (n >> 6) * 128 + (n & 63); else { const int q = n - 512; sc = (q >> 6) * 128 + 64 + (q & 63); }
            ptr = w_ukv + (size_t)k0 * 1024 + sc; stride = 1024; gk = kv_norm + k0; } break;
        case 4: { const int g = n >> 7, j = n & 127, pn = n >> 8, gk_ = 2 * pn + (k0 >> 7), i0 = k0 & 127; valid = (gk_ == g);
            ptr = w_pool + (size_t)g * 16384 + i0 * 128 + j; stride = 128; sn = pool_scale[n]; } break;
        case 5: { const int pn = n >> 8, bj = (n & 255) >> 7, ch = 128 * pn + (n & 127), hb = ch >> 6, j = ch & 63, hbk = 2 * pn + (k0 >> 6), i0 = k0 & 63; valid = (hbk == hb);
            ptr = (bj ? w_i : w_a) + (size_t)hb * 4096 + i0 * 64 + j; stride = 64; } break;
        case 6: { const int br = n >> 10, nn = n & 1023; ptr = w_branch + (size_t)br * 512 * 1024 + (size_t)k0 * 1024 + nn; stride = 1024; if (br == 2) gk = ssd_norm + k0; } break;
        case 7: ptr = w_out + (size_t)k0 * 1024 + n; stride = 1024; break;
        case 8: ptr = w_ff1 + (size_t)k0 * 4096 + n; stride = 4096; gk = g_mlp + k0; break;
        case 9: ptr = w_ff2 + (size_t)k0 * 1024 + n; stride = 1024; break;
        case 10: ptr = w_pg + (size_t)k0 * 1024 + n; stride = 1024; gk = g_ple + k0; break;
        default: ptr = w_ple + (size_t)k0 * 1024 + n; stride = 1024; break;
        }
        const int kh = lane >> 5;
#pragma unroll 8
        for (int i = 0; i < 32; ++i) { const int kk = 2 * i + kh; float x = 0.f; if (valid) { x = ptr[(size_t)kk * stride] * sn; if (gk) x *= gk[kk]; } scr[kk * 33 + (lane & 31)] = x; }
        asm volatile("s_waitcnt lgkmcnt(0)" ::: "memory");
        const int c = lane & 7;
#pragma unroll
        for (int jj = 0; jj < 4; ++jj) { const int nn = (lane >> 3) + 8 * jj; const LAS float* sp_ = scr + (8 * c) * 33 + nn;
            u32x4 o; o.x = cvt_pk_bf16(sp_[0], sp_[33]); o.y = cvt_pk_bf16(sp_[66], sp_[99]); o.z = cvt_pk_bf16(sp_[132], sp_[165]); o.w = cvt_pk_bf16(sp_[198], sp_[231]);
            *(u32x4*)(W + base + (size_t)(n0 + nn) * K + k0 + 8 * c) = o; }
        asm volatile("s_waitcnt lgkmcnt(0)" ::: "memory");
    }
}

__device__ __forceinline__ void p0_rows(PP P, const float* x, bool first, bf16_t* XB, float* ssq, f32x2* CS, int gw, int ngw, int tid_) {
    asm volatile("" : "+v"(tid_)); const int lane = tid_ & 63;
    const int* pos = (const int*)P->in[2];
    for (int mb = gw; mb < M; mb += 4 * ngw) {
        f32x4 v[4][4];
#pragma unroll
        for (int u = 0; u < 4; ++u) { const f32x4* xr = (const f32x4*)(x + (size_t)(mb + u * ngw) * D) + lane;
#pragma unroll
            for (int j = 0; j < 4; ++j) v[u][j] = xr[64 * j]; }
#pragma unroll
        for (int u = 0; u < 4; ++u) { const int m = mb + u * ngw; u32x2* o = (u32x2*)(XB + (size_t)m * D) + lane; float s = 0.f;
#pragma unroll
            for (int j = 0; j < 4; ++j) { const f32x4 t = v[u][j]; s += (t[0] * t[0] + t[1] * t[1]) + (t[2] * t[2] + t[3] * t[3]); u32x2 w; w.x = cvt_pk_bf16(t[0], t[1]); w.y = cvt_pk_bf16(t[2], t[3]); o[64 * j] = w; }
            if (first) {
                s = wave_sum(s);
                if (lane < 16) {
                    ssq[(size_t)m * 16 + lane] = (lane == 0) ? s : 0.f;
                    const double ang = (double)pos[m] * P->inv_freq[lane];
                    const double k = rint(ang * 0.15915494309189535);
                    const float r = (float)(ang - k * 6.283185307179586);
                    f32x2 cs_; cs_[0] = cosf(r); cs_[1] = sinf(r);
                    CS[(size_t)m * 16 + lane] = cs_;
                }
            }
        }
    }
}

__device__ __forceinline__ void p2_pool_block(const bf16_t* UB, bf16_t* Y, int m0, int lane) {
    const int g = lane >> 4, w = 2 << g, t0 = m0 & (SEQ - 1);
    const bf16_t* base = UB + (size_t)m0 * 1792 + lane * 8;
    bf16_t* ob = Y + (size_t)m0 * 2048 + 512 + lane * 8;
    u32x4 prev[16];
#pragma unroll
    for (int j = 0; j < 16; ++j) { prev[j] = (u32x4){0u, 0u, 0u, 0u}; if (t0 > 0) prev[j] = *(const u32x4*)(base - (size_t)(16 - j) * 1792); }
    f32x4 s0 = {0.f, 0.f, 0.f, 0.f}, s1 = {0.f, 0.f, 0.f, 0.f};
#pragma unroll
    for (int j = 0; j < 16; ++j) { f32x4 a, b; unpack8(prev[j], a, b); const float mk = (16 - j <= w) ? 1.f : 0.f; s0 += a * mk; s1 += b * mk; }
    for (int bt = 0; bt < 4; ++bt) {
        u32x4 cur[16];
#pragma unroll
        for (int j = 0; j < 16; ++j) cur[j] = *(const u32x4*)(base + (size_t)(bt * 16 + j) * 1792);
#pragma unroll
        for (int j = 0; j < 16; ++j) {
            const u32x4 o2 = (j >= 2) ? cur[j >= 2 ? j - 2 : 0] : prev[14 + j < 16 ? 14 + j : 15];
            const u32x4 o4 = (j >= 4) ? cur[j >= 4 ? j - 4 : 0] : prev[12 + j < 16 ? 12 + j : 15];
            const u32x4 o8 = (j >= 8) ? cur[j >= 8 ? j - 8 : 0] : prev[8 + j < 16 ? 8 + j : 15];
            const u32x4 o16 = prev[j];
            u32x4 os;
            os.x = g == 0 ? o2.x : g == 1 ? o4.x : g == 2 ? o8.x : o16.x; os.y = g == 0 ? o2.y : g == 1 ? o4.y : g == 2 ? o8.y : o16.y;
            os.z = g == 0 ? o2.z : g == 1 ? o4.z : g == 2 ? o8.z : o16.z; os.w = g == 0 ? o2.w : g == 1 ? o4.w : g == 2 ? o8.w : o16.w;
            f32x4 c0, c1, q0, q1; unpack8(cur[j], c0, c1); unpack8(os, q0, q1);
            s0 += c0 - q0; s1 += c1 - q1;
            const int t = t0 + bt * 16 + j; const int cnt = (t + 1) < w ? (t + 1) : w; const float inv = __builtin_amdgcn_rcpf((float)cnt);
            *(u32x4*)(ob + (size_t)(bt * 16 + j) * 2048) = pack8(s0 * inv - c0, s1 * inv - c1);
        }
#pragma unroll
        for (int j = 0; j < 16; ++j) prev[j] = cur[j];
    }
}
__device__ __forceinline__ void p2_conv_block(const bf16_t* src, int m0, bool active, const float* wgt, int wp, const float* bias, bool silu, bf16_t* out, int opitch) {
    if (!active) return;
    const int t0 = m0 & (SEQ - 1);
    const bf16_t* base = src + (size_t)m0 * 1792; bf16_t* ob = out + (size_t)m0 * opitch;
    f32x4 w0[4], w1[4];
#pragma unroll
    for (int k = 0; k < 4; ++k) { w0[k] = *(const f32x4*)(wgt + k * wp); w1[k] = *(const f32x4*)(wgt + k * wp + 4); }
    const f32x4 b0 = *(const f32x4*)bias, b1 = *(const f32x4*)(bias + 4);
    u32x4 p3[3];
#pragma unroll
    for (int j = 0; j < 3; ++j) { p3[j] = (u32x4){0u, 0u, 0u, 0u}; if (t0 > 0) p3[j] = *(const u32x4*)(base - (size_t)(3 - j) * 1792); }
    for (int bt = 0; bt < 4; ++bt) {
        u32x4 cur[16];
#pragma unroll
        for (int j = 0; j < 16; ++j) cur[j] = *(const u32x4*)(base + (size_t)(bt * 16 + j) * 1792);
#pragma unroll
        for (int j = 0; j < 16; ++j) {
            f32x4 a0 = b0, a1 = b1;
#pragma unroll
            for (int k = 0; k < 4; ++k) { const int jj = j - 3 + k; const u32x4 rw = (jj >= 0) ? cur[jj >= 0 ? jj : 0] : p3[jj < 0 ? 3 + jj : 0];
                f32x4 x0, x1; unpack8(rw, x0, x1); a0 += x0 * w0[k]; a1 += x1 * w1[k]; }
            if (silu) {
#pragma unroll
                for (int e = 0; e < 4; ++e) { a0[e] = a0[e] * sigmoidf_(a0[e]); a1[e] = a1[e] * sigmoidf_(a1[e]); } }
            *(u32x4*)(ob + (size_t)(bt * 16 + j) * opitch) = pack8(a0, a1);
        }
        p3[0] = cur[13]; p3[1] = cur[14]; p3[2] = cur[15];
    }
}
__device__ __forceinline__ void p2_prep(PP P, int l, unsigned char* ws, int gw, int ngw, int tid_) {
    asm volatile("" : "+v"(tid_)); const int lane = tid_ & 63;
    const bf16_t* UA = (const bf16_t*)(ws + B_UA); const bf16_t* UB = (const bf16_t*)(ws + B_UB);
    bf16_t* Y = (bf16_t*)(ws + WS_Y); bf16_t* BC = (bf16_t*)(ws + B_BC); bf16_t* KR = (bf16_t*)(ws + B_KR);
    float* RSQ = (float*)(ws + WS_RSQ); float* RSKV = (float*)(ws + WS_RSKV); float* DTF = (float*)(ws + WS_DTF); const f32x2* CS = (const f32x2*)(ws + WS_CS);
    const float* scw = P->in[11] + l * 4 * 768; const float* scb = P->in[12] + l * 768; const float* dtb = P->in[13] + l * 8;
    const float* lcw = P->in[17] + l * 4 * 512; const float* lcb = P->in[18] + l * 512;
    for (int mb = gw; mb < M; mb += 4 * ngw) {
        u32x4 q4[4], k4[4]; float x1[4], x2[4], dtr[4]; f32x2 cc[4];
#pragma unroll
        for (int u = 0; u < 4; ++u) { const int m = M - 1 - (mb + u * ngw); const bf16_t* ua = UA + (size_t)m * 768;
            q4[u] = (u32x4){0u, 0u, 0u, 0u}; k4[u] = (u32x4){0u, 0u, 0u, 0u}; x1[u] = 0.f; x2[u] = 0.f; dtr[u] = 0.f; cc[u] = (f32x2){0.f, 0.f};
            if (lane < 48) q4[u] = *(const u32x4*)(ua + lane * 8);
            if (lane < 32) k4[u] = *(const u32x4*)(ua + 384 + lane * 8);
            if (lane < 16) { x1[u] = bf2f(ua[640 + lane]); x2[u] = bf2f(ua[656 + lane]); cc[u] = CS[(size_t)m * 16 + lane]; }
            if (lane < 8) dtr[u] = bf2f(ua[672 + lane]); }
#pragma unroll
        for (int u = 0; u < 4; ++u) { const int m = M - 1 - (mb + u * ngw);
            f32x4 a, b; unpack8(q4[u], a, b); float s = (a[0]*a[0]+a[1]*a[1])+(a[2]*a[2]+a[3]*a[3])+(b[0]*b[0]+b[1]*b[1])+(b[2]*b[2]+b[3]*b[3]);
            unpack8(k4[u], a, b); float s2 = (a[0]*a[0]+a[1]*a[1])+(a[2]*a[2]+a[3]*a[3])+(b[0]*b[0]+b[1]*b[1])+(b[2]*b[2]+b[3]*b[3]);
            s = wave_sum(s); s2 = wave_sum(s2);
            if (lane == 0) { RSQ[m] = rsqrtf(s * (1.f / 384.f) + EPS); RSKV[m] = rsqrtf(s2 * (1.f / 256.f) + EPS); }
            if (lane < 16) *(unsigned*)(KR + (size_t)m * 32 + 2 * lane) = cvt_pk_bf16(x1[u] * cc[u][0] - x2[u] * cc[u][1], x2[u] * cc[u][0] + x1[u] * cc[u][1]);
            if (lane < 8) { const float v = dtr[u] + dtb[lane]; DTF[(size_t)m * 8 + lane] = v > 20.f ? v : log1pf(__expf(v)); } }
    }
    for (int wt = gw; wt < 2048; wt += ngw) {
        const int rb = 511 - (wt >> 2), cgp = wt & 3, m0 = rb * 64;
        if (cgp == 0) p2_pool_block(UB, Y, m0, lane);
        else if (cgp == 1) p2_conv_block(UB + 512 + 8 * lane, m0, true, scw + 8 * lane, 768, scb + 8 * lane, true, Y + 1024 + 8 * lane, 2048);
        else if (cgp == 2) p2_conv_block(UB + 1024 + 8 * (lane & 31), m0, lane < 32, scw + 512 + 8 * (lane & 31), 768, scb + 512 + 8 * (lane & 31), true, BC + 8 * (lane & 31), 256);
        else p2_conv_block(UB + 1280 + 8 * lane, m0, true, lcw + 8 * lane, 512, lcb + 8 * lane, false, Y + 1536 + 8 * lane, 2048);
    }
}

__device__ __forceinline__ void rstd_c_rows(unsigned char* ws, int gw, int ngw, int tid_) {
    asm volatile("" : "+v"(tid_)); const int lane = tid_ & 63;
    const bf16_t* Y = (const bf16_t*)(ws + WS_Y); float* RSC = (float*)(ws + WS_RSC);
    for (int m = gw; m < M; m += ngw) { f32x4 a, b; unpack8(*(const u32x4*)(Y + (size_t)m * 2048 + 1024 + lane * 8), a, b);
        float s = (a[0]*a[0]+a[1]*a[1])+(a[2]*a[2]+a[3]*a[3])+(b[0]*b[0]+b[1]*b[1])+(b[2]*b[2]+b[3]*b[3]); s = wave_sum(s);
        if (lane == 0) RSC[m] = rsqrtf(s * (1.f / 512.f) + EPS); }
}
__device__ __forceinline__ void conv_p(PP P, int l, bf16_t* PB, int tid_, int bid_, int ngt) {
    asm volatile("" : "+v"(tid_)); const int gt = bid_ * 512 + tid_;
    const f32x4* src = (const f32x4*)(P->in[1] + (size_t)l * M * 256);
    for (long c = gt; c < (long)M * 256 / 8; c += 4L * ngt) {
        f32x4 a[4], b[4];
#pragma unroll
        for (int u = 0; u < 4; ++u) { const long cc = c + (long)u * ngt; a[u] = src[2 * cc]; b[u] = src[2 * cc + 1]; }
#pragma unroll
        for (int u = 0; u < 4; ++u) { const long cc = c + (long)u * ngt; *(u32x4*)(PB + cc * 8) = pack8(a[u], b[u]); }
    }
}
__device__ __forceinline__ void final_norm(PP P, const float* ssq, int gw, int ngw, int tid_) {
    asm volatile("" : "+v"(tid_)); const int lane = tid_ & 63;
    const f32x4* gf = (const f32x4*)P->in[32];
    f32x4 g4[4];
#pragma unroll
    for (int j = 0; j < 4; ++j) g4[j] = gf[64 * j + lane];
    for (int mb = gw; mb < M; mb += 4 * ngw) {
        f32x4 v[4][4]; float r[4];
#pragma unroll
        for (int u = 0; u < 4; ++u) { const int m = mb + u * ngw; r[u] = 0.f;
            if (m < M) { const f32x4* xr = (const f32x4*)(P->out + (size_t)m * D) + lane; r[u] = rstd16(ssq, m);
#pragma unroll
                for (int j = 0; j < 4; ++j) v[u][j] = xr[64 * j]; } }
#pragma unroll
        for (int u = 0; u < 4; ++u) { const int m = mb + u * ngw;
            if (m < M) { f32x4* xr = (f32x4*)(P->out + (size_t)m * D) + lane;
#pragma unroll
                for (int j = 0; j < 4; ++j) xr[64 * j] = v[u][j] * r[u] * g4[j]; } }
    }
}


typedef float f32x16 __attribute__((ext_vector_type(16)));
__device__ __forceinline__ unsigned pk2c(float lo, float hi) { f32x2 v = {lo, hi}; bf16x2_t b = __builtin_convertvector(v, bf16x2_t); return __builtin_bit_cast(unsigned, b); }
constexpr int AT_KP = 208, AT_VP = 192, AT_KB = 64 * AT_KP, AT_VB = 64 * AT_VP, AT_BUF = AT_KB + AT_VB;
typedef short v4i16_t __attribute__((ext_vector_type(4)));
__device__ __forceinline__ void attn_unit(unsigned char* ws, LAS unsigned char* lds, int b, int h, int qb, int wave, int tid_, bf16_t* Obase, int opitch) {
    asm volatile("" : "+v"(tid_));
    const int lane = tid_ & 63, r = lane & 31, hh = lane >> 5;
    bf16_t* Y = (bf16_t*)(ws + WS_Y); const bf16_t* QR = (const bf16_t*)(ws + B_QR); const bf16_t* KV = (const bf16_t*)(ws + B_KV); const bf16_t* KR = (const bf16_t*)(ws + B_KR);
    const int q0 = qb * 256, qw0 = q0 + wave * 32;
    const size_t mrow = (size_t)b * SEQ + qw0 + r;
    bf16x8 qf[6];
#pragma unroll
    for (int ks = 0; ks < 4; ++ks) qf[ks] = *(const bf16x8*)(Y + mrow * 2048 + h * 64 + 16 * ks + 8 * hh);
#pragma unroll
    for (int ks = 0; ks < 2; ++ks) qf[4 + ks] = *(const bf16x8*)(QR + mrow * 256 + h * 32 + 16 * ks + 8 * hh);
    f32x16 o0, o1;
#pragma unroll
    for (int i = 0; i < 16; ++i) { o0[i] = 0.f; o1[i] = 0.f; }
    float mx = -1e30f, lsum = 0.f;
    const int nkt = (q0 + 256) / 64;
    const int skv = tid_ >> 3, sc = tid_ & 7;
    const int rkv = tid_ >> 2, rc = tid_ & 3;
    const bf16_t* gk = KV + ((size_t)b * SEQ + skv) * 1024 + h * 64 + sc * 8;
    const bf16_t* gv = gk + 512;
    const bf16_t* gr = KR + ((size_t)b * SEQ + rkv) * 32 + rc * 8;
    u32x4 rk, rv, rr;
    rk = *(const u32x4*)gk; rv = *(const u32x4*)gv; if (tid_ < 256) rr = *(const u32x4*)gr;
    __syncthreads();
    {
        LAS unsigned char* kb = lds; LAS unsigned char* vb = lds + AT_KB;
        *(LAS u32x4*)(kb + skv * AT_KP + sc * 16) = rk;
        if (tid_ < 256) *(LAS u32x4*)(kb + rkv * AT_KP + 128 + rc * 16) = rr;
        *(LAS u32x4*)(vb + skv * AT_VP + sc * 16) = rv;
    }
    __syncthreads();
    for (int kt = 0; kt < nkt; ++kt) {
        const bool more = (kt + 1 < nkt);
        if (more) { const size_t adv = (size_t)(kt + 1) * 64;
            rk = *(const u32x4*)(gk + adv * 1024); rv = *(const u32x4*)(gv + adv * 1024); if (tid_ < 256) rr = *(const u32x4*)(gr + adv * 32); }
        LAS unsigned char* kb = lds + (kt & 1) * AT_BUF; LAS unsigned char* vb = kb + AT_KB;
        const int kv0 = kt * 64;
        if (kv0 <= qw0 + 31) {
            __builtin_amdgcn_iglp_opt(0);
            f32x16 p0, p1;
#pragma unroll
            for (int i = 0; i < 16; ++i) { p0[i] = 0.f; p1[i] = 0.f; }
            bf16x8 kf0[6], kf1[6];
#pragma unroll
            for (int ks = 0; ks < 6; ++ks) {
                kf0[ks] = *(const LAS bf16x8*)(kb + r * AT_KP + (16 * ks + 8 * hh) * 2);
                kf1[ks] = *(const LAS bf16x8*)(kb + (32 + r) * AT_KP + (16 * ks + 8 * hh) * 2);
            }
#pragma unroll
            for (int ks = 0; ks < 6; ++ks) {
                p0 = __builtin_amdgcn_mfma_f32_32x32x16_bf16(kf0[ks], qf[ks], p0, 0, 0, 0);
                p1 = __builtin_amdgcn_mfma_f32_32x32x16_bf16(kf1[ks], qf[ks], p1, 0, 0, 0);
            }
            if (kv0 + 63 > qw0) {
                const int qg = qw0 + r;
#pragma unroll
                for (int i = 0; i < 16; ++i) { const int kvl = kv0 + (i & 3) + 8 * (i >> 2) + 4 * hh; if (kvl > qg) p0[i] = -1e30f; if (kvl + 32 > qg) p1[i] = -1e30f; }
            }
            float tm = fmaxf(p0[0], p1[0]);
#pragma unroll
            for (int i = 1; i < 16; ++i) tm = fmaxf(tm, fmaxf(p0[i], p1[i]));
            tm = xhalf_max(tm);
            if (__any(tm > mx + 8.f)) {
                const float mn = fmaxf(mx, tm);
                const float alpha = __builtin_amdgcn_exp2f(mx - mn);
                mx = mn; lsum *= alpha;
#pragma unroll
                for (int i = 0; i < 16; ++i) { o0[i] *= alpha; o1[i] *= alpha; }
            }
            float ps = 0.f;
#pragma unroll
            for (int i = 0; i < 16; ++i) { p0[i] = __builtin_amdgcn_exp2f(p0[i] - mx); p1[i] = __builtin_amdgcn_exp2f(p1[i] - mx); ps += p0[i] + p1[i]; }
            lsum += ps;
            u32x4 vw0[4], vw1[4];
            {
                const int li = lane & 15, tq = li >> 2, tp = li & 3, dblk = (lane >> 4) & 1;
                const LAS unsigned char* vbase = vb + (4 * hh + tq) * AT_VP + (16 * dblk + 4 * tp) * 2;
#pragma unroll
                for (int f = 0; f < 4; ++f) {
                    const v4i16_t lo0 = __builtin_amdgcn_ds_read_tr16_b64_v4i16((LAS v4i16_t*)(vbase + (16 * f) * AT_VP));
                    const v4i16_t hi0 = __builtin_amdgcn_ds_read_tr16_b64_v4i16((LAS v4i16_t*)(vbase + (16 * f + 8) * AT_VP));
                    const v4i16_t lo1 = __builtin_amdgcn_ds_read_tr16_b64_v4i16((LAS v4i16_t*)(vbase + (16 * f) * AT_VP + 64));
                    const v4i16_t hi1 = __builtin_amdgcn_ds_read_tr16_b64_v4i16((LAS v4i16_t*)(vbase + (16 * f + 8) * AT_VP + 64));
                    const u32x2 a = __builtin_bit_cast(u32x2, lo0), b2 = __builtin_bit_cast(u32x2, hi0), c = __builtin_bit_cast(u32x2, lo1), d2 = __builtin_bit_cast(u32x2, hi1);
                    vw0[f].x = a.x; vw0[f].y = a.y; vw0[f].z = b2.x; vw0[f].w = b2.y; vw1[f].x = c.x; vw1[f].y = c.y; vw1[f].z = d2.x; vw1[f].w = d2.y;
                }
            }
            u32x4 pw[4];
#pragma unroll
            for (int s2 = 0; s2 < 2; ++s2) {
                pw[s2].x = pk2c(p0[8 * s2 + 0], p0[8 * s2 + 1]); pw[s2].y = pk2c(p0[8 * s2 + 2], p0[8 * s2 + 3]); pw[s2].z = pk2c(p0[8 * s2 + 4], p0[8 * s2 + 5]); pw[s2].w = pk2c(p0[8 * s2 + 6], p0[8 * s2 + 7]);
                pw[2 + s2].x = pk2c(p1[8 * s2 + 0], p1[8 * s2 + 1]); pw[2 + s2].y = pk2c(p1[8 * s2 + 2], p1[8 * s2 + 3]); pw[2 + s2].z = pk2c(p1[8 * s2 + 4], p1[8 * s2 + 5]); pw[2 + s2].w = pk2c(p1[8 * s2 + 6], p1[8 * s2 + 7]); }
#pragma unroll
            for (int f = 0; f < 4; ++f) {
                const bf16x8 pf = __builtin_bit_cast(bf16x8, pw[f]);
                o0 = __builtin_amdgcn_mfma_f32_32x32x16_bf16(__builtin_bit_cast(bf16x8, vw0[f]), pf, o0, 0, 0, 0);
                o1 = __builtin_amdgcn_mfma_f32_32x32x16_bf16(__builtin_bit_cast(bf16x8, vw1[f]), pf, o1, 0, 0, 0);
            }
        }
        if (more) {
            LAS unsigned char* kb2 = lds + ((kt + 1) & 1) * AT_BUF; LAS unsigned char* vb2 = kb2 + AT_KB;
            *(LAS u32x4*)(kb2 + skv * AT_KP + sc * 16) = rk;
            if (tid_ < 256) *(LAS u32x4*)(kb2 + rkv * AT_KP + 128 + rc * 16) = rr;
            *(LAS u32x4*)(vb2 + skv * AT_VP + sc * 16) = rv;
        }
        __syncthreads();
    }
    lsum = xhalf_sum(lsum);
    const float inv = 1.f / lsum;
    bf16_t* orow = Obase + mrow * opitch + h * 64;
#pragma unroll
    for (int g = 0; g < 4; ++g) {
        u32x2 w0, w1;
        w0.x = pk2c(o0[4 * g] * inv, o0[4 * g + 1] * inv); w0.y = pk2c(o0[4 * g + 2] * inv, o0[4 * g + 3] * inv);
        w1.x = pk2c(o1[4 * g] * inv, o1[4 * g + 1] * inv); w1.y = pk2c(o1[4 * g + 2] * inv, o1[4 * g + 3] * inv);
        *(u32x2*)(orow + 8 * g + 4 * hh) = w0;
        *(u32x2*)(orow + 32 + 8 * g + 4 * hh) = w1;
    }
}
__device__ __forceinline__ void attn_phase(unsigned char* ws, LAS unsigned char* lds, unsigned* ctr, int wave, int tid_, bf16_t* Obase, int opitch) {
    LAS unsigned* slot = (LAS unsigned*)(lds + 2 * AT_BUF + 64);
    for (;;) {
        if (tid_ == 0) *slot = atomicAdd(ctr, 1u);
        __syncthreads();
        const unsigned u = *slot;
        if (u >= 1024u) break;
        const int qb = 15 - (int)(u >> 6), bh = (int)(u & 63u);
        attn_unit(ws, lds, bh >> 3, bh & 7, qb, wave, tid_, Obase, opitch);
    }
}

constexpr int SD_CS = 0, SD_BS = 18432, SD_XT = 36864, SD_BDT = 62464, SD_MM = 79872, SD_F = 131072;
constexpr int SD_CP = 144, SD_XP = 400, SD_DP = 272, SD_MP = 400;
#define MFMA32(a, b, c) __builtin_amdgcn_mfma_f32_32x32x16_bf16((a), (b), (c), 0, 0, 0)
__device__ __forceinline__ void ssd_mfma(PP P, int l, unsigned char* ws, LAS unsigned char* lds, int unit, int wave, int tid_) {
    asm volatile("" : "+v"(tid_));
    const int lane = tid_ & 63, r = lane & 31, hh = lane >> 5;
    const int b = unit >> 3, h = unit & 7, g = h >> 2;
    bf16_t* Y = (bf16_t*)(ws + WS_Y); const bf16_t* BC = (const bf16_t*)(ws + B_BC); const bf16_t* U1 = (const bf16_t*)(ws + B_U1); const float* DTF = (const float*)(ws + WS_DTF);
    const float Ah = -__expf(P->in[14][l * 8 + h]); const float Dh = P->in[15][l * 8 + h];
    LAS float* F0 = (LAS float*)(lds + SD_F);
    for (int idx = tid_; idx < 64 * 32; idx += 512) { const int p = idx >> 5, c = idx & 31; *(LAS unsigned*)(lds + SD_XT + p * SD_XP + 256 + c * 4) = 0u; }
    f32x16 S;
#pragma unroll
    for (int i = 0; i < 16; ++i) S[i] = 0.f;
    const int l_ = tid_ >> 2, qd = tid_ & 3;
    const size_t mb0 = (size_t)b * SEQ;
    u32x4 c0, c1, b0, b1, x0, x1;
#define SSD_LOAD(ck_) do { const size_t m_ = mb0 + (size_t)(ck_) * 128 + l_; \
        c0 = *(const u32x4*)(BC + m_ * 256 + 128 + g * 64 + 16 * qd); c1 = *(const u32x4*)(BC + m_ * 256 + 128 + g * 64 + 16 * qd + 8); \
        b0 = *(const u32x4*)(BC + m_ * 256 + g * 64 + 16 * qd); b1 = *(const u32x4*)(BC + m_ * 256 + g * 64 + 16 * qd + 8); \
        x0 = *(const u32x4*)(Y + m_ * 2048 + 1024 + h * 64 + 16 * qd); x1 = *(const u32x4*)(Y + m_ * 2048 + 1024 + h * 64 + 16 * qd + 8); } while (0)
#define SSD_FCALC(ck_) do { LAS float* F_ = F0 + ((ck_) & 1) * 512; const size_t m_ = mb0 + (size_t)(ck_) * 128; \
        const float d0 = DTF[(m_ + lane) * 8 + h], d1 = DTF[(m_ + 64 + lane) * 8 + h]; float s0 = d0 * Ah, s1 = d1 * Ah; \
        _Pragma("unroll") for (int o = 1; o < 64; o <<= 1) { const float t0 = __shfl_up(s0, o), t1 = __shfl_up(s1, o); if (lane >= o) { s0 += t0; s1 += t1; } } \
        const float tot0 = __shfl(s0, 63); s1 += tot0; const float tot = __shfl(s1, 63); \
        F_[lane] = s0; F_[64 + lane] = s1; F_[128 + lane] = __expf(s0); F_[192 + lane] = __expf(s1); \
        F_[256 + lane] = __expf(tot - s0); F_[320 + lane] = __expf(tot - s1); F_[384 + lane] = d0; F_[448 + lane] = d1; } while (0)
#define SSD_STAGE(ck_) do { const LAS float* F_ = F0 + ((ck_) & 1) * 512; const float ea = F_[128 + l_], dec = F_[256 + l_], dt = F_[384 + l_]; \
        *(LAS u32x4*)(lds + SD_CS + l_ * SD_CP + qd * 32) = c0; *(LAS u32x4*)(lds + SD_CS + l_ * SD_CP + qd * 32 + 16) = c1; \
        *(LAS u32x4*)(lds + SD_BS + l_ * SD_CP + qd * 32) = b0; *(LAS u32x4*)(lds + SD_BS + l_ * SD_CP + qd * 32 + 16) = b1; \
        f32x4 ca, cb, cc, cd; unpack8(c0, ca, cb); unpack8(c1, cc, cd); \
        *(LAS u32x4*)(lds + SD_MM + l_ * SD_MP + 256 + qd * 32) = pack8(ca * ea, cb * ea); *(LAS u32x4*)(lds + SD_MM + l_ * SD_MP + 256 + qd * 32 + 16) = pack8(cc * ea, cd * ea); \
        f32x4 ba, bb, bc, bd; unpack8(b0, ba, bb); unpack8(b1, bc, bd); f32x4 xa, xb, xc, xd; unpack8(x0, xa, xb); unpack8(x1, xc, xd); \
        LAS unsigned short* bdt = (LAS unsigned short*)(lds + SD_BDT + (16 * qd) * SD_DP + l_ * 2); LAS unsigned short* xt = (LAS unsigned short*)(lds + SD_XT + (16 * qd) * SD_XP + l_ * 2); \
        _Pragma("unroll") for (int e = 0; e < 4; ++e) { \
            bdt[(e) * (SD_DP / 2)] = f2bf(ba[e] * dec); bdt[(4 + e) * (SD_DP / 2)] = f2bf(bb[e] * dec); bdt[(8 + e) * (SD_DP / 2)] = f2bf(bc[e] * dec); bdt[(12 + e) * (SD_DP / 2)] = f2bf(bd[e] * dec); \
            xt[(e) * (SD_XP / 2)] = f2bf(xa[e] * dt); xt[(4 + e) * (SD_XP / 2)] = f2bf(xb[e] * dt); xt[(8 + e) * (SD_XP / 2)] = f2bf(xc[e] * dt); xt[(12 + e) * (SD_XP / 2)] = f2bf(xd[e] * dt); } } while (0)
    SSD_LOAD(0);
    if (wave == 0) SSD_FCALC(0);
    __syncthreads();
    SSD_STAGE(0);
    SSD_LOAD(1);
    if (wave == 7) SSD_FCALC(1);
    __syncthreads();
    for (int ck = 0; ck < 32; ++ck) {
        const size_t m0 = mb0 + (size_t)ck * 128;
        const LAS float* F = F0 + (ck & 1) * 512;
        {
            const int lt = wave & 3;
#pragma unroll
            for (int sti = 0; sti < 2; ++sti) {
                const int st = 2 * (wave >> 2) + sti;
                if (st <= lt) {
                    f32x16 ga;
#pragma unroll
                    for (int i = 0; i < 16; ++i) ga[i] = 0.f;
#pragma unroll
                    for (int ks = 0; ks < 4; ++ks) {
                        const bf16x8 a = *(const LAS bf16x8*)(lds + SD_CS + (32 * lt + r) * SD_CP + 32 * ks + 16 * hh);
                        const bf16x8 bq = *(const LAS bf16x8*)(lds + SD_BS + (32 * st + r) * SD_CP + 32 * ks + 16 * hh);
                        ga = MFMA32(a, bq, ga);
                    }
                    const int sg = 32 * st + r; const float acs_s = F[sg];
#pragma unroll
                    for (int i = 0; i < 16; ++i) { const int lg = 32 * lt + (i & 3) + 8 * (i >> 2) + 4 * hh;
                        const float v = (sg <= lg) ? ga[i] * __expf(F[lg] - acs_s) : 0.f;
                        *(LAS unsigned short*)(lds + SD_MM + lg * SD_MP + sg * 2) = f2bf(v); }
                }
            }
        }
        __syncthreads();
        {
            const int lt = wave >> 1, pt = wave & 1;
            const size_t m = m0 + 32 * lt + r;
            bf16_t* yrow = Y + m * 2048 + 1024 + h * 64 + 32 * pt + 4 * hh; const bf16_t* zrow = U1 + m * 1024 + h * 64 + 32 * pt + 4 * hh;
            u32x2 xs4[4], z4[4]; float ssl = 0.f;
#pragma unroll
            for (int g4 = 0; g4 < 4; ++g4) { xs4[g4] = *(const u32x2*)(yrow + 8 * g4); z4[g4] = *(const u32x2*)(zrow + 8 * g4); }
            f32x16 ya;
#pragma unroll
            for (int i = 0; i < 16; ++i) ya[i] = 0.f;
            const LAS unsigned char* bp = lds + SD_MM + (32 * lt + r) * SD_MP + 16 * hh;
            const LAS unsigned char* ap = lds + SD_XT + (32 * pt + r) * SD_XP + 16 * hh;
            const int nks = 2 * (lt + 1);
            for (int ks = 0; ks < nks; ++ks) ya = MFMA32(*(const LAS bf16x8*)(ap + 32 * ks), *(const LAS bf16x8*)(bp + 32 * ks), ya);
#pragma unroll
            for (int ks = 8; ks < 12; ++ks) ya = MFMA32(*(const LAS bf16x8*)(ap + 32 * ks), *(const LAS bf16x8*)(bp + 32 * ks), ya);
#pragma unroll
            for (int g4 = 0; g4 < 4; ++g4) {
                const float xv[4] = {bflo(xs4[g4].x), bfhi(xs4[g4].x), bflo(xs4[g4].y), bfhi(xs4[g4].y)};
                const float zv[4] = {bflo(z4[g4].x), bfhi(z4[g4].x), bflo(z4[g4].y), bfhi(z4[g4].y)};
                float o[4];
#pragma unroll
                for (int e = 0; e < 4; ++e) o[e] = (ya[4 * g4 + e] + xv[e] * Dh) * (zv[e] * sigmoidf_(zv[e]));
                u32x2 w; w.x = cvt_pk_bf16(o[0], o[1]); w.y = cvt_pk_bf16(o[2], o[3]);
                *(u32x2*)(yrow + 8 * g4) = w;
                const float q0 = bflo(w.x), q1 = bfhi(w.x), q2 = bflo(w.y), q3 = bfhi(w.y);
                ssl += (q0 * q0 + q1 * q1) + (q2 * q2 + q3 * q3);
            }
            ssl = xhalf_sum(ssl);
            if (hh == 0) ((float*)(ws + WS_SSQC))[m * 16 + h * 2 + pt] = ssl;
        }
        const int spt = wave >> 1, snt = wave & 1;
        if (wave < 4) {
            const float et = F[255];
#pragma unroll
            for (int i = 0; i < 16; ++i) S[i] *= et;
#pragma unroll
            for (int ks = 0; ks < 8; ++ks) {
                const bf16x8 a = *(const LAS bf16x8*)(lds + SD_XT + (32 * spt + r) * SD_XP + 32 * ks + 16 * hh);
                const bf16x8 bq = *(const LAS bf16x8*)(lds + SD_BDT + (32 * snt + r) * SD_DP + 32 * ks + 16 * hh);
                S = MFMA32(a, bq, S);
            }
        }
        __syncthreads();
        if (wave < 4) {
#pragma unroll
            for (int i = 0; i < 16; ++i) { const int pgl = 32 * spt + (i & 3) + 8 * (i >> 2) + 4 * hh;
                *(LAS unsigned short*)(lds + SD_XT + pgl * SD_XP + (128 + 32 * snt + r) * 2) = f2bf(S[i]); }
        }
        if (ck + 1 < 32) {
            SSD_STAGE(ck + 1);
            if (ck + 2 < 32) { SSD_LOAD(ck + 2); if (wave == 7) SSD_FCALC(ck + 2); }
        }
        __syncthreads();
    }
#undef SSD_LOAD
#undef SSD_FCALC
#undef SSD_STAGE
}

__device__ __forceinline__ void attn_naive(unsigned char* ws, int gw, int tid_) {
    asm volatile("" : "+v"(tid_)); const int lane = tid_ & 63;
    const bf16_t* Y = (const bf16_t*)(ws + WS_Y); const bf16_t* QR = (const bf16_t*)(ws + B_QR); const bf16_t* KV = (const bf16_t*)(ws + B_KV); const bf16_t* KR = (const bf16_t*)(ws + B_KR);
    bf16_t* YO = (bf16_t*)(ws + WS_Y);
    const int bh = gw >> 5, j = gw & 31, b = bh >> 3, h = bh & 7;
    for (int pass = 0; pass < 2; ++pass) {
        const int qb = pass ? 63 - j : j;
        const int t = qb * 64 + lane; const size_t m = (size_t)b * SEQ + t;
        unsigned q[48];
#pragma unroll
        for (int i = 0; i < 8; ++i) { const u32x4 w = *(const u32x4*)(Y + m * 2048 + h * 64 + i * 8); q[4 * i] = w.x; q[4 * i + 1] = w.y; q[4 * i + 2] = w.z; q[4 * i + 3] = w.w; }
#pragma unroll
        for (int i = 0; i < 4; ++i) { const u32x4 w = *(const u32x4*)(QR + m * 256 + h * 32 + i * 8); q[32 + 4 * i] = w.x; q[33 + 4 * i] = w.y; q[34 + 4 * i] = w.z; q[35 + 4 * i] = w.w; }
        float acc[64];
#pragma unroll
        for (int d = 0; d < 64; ++d) acc[d] = 0.f;
        float mx = -1e30f, lsum = 0.f;
        const int kend = qb * 64 + 64;
        for (int kv = 0; kv < kend; ++kv) {
            const size_t mk = (size_t)b * SEQ + kv;
            const u32x4* kn = (const u32x4*)(KV + mk * 1024 + h * 64); const u32x4* kr = (const u32x4*)(KR + mk * 32); const u32x4* vv = (const u32x4*)(KV + mk * 1024 + 512 + h * 64);
            float s0 = 0.f, s1 = 0.f;
#pragma unroll
            for (int i = 0; i < 8; ++i) { const u32x4 w = kn[i];
                s0 = dot2x(q[4 * i], w.x, s0);
                s1 = dot2x(q[4 * i + 1], w.y, s1);
                s0 = dot2x(q[4 * i + 2], w.z, s0);
                s1 = dot2x(q[4 * i + 3], w.w, s1); }
#pragma unroll
            for (int i = 0; i < 4; ++i) { const u32x4 w = kr[i];
                s0 = dot2x(q[32 + 4 * i], w.x, s0);
                s1 = dot2x(q[33 + 4 * i], w.y, s1);
                s0 = dot2x(q[34 + 4 * i], w.z, s0);
                s1 = dot2x(q[35 + 4 * i], w.w, s1); }
            float s = s0 + s1;
            if (kv > t) s = -1e30f;
            const float mn = fmaxf(mx, s);
            const float alpha = exp2f(mx - mn), p = (kv > t) ? 0.f : exp2f(s - mn);
            mx = mn; lsum = lsum * alpha + p;
#pragma unroll
            for (int i = 0; i < 8; ++i) { const u32x4 w = vv[i];
                acc[8 * i + 0] = acc[8 * i + 0] * alpha + p * bflo(w.x); acc[8 * i + 1] = acc[8 * i + 1] * alpha + p * bfhi(w.x);
                acc[8 * i + 2] = acc[8 * i + 2] * alpha + p * bflo(w.y); acc[8 * i + 3] = acc[8 * i + 3] * alpha + p * bfhi(w.y);
                acc[8 * i + 4] = acc[8 * i + 4] * alpha + p * bflo(w.z); acc[8 * i + 5] = acc[8 * i + 5] * alpha + p * bfhi(w.z);
                acc[8 * i + 6] = acc[8 * i + 6] * alpha + p * bflo(w.w); acc[8 * i + 7] = acc[8 * i + 7] * alpha + p * bfhi(w.w); }
        }
        const float inv = 1.f / lsum;
#pragma unroll
        for (int i = 0; i < 8; ++i) { u32x4 w; w.x = cvt_pk_bf16(acc[8 * i] * inv, acc[8 * i + 1] * inv); w.y = cvt_pk_bf16(acc[8 * i + 2] * inv, acc[8 * i + 3] * inv);
            w.z = cvt_pk_bf16(acc[8 * i + 4] * inv, acc[8 * i + 5] * inv); w.w = cvt_pk_bf16(acc[8 * i + 6] * inv, acc[8 * i + 7] * inv);
            *(u32x4*)(YO + m * 2048 + h * 64 + i * 8) = w; }
    }
}

__device__ __forceinline__ void ssd_naive(PP P, int l, unsigned char* ws, int unit, int wave, int tid_) {
    asm volatile("" : "+v"(tid_)); const int lane = tid_ & 63;
    const int b = unit >> 3, h = unit & 7, g = h >> 2;
    bf16_t* Y = (bf16_t*)(ws + WS_Y); const bf16_t* BC = (const bf16_t*)(ws + B_BC); const bf16_t* U1 = (const bf16_t*)(ws + B_U1); const float* DTF = (const float*)(ws + WS_DTF);
    const float Ah = -__expf(P->in[14][l * 8 + h]); const float Dh = P->in[15][l * 8 + h];
    const int p = wave * 8 + (lane >> 3), no = lane & 7;
    float S[8];
#pragma unroll
    for (int i = 0; i < 8; ++i) S[i] = 0.f;
    for (int t = 0; t < SEQ; ++t) {
        const size_t m = (size_t)b * SEQ + t;
        const float dt = DTF[m * 8 + h]; const float a = __expf(dt * Ah);
        bf16_t* xp = Y + m * 2048 + 1024 + h * 64 + p;
        const float xv = bf2f(*xp); const float xdt = xv * dt;
        f32x4 b0, b1, c0, c1; unpack8(*(const u32x4*)(BC + m * 256 + g * 64 + no * 8), b0, b1); unpack8(*(const u32x4*)(BC + m * 256 + 128 + g * 64 + no * 8), c0, c1);
        float y = 0.f;
#pragma unroll
        for (int i = 0; i < 4; ++i) { S[i] = a * S[i] + xdt * b0[i]; y += S[i] * c0[i]; S[4 + i] = a * S[4 + i] + xdt * b1[i]; y += S[4 + i] * c1[i]; }
        y += __shfl_xor(y, 1); y += __shfl_xor(y, 2); y += __shfl_xor(y, 4);
        const float z = bf2f(U1[m * 1024 + h * 64 + p]);
        y = (y + xv * Dh) * (z * sigmoidf_(z));
        if (no == 0) *xp = f2bf(y);
    }
}

__device__ __forceinline__ float gelu_tanh(float x) { const float u = 0.7978845608028654f * (x + 0.044715f * x * x * x); return x * sigmoidf_(2.f * u); }
__device__ __forceinline__ void lru_scan(unsigned char* ws, int unit, int wave, int tid_, LAS float* sm) {
    asm volatile("" : "+v"(tid_)); const int lane = tid_ & 63;
    const int b = unit >> 3, ch = (unit & 7) * 64 + lane;
    bf16_t* Y = (bf16_t*)(ws + WS_Y); const bf16_t* LA = (const bf16_t*)(ws + B_LA); const bf16_t* U1 = (const bf16_t*)(ws + B_U1);
    const int t0 = wave * 512;
    const size_t m0 = (size_t)b * SEQ + t0;
    const bf16_t* lap = LA + m0 * 512 + ch; bf16_t* up = Y + m0 * 2048 + 1536 + ch; const bf16_t* gp = U1 + m0 * 1024 + 512 + ch;
    float A = 1.f, H = 0.f;
    for (int t = 0; t < 512; t += 16) {
        bf16_t la[16], uu[16];
#pragma unroll
        for (int k = 0; k < 16; ++k) { la[k] = lap[(size_t)(t + k) * 512]; uu[k] = up[(size_t)(t + k) * 2048]; }
#pragma unroll
        for (int k = 0; k < 16; ++k) { const float a = __expf(bf2f(la[k])); H = a * H + bf2f(uu[k]); A *= a; }
    }
    sm[wave * 64 + lane] = A; sm[512 + wave * 64 + lane] = H;
    __syncthreads();
    float hcar = 0.f;
    for (int w = 0; w < wave; ++w) hcar = sm[w * 64 + lane] * hcar + sm[512 + w * 64 + lane];
    for (int t = 0; t < 512; t += 16) {
        bf16_t la[16], uu[16], gg[16];
#pragma unroll
        for (int k = 0; k < 16; ++k) { la[k] = lap[(size_t)(t + k) * 512]; uu[k] = up[(size_t)(t + k) * 2048]; gg[k] = gp[(size_t)(t + k) * 1024]; }
#pragma unroll
        for (int k = 0; k < 16; ++k) { const float a = __expf(bf2f(la[k])); hcar = a * hcar + bf2f(uu[k]); up[(size_t)(t + k) * 2048] = f2bf(bf2f(f2bf(hcar)) * gelu_tanh(bf2f(gg[k]))); }
    }
    __syncthreads();
}


#define RLX_AGENT __ATOMIC_RELAXED, __HIP_MEMORY_SCOPE_AGENT
#define XB_TMO      128
#define XB_XCNT(j)  (256  + 64 * (j))
#define XB_XSUB(j)  (1280 + 64 * (j))
#define XB_XGEN(j)  (2304 + 64 * (j))
#define XB_TOP      3328
#define XB_TOPGEN   3392
#define XCD_BAR_WORDS 3456
#define XB_SPIN_CAP (1u << 18)

__device__ __forceinline__ unsigned xb_ld(unsigned* p)              { return __hip_atomic_load(p, __ATOMIC_RELAXED, __HIP_MEMORY_SCOPE_AGENT); }
__device__ __forceinline__ unsigned xb_add(unsigned* p, unsigned v) { return __hip_atomic_fetch_add(p, v, __ATOMIC_RELAXED, __HIP_MEMORY_SCOPE_AGENT); }
__device__ __forceinline__ unsigned xb_xcc_id() { return (unsigned)__builtin_amdgcn_s_getreg((3 << 11) | 20) & 0xFu; }
#define XB_SPIN(cond, bar) do { unsigned _sp = 0; while (cond) { __builtin_amdgcn_s_sleep(1); \
    if ((++_sp & 255u) == 0u) { if (xb_ld(&(bar)[XB_TMO])) break; if (_sp > XB_SPIN_CAP) { atomicAdd(&(bar)[XB_TMO], 1u); break; } } } } while (0)

struct XcdBarrier {
    unsigned* bar; unsigned x;
    volatile LAS unsigned* st;
};

__device__ __forceinline__ XcdBarrier xcd_barrier_post(unsigned* bar, volatile LAS unsigned* st) {
    XcdBarrier b; b.bar = bar; b.x = xb_xcc_id(); b.st = st;
    if (threadIdx.x == 0) (void)xb_add(&bar[XB_XCNT(b.x)], 1u);
    return b;
}
__device__ __forceinline__ void xcd_barrier_complete(unsigned* bar, unsigned x, unsigned& nloc, unsigned& nx) {
    const unsigned G = gridDim.x * gridDim.y * gridDim.z;
    unsigned sum, cnt, mine, sp = 0u;
    for (;;) {
        sum = 0u; cnt = 0u; mine = 0u;
#pragma unroll
        for (unsigned j = 0; j < 16; ++j) { const unsigned c = xb_ld(&bar[XB_XCNT(j)]); sum += c; cnt += (c > 0u) ? 1u : 0u; mine = (j == x) ? c : mine; }
        if (sum == G) break;
        __builtin_amdgcn_s_sleep(1);
        if ((++sp & 255u) == 0u) { if (xb_ld(&bar[XB_TMO])) break; if (sp > XB_SPIN_CAP) { atomicAdd(&bar[XB_TMO], 1u); break; } }
    }
    nloc = mine > 0u ? mine : 1u; nx = cnt > 0u ? cnt : 1u;
}

__device__ __forceinline__ void xcd_barrier(const XcdBarrier& b) {
    asm volatile("s_waitcnt vmcnt(0)" ::: "memory");
    __syncthreads();
    if (threadIdx.x == 0) {
        unsigned* bar = b.bar;
        __builtin_amdgcn_s_waitcnt(0);
        unsigned nloc = b.st[0], nx = b.st[1];
        if (nloc == 0u) { xcd_barrier_complete(bar, b.x, nloc, nx); b.st[0] = nloc; b.st[1] = nx; }
        const unsigned old = xb_add(&bar[XB_XSUB(b.x)], 1u);
        const unsigned gen = old / nloc;
        if (old + 1u == (gen + 1u) * nloc) {
            __builtin_amdgcn_fence(__ATOMIC_RELEASE, "agent");
            asm volatile("s_waitcnt vmcnt(0)" ::: "memory");
            const unsigned og = xb_add(&bar[XB_TOP], 1u);
            const unsigned tg = og / nx;
            if (og + 1u == (tg + 1u) * nx) xb_add(&bar[XB_TOPGEN], 1u);
            else XB_SPIN(xb_ld(&bar[XB_TOPGEN]) == tg, bar);
            __builtin_amdgcn_fence(__ATOMIC_ACQUIRE, "agent");
            xb_add(&bar[XB_XGEN(b.x)], 1u);
            asm volatile("s_waitcnt vmcnt(0)" ::: "memory");
        } else {
            XB_SPIN(xb_ld(&bar[XB_XGEN(b.x)]) == gen, bar);
            __builtin_amdgcn_fence(__ATOMIC_ACQUIRE, "agent");
            asm volatile("s_waitcnt vmcnt(0)" ::: "memory");
        }
    }
    __syncthreads();
}


constexpr int LDS_BYTES = 147456;
#ifndef GMASK
#define GMASK 0xffffffffu
#endif
__global__ void __launch_bounds__(512, 2) mk_fwd(Params Pk) {
    extern __shared__ __attribute__((aligned(16))) unsigned char lds_raw[];
    LAS unsigned char* lds = (LAS unsigned char*)lds_raw;
    cg::grid_group grid = cg::this_grid();
    const int tid = threadIdx.x, wave = __builtin_amdgcn_readfirstlane(tid >> 6);
    const int G = gridDim.x, bid = blockIdx.x;
    const int gw = bid * 8 + wave, NGW = G * 8, NGT = G * 512;
    PP P = (PP)__builtin_amdgcn_kernarg_segment_ptr();
    unsigned char* ws = (unsigned char*)(__attribute__((address_space(1))) unsigned char*)P->ws;
    { volatile LAS unsigned* st0 = (volatile LAS unsigned*)(lds + 146000); if (tid == 0) { st0[0] = 0u; st0[1] = 0u; } __syncthreads(); }
    XcdBarrier xbar = xcd_barrier_post((unsigned*)P->ws + 4096, (volatile LAS unsigned*)(lds + 146000));
    if (G > 100000) grid.sync();
#define FRESH() do { asm volatile("" : "+s"(P)); { __attribute__((address_space(1))) unsigned char* g_ = (__attribute__((address_space(1))) unsigned char*)P->ws; asm volatile("" : "+s"(g_), "+s"(l)); ws = (unsigned char*)g_; } W = (bf16_t*)(ws + WS_W); XB = (bf16_t*)(ws + WS_XB); Y = (bf16_t*)(ws + WS_Y); } while (0)
#define GSYNC() do { xcd_barrier(xbar); } while (0)
    bf16_t* W = (bf16_t*)(ws + WS_W); bf16_t* XB = (bf16_t*)(ws + WS_XB); bf16_t* Y = (bf16_t*)(ws + WS_Y);
    #define SSQA ((float*)(ws + WS_SSQA))
#define SSQB ((float*)(ws + WS_SSQB))
#define SSQC_ (cur ? SSQB : SSQA)
#define SSQN_ (cur ? SSQA : SSQB)
    int cur = 0;
    using namespace pg8;

    for (int l = 0; l < DEPTH; ++l) {
        FRESH();
        conv_weights(P, l, W, tid, bid, NGT, lds);
        p0_rows(P, l == 0 ? P->in[0] : (const float*)P->out, l == 0, XB, SSQA, (f32x2*)(ws + WS_CS), gw, NGW, tid);
        GSYNC(); FRESH();
        { Gemm g{XB, W + W_IN, M, 3584, 1024, 1024, 0, 0}; StaticOrder S; S.init(M, 3584, G, bid);
          EpiInproj E{(bf16_t*)(ws + B_U1), (bf16_t*)(ws + B_UA), (bf16_t*)(ws + B_UB), lds};
          rstd_prepass(lds, SSQC_, S, tid); if (GMASK & (1u << 0)) gemm_phase(lds, g, S, E); }
        GSYNC(); FRESH();
        p2_prep(P, l, ws, gw, NGW, tid);
        GSYNC(); FRESH();
        { Gemm g{(const bf16_t*)(ws + B_UA), W + W_UQ, M, 768, 384, 768, 0, 0}; StaticOrder S; S.init(M, 768, G, bid);
          EpiQ E{Y, (bf16_t*)(ws + B_QR), (const float*)(ws + WS_RSQ), (const f32x2*)(ws + WS_CS)}; if (GMASK & (1u << 1)) gemm_phase(lds, g, S, E); }
        { Gemm g{(const bf16_t*)(ws + B_UA) + 384, W + W_UKV, M, 1024, 256, 768, 0, 0}; StaticOrder S; S.init(M, 1024, G, (bid + 128) % G);
          EpiRowScale E{(bf16_t*)(ws + B_KV), 1024, (const float*)(ws + WS_RSKV), 0}; if (GMASK & (1u << 2)) gemm_phase(lds, g, S, E); }
        if (G == 256 ? bid >= 128 : true) { Gemm g{Y + 512, W + W_POOL, M, 512, 256, 2048, 256, 0}; StaticOrder S; if (G == 256) S.init(M, 512, 128, bid - 128); else S.init(M, 512, G, bid);
          EpiRowScale E{Y + 512, 2048, nullptr, 0}; if (GMASK & (1u << 3)) gemm_phase(lds, g, S, E); }
        { Gemm g{Y + 1536, W + W_LRU, M, 1024, 128, 2048, 128, 0}; StaticOrder S; S.init(M, 1024, G, bid);
          EpiLru E{Y + 1536, (bf16_t*)(ws + B_LA), P->in[20] + l * 512, P->in[22] + l * 512, P->in[23] + l * 512}; if (GMASK & (1u << 4)) gemm_phase(lds, g, S, E); }
        GSYNC(); FRESH();
#ifdef NAIVE_SSD
        if (bid < 64) ssd_naive(P, l, ws, bid, wave, tid);
#else
        if (bid < 64) ssd_mfma(P, l, ws, lds, bid, wave, tid);
#endif
#ifndef NO_LRU
        if (bid >= 64 && bid < 128) lru_scan(ws, bid - 64, wave, tid, (LAS float*)lds);
#endif
#ifdef NAIVE_ATTN
        if (gw < 2048) attn_naive(ws, gw, tid);
#else
#ifdef PROBE_ATTN
        attn_phase(ws, lds, (unsigned*)ws + 64 + 16 * l + 8, wave, tid, (bf16_t*)(ws + B_UA), 512);
#endif
        attn_phase(ws, lds, (unsigned*)ws + 64 + 16 * l, wave, tid, (bf16_t*)(ws + WS_Y), 2048);
#endif
        GSYNC(); FRESH();
#define TBUF(n) ((bf16_t*)(ws + WS_BIG + (size_t)(n) * 64 * MiB))
#define MB ((bf16_t*)(ws + WS_BIG + 64 * MiB))
        { MergeOrder S; S.base.init(M, 1024, G, bid); EpiMerge E{lds, TBUF(0), MB};
          merge_prepass(lds, SSQC_, (const float*)(ws + WS_SSQC), S, tid);
          if (GMASK & (1u << 5)) gemm_merge_fused(lds, Y, XB, W + W_BR, W + W_G, S, E); }
        GSYNC(); FRESH();
        { Gemm g{MB, W + W_OUT, M, 1024, 1024, 1024, 0, 0}; StaticOrder S; S.init(M, 1024, G, bid);
          EpiRes<0> E{l == 0 ? P->in[0] : P->out, P->out, XB, SSQN_, (const LAS unsigned char*)nullptr, nullptr}; if (GMASK & (1u << 8)) gemm_phase(lds, g, S, E); cur ^= 1; }
        GSYNC(); FRESH();
        conv_p(P, l, (bf16_t*)(ws + Y_PB), tid, bid, NGT);
        { Gemm g{XB, W + W_FF1, M, 4096, 1024, 1024, 0, 0}; StaticOrder S; S.init(M, 4096, G, bid);
          EpiFF1 E{(bf16_t*)(ws + B_H), lds}; rstd_prepass(lds, SSQC_, S, tid); if (GMASK & (1u << 9)) gemm_phase(lds, g, S, E); }
        GSYNC(); FRESH();
        { Gemm g{(const bf16_t*)(ws + B_H), W + W_FF2, M, 1024, 4096, 4096, 0, 0}; StaticOrder S; S.init(M, 1024, G, bid); S.rev = 1;
          EpiRes<0> E{P->out, P->out, XB, SSQN_, (const LAS unsigned char*)nullptr, nullptr}; if (GMASK & (1u << 10)) gemm_phase(lds, g, S, E); cur ^= 1; }
        { Gemm g{(const bf16_t*)(ws + Y_PB), W + W_PLE, M, 1024, 256, 256, 0, 0}; StaticOrder S; S.init(M, 1024, G, bid);
          EpiRowScale E{(bf16_t*)(ws + Y_TP), 1024, nullptr, 0}; if (GMASK & (1u << 11)) gemm_phase(lds, g, S, E); }
        GSYNC(); FRESH();
        { Gemm g{XB, W + W_PG, M, 1024, 1024, 1024, 0, 0}; StaticOrder S; S.init(M, 1024, G, bid);
          EpiRes<1> E{P->out, P->out, XB, SSQN_, lds, (const bf16_t*)(ws + Y_TP)}; rstd_prepass(lds, SSQC_, S, tid); if (GMASK & (1u << 12)) gemm_phase(lds, g, S, E); cur ^= 1; }
        GSYNC(); FRESH();
    }
    final_norm(P, SSQC_, gw, NGW, tid);
}

extern "C" void kernel_launch(void* const* d_in, const int* in_sizes, int n_in, void* d_out, int out_size, void* d_ws, size_t ws_size, hipStream_t stream) {
    static int grid = 0;
    if (grid == 0) {
        if (n_in != 33 || out_size != M * D || ws_size < WS_END) { fprintf(stderr, "kernel_launch: unexpected shapes (n_in %d out %d ws %zu)\n", n_in, out_size, ws_size); grid = -1; return; }
        int dev = 0, cus = 0, per_cu = 0;
        hipGetDevice(&dev); hipDeviceGetAttribute(&cus, hipDeviceAttributeMultiprocessorCount, dev);
        hipFuncSetAttribute((const void*)mk_fwd, hipFuncAttributeMaxDynamicSharedMemorySize, LDS_BYTES);
        hipOccupancyMaxActiveBlocksPerMultiprocessor(&per_cu, (const void*)mk_fwd, 512, LDS_BYTES);
        if (per_cu < 1) per_cu = 1;
        grid = cus >= 256 ? 256 : cus;
        (void)hipGetLastError();
    }
    if (grid < 0) return;
    if (hipMemsetAsync(d_ws, 0, 65536, stream) != hipSuccess) { fprintf(stderr, "memset failed\n"); return; }
    Params p{};
    for (int i = 0; i < 33; ++i) p.in[i] = (const float*)d_in[i];
    p.out = (float*)d_out; p.ws = (unsigned char*)d_ws;
    for (int i = 0; i < 16; ++i) p.inv_freq[i] = 1.0 / pow(10000.0, (double)i / 16.0);
    void* args[] = {&p};
    hipError_t e = hipLaunchCooperativeKernel((const void*)mk_fwd, dim3(grid), dim3(512), args, LDS_BYTES, stream);
    if (e != hipSuccess) fprintf(stderr, "cooperative launch failed: %s (grid %d)\n", hipGetErrorString(e), grid);
}
```

```cpp
#include <hip/hip_runtime.h>
#include <hip/hip_cooperative_groups.h>
#include <cstdio>
#include <cstdint>
#include <cmath>
namespace cg = cooperative_groups;

#define LAS __attribute__((address_space(3)))
typedef unsigned short bf16_t;
typedef short bf16x8 __attribute__((ext_vector_type(8)));
typedef float f32x4 __attribute__((ext_vector_type(4)));
typedef float f32x2 __attribute__((ext_vector_type(2)));
typedef unsigned u32x4 __attribute__((ext_vector_type(4)));
typedef unsigned u32x2 __attribute__((ext_vector_type(2)));
typedef __bf16 bf16x2_t __attribute__((ext_vector_type(2)));

constexpr int M = 32768, SEQ = 4096, NB = 8, D = 1024, DEPTH = 2;
constexpr int INC = 7592;
constexpr float EPS = 1e-6f;
constexpr float QSCALE = 0.10206207261596577f * 1.4426950408889634f;

constexpr size_t MiB = 1u << 20;
constexpr size_t WS_SSQA = 2 * MiB, WS_SSQB = 4 * MiB, WS_RSQ = 6 * MiB, WS_RSKV = WS_RSQ + 128 * 1024, WS_RSC = WS_RSKV + 128 * 1024;
constexpr size_t WS_DTF = 7 * MiB, WS_CS = 8 * MiB, WS_SSQC = 12 * MiB;
constexpr size_t WS_W = 16 * MiB, WS_XB = 60 * MiB, WS_Y = 124 * MiB, WS_BIG = 252 * MiB, WS_END = 512 * MiB;
constexpr size_t B_U1 = WS_BIG, B_UA = WS_BIG + 64 * MiB, B_UB = WS_BIG + 112 * MiB, B_BC = WS_BIG + 224 * MiB, B_KR = WS_BIG + 240 * MiB;
constexpr size_t B_QR = WS_BIG + 112 * MiB, B_KV = WS_BIG + 128 * MiB, B_LA = WS_BIG + 192 * MiB;
constexpr size_t B_T0 = WS_BIG, B_T1 = WS_BIG + 64 * MiB, B_MB = WS_BIG + 128 * MiB;
constexpr size_t B_H = WS_BIG;
constexpr size_t Y_TP = WS_Y, Y_PB = WS_Y + 64 * MiB;
constexpr size_t W_IN = 0, W_G = W_IN + 3584ull * 1024, W_UQ = W_G + 4096ull * 1024, W_UKV = W_UQ + 768ull * 384, W_POOL = W_UKV + 1024ull * 256,
                 W_LRU = W_POOL + 512ull * 256, W_BR = W_LRU + 1024ull * 128, W_OUT = W_BR + 4096ull * 512, W_FF1 = W_OUT + 1024ull * 1024,
                 W_FF2 = W_FF1 + 4096ull * 1024, W_PG = W_FF2 + 4096ull * 1024, W_PLE = W_PG + 1024ull * 1024, W_TOTAL = W_PLE + 1024ull * 256;
static_assert(W_TOTAL * 2 <= 44 * MiB, "weights fit");

struct Params {
    const float* in[33];
    float* out;
    unsigned char* ws;
    double inv_freq[16];
};

typedef const __attribute__((address_space(4))) Params* PP;
#if defined(__HIP_DEVICE_COMPILE__)
#define ASSUME_GLOBAL(p) do { __builtin_assume(!__builtin_amdgcn_is_shared((const __attribute__((address_space(0))) void*)(p))); __builtin_assume(!__builtin_amdgcn_is_private((const __attribute__((address_space(0))) void*)(p))); } while (0)
#else
#define ASSUME_GLOBAL(p) do { } while (0)
#endif
__device__ __forceinline__ unsigned cvt_pk_bf16(float lo, float hi) { unsigned r; asm("v_cvt_pk_bf16_f32 %0, %1, %2" : "=v"(r) : "v"(lo), "v"(hi)); return r; }
__device__ __forceinline__ float bflo(unsigned w) { return __uint_as_float(w << 16); }
__device__ __forceinline__ float bfhi(unsigned w) { return __uint_as_float(w & 0xffff0000u); }
__device__ __forceinline__ float bf2f(bf16_t h) { return __uint_as_float(((unsigned)h) << 16); }
__device__ __forceinline__ bf16_t f2bf(float f) { return (bf16_t)(cvt_pk_bf16(f, 0.f) & 0xffffu); }
__device__ __forceinline__ u32x4 pack8(f32x4 a, f32x4 b) { u32x4 w; w.x = cvt_pk_bf16(a[0], a[1]); w.y = cvt_pk_bf16(a[2], a[3]); w.z = cvt_pk_bf16(b[0], b[1]); w.w = cvt_pk_bf16(b[2], b[3]); return w; }
__device__ __forceinline__ void unpack8(u32x4 w, f32x4& a, f32x4& b) { a = (f32x4){bflo(w.x), bfhi(w.x), bflo(w.y), bfhi(w.y)}; b = (f32x4){bflo(w.z), bfhi(w.z), bflo(w.w), bfhi(w.w)}; }
__device__ __forceinline__ float dot2x(unsigned a, unsigned b, float c) { return c + bflo(a) * bflo(b) + bfhi(a) * bfhi(b); }
__device__ __forceinline__ float sigmoidf_(float x) { return __builtin_amdgcn_rcpf(1.f + __builtin_amdgcn_exp2f(-1.4426950408889634f * x)); }
__device__ __forceinline__ float one_minus_exp(float x) {
    const float p = -x * (1.f + x * (0.5f + x * (0.16666667f + x * (0.041666668f + x * (0.008333334f + x * (0.0013888889f + x * 0.0001984127f))))));
    return x < -0.25f ? 1.f - __expf(x) : p;
}
__device__ __forceinline__ float xhalf_sum(float v) { const auto r_ = __builtin_amdgcn_permlane32_swap(__float_as_uint(v), __float_as_uint(v), false, false); return __uint_as_float(r_[0]) + __uint_as_float(r_[1]); }
__device__ __forceinline__ float xhalf_max(float v) { const auto r_ = __builtin_amdgcn_permlane32_swap(__float_as_uint(v), __float_as_uint(v), false, false); return fmaxf(__uint_as_float(r_[0]), __uint_as_float(r_[1])); }
__device__ __forceinline__ float wave_sum(float v) {
#pragma unroll
    for (int o = 1; o < 64; o <<= 1) v += __shfl_xor(v, o);
    return v;
}
__device__ __forceinline__ float rstd16(const float* ssq, int row) {
    const f32x4* p = (const f32x4*)(ssq + (size_t)row * 16);
    f32x4 a = p[0], b = p[1], c = p[2], d = p[3];
    f32x4 s = (a + b) + (c + d);
    return rsqrtf(((s[0] + s[1]) + (s[2] + s[3])) * (1.f / 1024.f) + EPS);
}

namespace pg8 {
constexpr int BM = 256, BK = 64, HALF = 128, HTB = HALF * BK * 2, STAGE_BYTES = 8 * HTB, NXCD = 8, WGM = 8;
__host__ __device__ __forceinline__ int lds_byte(int r, int c) { const int st = (r >> 4) * 2 + (c >> 5), rr = r & 15, cc = c & 31, ob = rr * 64 + cc * 2; return st * 1024 + (ob ^ (((ob >> 9) & 1) << 5)); }
__host__ __device__ __forceinline__ void stage_rc(int b, int& R, int& C) { const int st = b / 1024, sb = b % 1024, swz = sb ^ (((sb >> 9) & 1) << 5); R = (st >> 1) * 16 + swz / 64; C = (st & 1) * 32 + (swz % 64) / 2; }
__host__ __device__ __forceinline__ int perm32(int rho) { const int n = rho >> 4, i = rho & 15; return 8 * (i >> 2) + 4 * n + (i & 3); }

struct Unit { int pm, pn, ui; };
struct Gemm { const bf16_t* A; const bf16_t* Bt; int M, N, K, lda, a_pn_off, a_sh; };

struct StaticOrder {
    int nM, nN, nwg, G, c, rev;
    __device__ __forceinline__ void init(int M_, int N_, int G_, int c_) { nM = M_ / BM; nN = N_ / BM; nwg = nM * nN; G = G_; c = c_; rev = 0; }
    __device__ __forceinline__ bool next(int i, Unit& u) const {
        const long L = (long)i * G + c; if (L >= nwg) return false;
        int wgid = (int)L; { const int q = nwg / NXCD, r = nwg % NXCD, xcd = wgid % NXCD, off = wgid / NXCD; wgid = (xcd < r ? xcd * (q + 1) : r * (q + 1) + (xcd - r) * q) + off; }
        const int nig = WGM * nN, gid = wgid / nig, fm = gid * WGM, gsz = (nM - fm) < WGM ? (nM - fm) : WGM;
        u.pm = fm + ((wgid % nig) % gsz); u.pn = (wgid % nig) / gsz; if (rev) u.pm = nM - 1 - u.pm; return true;
    }
};

struct GateOrder {
    StaticOrder base;
    __device__ __forceinline__ bool next(int i, Unit& u) const { Unit t; if (!base.next(i >> 2, t)) return false; u.pm = t.pm; u.pn = (i & 3) * 4 + t.pn; return true; }
};
constexpr int RSL_OFF = 135168;
template <class Sched>
__device__ __forceinline__ void rstd_prepass(LAS unsigned char* lds, const float* ssq, const Sched& S, int tid_) {
    asm volatile("" : "+v"(tid_));
    LAS float* rsl = (LAS float*)(lds + RSL_OFF); Unit u;
    for (int i = tid_ >> 8; i < 10 && S.next(i, u); i += 2) rsl[i * 256 + (tid_ & 255)] = rstd16(ssq, u.pm * 256 + (tid_ & 255));
    __syncthreads();
}
#define RSL(u_, row_) (((const LAS float*)(lds_rs + RSL_OFF))[(u_).ui * 256 + ((row_) & 255)])
template <class Epi, class Sched>
__device__ __forceinline__ void gemm_phase(LAS unsigned char* lds, const Gemm g, const Sched& S, const Epi& E) {
    int tid = threadIdx.x; asm volatile("" : "+v"(tid));
    const int wid = __builtin_amdgcn_readfirstlane(tid >> 6), lane = tid & 63, wr = wid >> 2, wc = wid & 3, fr = lane & 15, fq = lane >> 4;
    int K = g.K, lda = g.lda; asm volatile("" : "+s"(K), "+s"(lda));
    const int nt = K / BK;
    unsigned voffA[2], voffB[2];
#pragma unroll
    for (int i = 0; i < 2; ++i) { int R, C; stage_rc(tid * 16 + i * 8192, R, C); const int Rb = (R & ~31) + perm32(R & 31);
        voffA[i] = (unsigned)(R * lda + C) * 2u; voffB[i] = (unsigned)(Rb * K + C) * 2u; }
    const size_t kstep = (size_t)(BK * 2);
    const size_t hsA = (size_t)HALF * lda * 2, hsB = (size_t)HALF * K * 2;
    const size_t tsA = 2 * hsA, tsB = 2 * hsB, pnA = (size_t)g.a_pn_off * 2;
    const unsigned ldsw = (unsigned)wid * 1024u;
    const int aoff = lds_byte(wr * 64 + fr, fq * 8), boff = lds_byte(wc * 32 + fr, fq * 8);
#define PG8_SA(b, h) (((b) * 2 + (h)) * HTB)
#define PG8_SB(b, h) ((4 + (b) * 2 + (h)) * HTB)
#define PG8_STAGE(bufoff, gbase, voff) do { _Pragma("unroll") for (int _i = 0; _i < 2; ++_i) \
        __builtin_amdgcn_global_load_lds((const unsigned*)((const char*)(gbase) + (voff)[_i]), (LAS unsigned*)(lds + (bufoff) + ldsw + _i * 8192), 16, 0, 0); } while (0)
#define PG8_LDA(dst, b, h) do { _Pragma("unroll") for (int m = 0; m < 4; ++m) _Pragma("unroll") for (int k = 0; k < 2; ++k) dst[m][k] = *(const LAS bf16x8*)(lds + PG8_SA(b, h) + aoff + m * 2048 + k * 1024); } while (0)
#define PG8_LDB(dst, b, h) do { _Pragma("unroll") for (int n = 0; n < 2; ++n) _Pragma("unroll") for (int k = 0; k < 2; ++k) dst[n][k] = *(const LAS bf16x8*)(lds + PG8_SB(b, h) + boff + n * 2048 + k * 1024); } while (0)
#define PG8_MMA(ai, bj, At, Bt) do { __builtin_amdgcn_s_setprio(1); _Pragma("unroll") for (int m = 0; m < 4; ++m) _Pragma("unroll") for (int n = 0; n < 2; ++n) _Pragma("unroll") for (int k = 0; k < 2; ++k) \
        acc[ai][bj][m][n] = __builtin_amdgcn_mfma_f32_16x16x32_bf16(Bt[n][k], At[m][k], acc[ai][bj][m][n], 0, 0, 0); __builtin_amdgcn_s_setprio(0); } while (0)
#define PG8_WAIT_V(n) asm volatile("s_waitcnt vmcnt(" #n ")" ::: "memory")
#define PG8_WAIT_L(n) asm volatile("s_waitcnt lgkmcnt(" #n ")" ::: "memory")
#define PG8_BAR __builtin_amdgcn_s_barrier()
#define PG8_SCHED __builtin_amdgcn_sched_barrier(0)
    Unit cur, nxt; int ui = 0;
    if (!S.next(0, cur)) return;
    f32x4 acc[2][2][4][2];
#pragma unroll
    for (int a = 0; a < 2; ++a)
#pragma unroll
        for (int b = 0; b < 2; ++b)
#pragma unroll
            for (int m = 0; m < 4; ++m)
#pragma unroll
                for (int n = 0; n < 2; ++n) acc[a][b][m][n] = (f32x4){0.f, 0.f, 0.f, 0.f};
    bf16x8 At[4][2], B0[2][2], B1[2][2];
    const char* cA = (const char*)g.A + (size_t)cur.pm * tsA + (size_t)(cur.pn >> g.a_sh) * pnA; const char* cB = (const char*)g.Bt + (size_t)cur.pn * tsB;
    PG8_STAGE(PG8_SB(0, 0), cB, voffB); PG8_STAGE(PG8_SB(0, 1), cB + hsB, voffB); PG8_STAGE(PG8_SA(0, 0), cA, voffA); PG8_STAGE(PG8_SA(0, 1), cA + hsA, voffA);
    if (wr == 1) PG8_BAR;
    PG8_WAIT_V(2); PG8_BAR;
    PG8_STAGE(PG8_SB(1, 0), cB + kstep, voffB); PG8_STAGE(PG8_SA(1, 0), cA + kstep, voffA); PG8_STAGE(PG8_SB(1, 1), cB + hsB + kstep, voffB);
    PG8_WAIT_V(6); PG8_BAR;
    for (;;) {
        const bool has_next = S.next(ui + 1, nxt);
        const char* nA = has_next ? (const char*)g.A + (size_t)nxt.pm * tsA + (size_t)(nxt.pn >> g.a_sh) * pnA : cA; const char* nB = has_next ? (const char*)g.Bt + (size_t)nxt.pn * tsB : cB;
        for (int t = 0; t < nt; t += 2) {
            const bool last = (t == nt - 2);
            const char* a1 = cA + (size_t)(t + 1) * kstep;
            const char* a2 = last ? nA : cA + (size_t)(t + 2) * kstep; const char* b2 = last ? nB : cB + (size_t)(t + 2) * kstep;
            const char* a3 = a2 + kstep; const char* b3 = b2 + kstep;
            PG8_LDB(B0, 0, 0); PG8_LDB(B1, 0, 1); PG8_SCHED; PG8_LDA(At, 0, 0); PG8_STAGE(PG8_SA(1, 1), a1 + hsA, voffA);
            PG8_WAIT_V(8); PG8_WAIT_L(0); PG8_BAR; PG8_MMA(0, 0, At, B0); PG8_MMA(0, 1, At, B1); PG8_BAR; PG8_SCHED;
            PG8_LDA(At, 0, 1); PG8_STAGE(PG8_SB(0, 0), b2, voffB); PG8_STAGE(PG8_SB(0, 1), b2 + hsB, voffB); PG8_STAGE(PG8_SA(0, 0), a2, voffA);
            PG8_WAIT_V(8); PG8_WAIT_L(0); PG8_BAR; PG8_MMA(1, 0, At, B0); PG8_MMA(1, 1, At, B1); PG8_BAR; PG8_SCHED;
            PG8_LDB(B0, 1, 0); PG8_LDB(B1, 1, 1); PG8_SCHED; PG8_LDA(At, 1, 0); PG8_STAGE(PG8_SA(0, 1), a2 + hsA, voffA);
            PG8_WAIT_V(8); PG8_WAIT_L(0); PG8_BAR; PG8_MMA(0, 0, At, B0); PG8_MMA(0, 1, At, B1); PG8_BAR; PG8_SCHED;
            PG8_LDA(At, 1, 1); PG8_STAGE(PG8_SB(1, 0), b3, voffB); PG8_STAGE(PG8_SB(1, 1), b3 + hsB, voffB); PG8_STAGE(PG8_SA(1, 0), a3, voffA);
            PG8_WAIT_V(8); PG8_WAIT_L(0); PG8_BAR; PG8_MMA(1, 0, At, B0); PG8_MMA(1, 1, At, B1); PG8_BAR; PG8_SCHED;
        }
        if (wr == 0) PG8_BAR;
        cur.ui = ui; E(acc, cur, wr, wc, fr, fq);
        if (!has_next) break;
#pragma unroll
        for (int a = 0; a < 2; ++a)
#pragma unroll
            for (int b = 0; b < 2; ++b)
#pragma unroll
                for (int m = 0; m < 4; ++m)
#pragma unroll
                    for (int n = 0; n < 2; ++n) acc[a][b][m][n] = (f32x4){0.f, 0.f, 0.f, 0.f};
        cur = nxt; cA = nA; cB = nB; ++ui;
        if (wr == 1) PG8_BAR;
    }
    PG8_WAIT_V(0);
    PG8_BAR;
#undef PG8_SA
#undef PG8_SB
#undef PG8_STAGE
#undef PG8_LDA
#undef PG8_LDB
#undef PG8_MMA
#undef PG8_WAIT_V
#undef PG8_WAIT_L
#undef PG8_BAR
#undef PG8_SCHED
}

struct MUnit { int pm, pn, ui, kind, n; };
struct MergeOrder { StaticOrder base;
    __device__ __forceinline__ bool next(int i, MUnit& u) const { Unit t; if (!base.next(i >> 3, t)) return false; u.pm = t.pm; u.pn = t.pn; u.n = (i >> 1) & 3; u.kind = i & 1; u.ui = i; return true; } };
template <class Epi>
__device__ __forceinline__ void gemm_merge_fused(LAS unsigned char* lds, const bf16_t* Yb, const bf16_t* XBb, const bf16_t* WBR, const bf16_t* WG, const MergeOrder& S, const Epi& E) {
    int tid = threadIdx.x; asm volatile("" : "+v"(tid));
    const int wid = __builtin_amdgcn_readfirstlane(tid >> 6), lane = tid & 63, wr = wid >> 2, wc = wid & 3, fr = lane & 15, fq = lane >> 4;
    int R0, C0; stage_rc(tid * 16, R0, C0);
    const unsigned Rb0 = (unsigned)((R0 & ~31) + perm32(R0 & 31)), Ra0 = (unsigned)R0, C2 = (unsigned)C0 * 2u;
    int la0 = 4096, lb0 = 1024, la1_ = 2048, lb1 = 2048, nt0 = 8, nt1 = 16;
    asm volatile("" : "+s"(la0), "+s"(lb0), "+s"(la1_), "+s"(lb1), "+s"(nt0), "+s"(nt1));
#define MF_LA(k) ((unsigned)((k) ? la1_ : la0))
#define MF_LB(k) ((unsigned)((k) ? lb1 : lb0))
    const size_t kstep = (size_t)(BK * 2);
#define MF_ABASE(u_) ((u_).kind ? (const char*)XBb + (size_t)(u_).pm * 256 * 1024 * 2 : (const char*)Yb + (size_t)(u_).pm * 256 * 2048 * 2 + (size_t)(u_).n * 512 * 2)
#define MF_BBASE(u_) ((u_).kind ? (const char*)WG + ((size_t)(u_).n * 1024 + (size_t)(u_).pn * 256) * 1024 * 2 : (const char*)WBR + ((size_t)(u_).n * 1024 + (size_t)(u_).pn * 256) * 512 * 2)
    const unsigned ldsw = (unsigned)wid * 1024u;
    const int aoff = lds_byte(wr * 64 + fr, fq * 8), boff = lds_byte(wc * 32 + fr, fq * 8);
#define PG8_SA(b, h) (((b) * 2 + (h)) * HTB)
#define PG8_SB(b, h) ((4 + (b) * 2 + (h)) * HTB)
#define PG8_STAGE(bufoff, gbase, voff) do { _Pragma("unroll") for (int _i = 0; _i < 2; ++_i) \
        __builtin_amdgcn_global_load_lds((const unsigned*)((const char*)(gbase) + (voff)[_i]), (LAS unsigned*)(lds + (bufoff) + ldsw + _i * 8192), 16, 0, 0); } while (0)
#define PG8_LDA(dst, b, h) do { _Pragma("unroll") for (int m = 0; m < 4; ++m) _Pragma("unroll") for (int k = 0; k < 2; ++k) dst[m][k] = *(const LAS bf16x8*)(lds + PG8_SA(b, h) + aoff + m * 2048 + k * 1024); } while (0)
#define PG8_LDB(dst, b, h) do { _Pragma("unroll") for (int n = 0; n < 2; ++n) _Pragma("unroll") for (int k = 0; k < 2; ++k) dst[n][k] = *(const LAS bf16x8*)(lds + PG8_SB(b, h) + boff + n * 2048 + k * 1024); } while (0)
#define PG8_MMA(ai, bj, At, Bt) do { __builtin_amdgcn_s_setprio(1); _Pragma("unroll") for (int m = 0; m < 4; ++m) _Pragma("unroll") for (int n = 0; n < 2; ++n) _Pragma("unroll") for (int k = 0; k < 2; ++k) \
        acc[ai][bj][m][n] = __builtin_amdgcn_mfma_f32_16x16x32_bf16(Bt[n][k], At[m][k], acc[ai][bj][m][n], 0, 0, 0); __builtin_amdgcn_s_setprio(0); } while (0)
#define PG8_WAIT_V(n) asm volatile("s_waitcnt vmcnt(" #n ")" ::: "memory")
#define PG8_WAIT_L(n) asm volatile("s_waitcnt lgkmcnt(" #n ")" ::: "memory")
#define PG8_BAR __builtin_amdgcn_s_barrier()
#define PG8_SCHED __builtin_amdgcn_sched_barrier(0)
    MUnit cur, nxt; int ui = 0;
    if (!S.next(0, cur)) return;
    f32x4 acc[2][2][4][2];
#pragma unroll
    for (int a = 0; a < 2; ++a)
#pragma unroll
        for (int b = 0; b < 2; ++b)
#pragma unroll
            for (int m = 0; m < 4; ++m)
#pragma unroll
                for (int n = 0; n < 2; ++n) acc[a][b][m][n] = (f32x4){0.f, 0.f, 0.f, 0.f};
    bf16x8 At[4][2], B0[2][2], B1[2][2];
    const char* cA = MF_ABASE(cur); const char* cB = MF_BBASE(cur); int ck = cur.kind;
    { const unsigned la = MF_LA(ck), lb = MF_LB(ck); unsigned voffA[2] = {Ra0 * la + C2, Ra0 * la + C2 + 64u * la}, voffB[2] = {Rb0 * lb + C2, Rb0 * lb + C2 + 64u * lb}; const size_t hsA = (size_t)128 * la, hsB = (size_t)128 * lb;
    PG8_STAGE(PG8_SB(0, 0), cB, voffB); PG8_STAGE(PG8_SB(0, 1), cB + hsB, voffB); PG8_STAGE(PG8_SA(0, 0), cA, voffA); PG8_STAGE(PG8_SA(0, 1), cA + hsA, voffA);
    if (wr == 1) PG8_BAR;
    PG8_WAIT_V(2); PG8_BAR;
    PG8_STAGE(PG8_SB(1, 0), cB + kstep, voffB); PG8_STAGE(PG8_SA(1, 0), cA + kstep, voffA); PG8_STAGE(PG8_SB(1, 1), cB + hsB + kstep, voffB);
    PG8_WAIT_V(6); PG8_BAR; }
    for (;;) {
        const bool has_next = S.next(ui + 1, nxt);
        const char* nA = cA; const char* nB = cB; int nk = ck;
        if (has_next) { nA = MF_ABASE(nxt); nB = MF_BBASE(nxt); nk = nxt.kind; }
        const int nt = ck ? nt1 : nt0;
        for (int t = 0; t < nt; t += 2) {
            const bool last = (t == nt - 2);
            const int kx = last ? nk : ck;
            const unsigned la1 = MF_LA(ck), lax = MF_LA(kx), lbx = MF_LB(kx);
            unsigned voffA1[2] = {Ra0 * la1 + C2, Ra0 * la1 + C2 + 64u * la1};
            unsigned voffA[2] = {Ra0 * lax + C2, Ra0 * lax + C2 + 64u * lax};
            unsigned voffB[2] = {Rb0 * lbx + C2, Rb0 * lbx + C2 + 64u * lbx};
            const size_t hsA1 = (size_t)128 * la1, hsA = (size_t)128 * lax, hsB = (size_t)128 * lbx;
            const char* a1 = cA + (size_t)(t + 1) * kstep;
            const char* a2 = last ? nA : cA + (size_t)(t + 2) * kstep; const char* b2 = last ? nB : cB + (size_t)(t + 2) * kstep;
            const char* a3 = a2 + kstep; const char* b3 = b2 + kstep;
            PG8_LDB(B0, 0, 0); PG8_LDB(B1, 0, 1); PG8_SCHED; PG8_LDA(At, 0, 0); PG8_STAGE(PG8_SA(1, 1), a1 + hsA1, voffA1);
            PG8_WAIT_V(8); PG8_WAIT_L(0); PG8_BAR; PG8_MMA(0, 0, At, B0); PG8_MMA(0, 1, At, B1); PG8_BAR; PG8_SCHED;
            PG8_LDA(At, 0, 1); PG8_STAGE(PG8_SB(0, 0), b2, voffB); PG8_STAGE(PG8_SB(0, 1), b2 + hsB, voffB); PG8_STAGE(PG8_SA(0, 0), a2, voffA);
            PG8_WAIT_V(8); PG8_WAIT_L(0); PG8_BAR; PG8_MMA(1, 0, At, B0); PG8_MMA(1, 1, At, B1); PG8_BAR; PG8_SCHED;
            PG8_LDB(B0, 1, 0); PG8_LDB(B1, 1, 1); PG8_SCHED; PG8_LDA(At, 1, 0); PG8_STAGE(PG8_SA(0, 1), a2 + hsA, voffA);
            PG8_WAIT_V(8); PG8_WAIT_L(0); PG8_BAR; PG8_MMA(0, 0, At, B0); PG8_MMA(0, 1, At, B1); PG8_BAR; PG8_SCHED;
            PG8_LDA(At, 1, 1); PG8_STAGE(PG8_SB(1, 0), b3, voffB); PG8_STAGE(PG8_SB(1, 1), b3 + hsB, voffB); PG8_STAGE(PG8_SA(1, 0), a3, voffA);
            PG8_WAIT_V(8); PG8_WAIT_L(0); PG8_BAR; PG8_MMA(1, 0, At, B0); PG8_MMA(1, 1, At, B1); PG8_BAR; PG8_SCHED;
        }
        if (wr == 0) PG8_BAR;
        cur.ui = ui; E(acc, cur, wr, wc, fr, fq);
        if (!has_next) break;
#pragma unroll
        for (int a = 0; a < 2; ++a)
#pragma unroll
            for (int b = 0; b < 2; ++b)
#pragma unroll
                for (int m = 0; m < 4; ++m)
#pragma unroll
                    for (int n = 0; n < 2; ++n) acc[a][b][m][n] = (f32x4){0.f, 0.f, 0.f, 0.f};
        cur = nxt; cA = nA; cB = nB; ck = nk; ++ui;
        if (wr == 1) PG8_BAR;
    }
    PG8_WAIT_V(0);
    PG8_BAR;
#undef MF_ABASE
#undef MF_BBASE
#undef MF_LA
#undef MF_LB
#undef PG8_SA
#undef PG8_SB
#undef PG8_STAGE
#undef PG8_LDA
#undef PG8_LDB
#undef PG8_MMA
#undef PG8_WAIT_V
#undef PG8_WAIT_L
#undef PG8_BAR
#undef PG8_SCHED
}

#define EPI_ROWS_BEGIN _Pragma("unroll") for (int ai = 0; ai < 2; ++ai) _Pragma("unroll") for (int m = 0; m < 4; ++m) { const int row = u.pm * 256 + ai * 128 + wr * 64 + m * 16 + fr;
#define EPI_ROWS_END if (m & 1) asm volatile("" ::: "memory"); }
typedef const f32x4 (&AccRef)[2][2][4][2];

struct EpiInproj {
    bf16_t *u1, *ua, *ub; const LAS unsigned char* lds_rs;
    __device__ __forceinline__ void operator()(AccRef acc, const Unit& u, int wr, int wc, int fr, int fq) const {
        bf16_t* base; int ld, ct; const int pn = u.pn;
        if (pn < 4) { base = u1; ld = 1024; ct = pn; } else if (pn < 7) { base = ua; ld = 768; ct = pn - 4; } else { base = ub; ld = 1792; ct = pn - 7; }
        const int col0 = ct * 256 + wc * 32 + 8 * fq;
        EPI_ROWS_BEGIN
            const float r = RSL(u, row);
#pragma unroll
            for (int bj = 0; bj < 2; ++bj) *(u32x4*)(base + (size_t)row * ld + col0 + bj * 128) = pack8(acc[ai][bj][m][0] * r, acc[ai][bj][m][1] * r);
        EPI_ROWS_END
    }
};
struct EpiQ {
    bf16_t *y, *qr; const float* rsq; const f32x2* cs;
    __device__ __forceinline__ void operator()(AccRef acc, const Unit& u, int wr, int wc, int fr, int fq) const {
        const int pn = u.pn;
        EPI_ROWS_BEGIN
            const float r = rsq[row] * QSCALE;
#pragma unroll
            for (int bj = 0; bj < 2; ++bj) {
                f32x4 v0 = acc[ai][bj][m][0] * r, v1 = acc[ai][bj][m][1] * r;
                if (pn < 2) { *(u32x4*)(y + (size_t)row * 2048 + pn * 256 + bj * 128 + wc * 32 + 8 * fq) = pack8(v0, v1); }
                else {
                    const int c0 = bj * 128 + wc * 32 + 8 * fq, i0 = (c0 & 31) >> 1;
                    const f32x4* cp = (const f32x4*)(cs + (size_t)row * 16 + i0);
                    const f32x4 t0 = cp[0], t1 = cp[1];
                    f32x4 o0, o1;
                    o0[0] = v0[0] * t0[0] - v0[1] * t0[1]; o0[1] = v0[1] * t0[0] + v0[0] * t0[1];
                    o0[2] = v0[2] * t0[2] - v0[3] * t0[3]; o0[3] = v0[3] * t0[2] + v0[2] * t0[3];
                    o1[0] = v1[0] * t1[0] - v1[1] * t1[1]; o1[1] = v1[1] * t1[0] + v1[0] * t1[1];
                    o1[2] = v1[2] * t1[2] - v1[3] * t1[3]; o1[3] = v1[3] * t1[2] + v1[2] * t1[3];
                    *(u32x4*)(qr + (size_t)row * 256 + c0) = pack8(o0, o1);
                }
            }
        EPI_ROWS_END
    }
};
struct EpiRowScale {
    bf16_t* o0; int ld; const float* rs; size_t split;
    __device__ __forceinline__ void operator()(AccRef acc, const Unit& u, int wr, int wc, int fr, int fq) const {
        bf16_t* o = split ? o0 + (size_t)(u.pn >> 2) * split : o0;
        const int col0 = (split ? (u.pn & 3) : u.pn) * 256 + wc * 32 + 8 * fq;
        EPI_ROWS_BEGIN
            const float r = rs ? rs[row] : 1.f;
#pragma unroll
            for (int bj = 0; bj < 2; ++bj) *(u32x4*)(o + (size_t)row * ld + col0 + bj * 128) = pack8(acc[ai][bj][m][0] * r, acc[ai][bj][m][1] * r);
        EPI_ROWS_END
    }
};
struct EpiLru {
    bf16_t* y3; bf16_t* la; const float *b_a, *b_i, *lam;
    __device__ __forceinline__ void operator()(AccRef acc, const Unit& u, int wr, int wc, int fr, int fq) const {
#pragma unroll
        for (int n = 0; n < 2; ++n) {
            const int ch0 = u.pn * 128 + wc * 32 + 8 * fq + 4 * n;
            const f32x4 ba = *(const f32x4*)(b_a + ch0), bi = *(const f32x4*)(b_i + ch0), lm = *(const f32x4*)(lam + ch0);
            f32x4 sp;
#pragma unroll
            for (int e = 0; e < 4; ++e) sp[e] = -8.f * log1pf(__expf(-lm[e]));
            EPI_ROWS_BEGIN
                bf16_t* xp = y3 + (size_t)row * 2048 + ch0;
                const u32x2 xw = *(const u32x2*)xp;
                const f32x4 xc = (f32x4){bflo(xw.x), bfhi(xw.x), bflo(xw.y), bfhi(xw.y)};
                f32x4 uo, lo;
#pragma unroll
                for (int e = 0; e < 4; ++e) {
                    const float rr = acc[ai][0][m][n][e] + ba[e], ii = acc[ai][1][m][n][e] + bi[e];
                    const float log_a = sp[e] * sigmoidf_(rr);
                    const float mult = sqrtf(one_minus_exp(2.f * log_a));
                    uo[e] = xc[e] * sigmoidf_(ii) * mult; lo[e] = log_a;
                }
                u32x2 w0, w1; w0.x = cvt_pk_bf16(uo[0], uo[1]); w0.y = cvt_pk_bf16(uo[2], uo[3]); w1.x = cvt_pk_bf16(lo[0], lo[1]); w1.y = cvt_pk_bf16(lo[2], lo[3]);
                *(u32x2*)xp = w0;
                *(u32x2*)(la + (size_t)row * 512 + ch0) = w1;
                asm volatile("" ::: "memory");
            EPI_ROWS_END
        }
    }
};
struct EpiGate {
    const LAS unsigned char* lds_rs; const bf16_t* tall; bf16_t* mb; const float* rsc;
    __device__ __forceinline__ void operator()(AccRef acc, const Unit& u, int wr, int wc, int fr, int fq) const {
        const int n = u.pn >> 2; const bf16_t* tn = tall + (size_t)n * 64 * MiB / 2; const float* trs = (n == 2) ? rsc : nullptr;
        const int col0 = (u.pn & 3) * 256 + wc * 32 + 8 * fq;
        u32x4 tq[2][4][2];
#pragma unroll
        for (int ai = 0; ai < 2; ++ai)
#pragma unroll
            for (int m = 0; m < 4; ++m)
#pragma unroll
                for (int bj = 0; bj < 2; ++bj) tq[ai][m][bj] = *(const u32x4*)(tn + (size_t)(u.pm * 256 + ai * 128 + wr * 64 + m * 16 + fr) * 1024 + col0 + bj * 128);
        EPI_ROWS_BEGIN
            const float r = RSL(u, row); const float ts = trs ? trs[row] : 1.f;
#pragma unroll
            for (int bj = 0; bj < 2; ++bj) {
                const size_t off = (size_t)row * 1024 + col0 + bj * 128;
                f32x4 t0, t1; unpack8(tq[ai][m][bj], t0, t1); t0 = t0 * ts; t1 = t1 * ts;
                f32x4 g0 = acc[ai][bj][m][0] * r, g1 = acc[ai][bj][m][1] * r;
#pragma unroll
                for (int e = 0; e < 4; ++e) { g0[e] = sigmoidf_(g0[e]) * t0[e]; g1[e] = sigmoidf_(g1[e]) * t1[e]; }
                if (n > 0) { f32x4 p0, p1; unpack8(*(const u32x4*)(mb + off), p0, p1); g0 += p0; g1 += p1; }
                *(u32x4*)(mb + off) = pack8(g0, g1);
            }
        EPI_ROWS_END
    }
};
struct EpiMerge {
    const LAS unsigned char* lds_rs; bf16_t* tall; bf16_t* mb;
    __device__ __forceinline__ void operator()(AccRef acc, const MUnit& u, int wr, int wc, int fr, int fq) const {
        const int n = u.n; bf16_t* tn = tall;
        const int col0 = u.pn * 256 + wc * 32 + 8 * fq;
        if (u.kind == 0) {
            EPI_ROWS_BEGIN
#pragma unroll
                for (int bj = 0; bj < 2; ++bj) *(u32x4*)(tn + (size_t)row * 1024 + col0 + bj * 128) = pack8(acc[ai][bj][m][0], acc[ai][bj][m][1]);
            EPI_ROWS_END
        } else {
            const LAS float* rsl = (const LAS float*)(lds_rs + RSL_OFF) + (u.ui >> 3) * 256;
            u32x4 tq[2][4][2];
#pragma unroll
            for (int ai = 0; ai < 2; ++ai)
#pragma unroll
                for (int m = 0; m < 4; ++m)
#pragma unroll
                    for (int bj = 0; bj < 2; ++bj) tq[ai][m][bj] = *(const u32x4*)(tn + (size_t)(u.pm * 256 + ai * 128 + wr * 64 + m * 16 + fr) * 1024 + col0 + bj * 128);
            EPI_ROWS_BEGIN
                const float r = rsl[row & 255]; const float ts = (n == 2) ? rsl[1024 + (row & 255)] : 1.f;
#pragma unroll
                for (int bj = 0; bj < 2; ++bj) {
                    const size_t off = (size_t)row * 1024 + col0 + bj * 128;
                    f32x4 t0, t1; unpack8(tq[ai][m][bj], t0, t1); t0 = t0 * ts; t1 = t1 * ts;
                    f32x4 g0 = acc[ai][bj][m][0] * r, g1 = acc[ai][bj][m][1] * r;
#pragma unroll
                    for (int e = 0; e < 4; ++e) { g0[e] = sigmoidf_(g0[e]) * t0[e]; g1[e] = sigmoidf_(g1[e]) * t1[e]; }
                    if (n > 0) { f32x4 p0, p1; unpack8(*(const u32x4*)(mb + off), p0, p1); g0 += p0; g1 += p1; }
                    *(u32x4*)(mb + off) = pack8(g0, g1);
                }
            EPI_ROWS_END
        }
    }
};
__device__ __forceinline__ void merge_prepass(LAS unsigned char* lds, const float* ssq, const float* ssqc, const MergeOrder& S, int tid_) {
    asm volatile("" : "+v"(tid_));
    LAS float* rsl = (LAS float*)(lds + RSL_OFF); Unit t;
    const int ti = tid_ >> 8, rr = tid_ & 255;
    if (S.base.next(ti, t)) { const int row = t.pm * 256 + rr; rsl[ti * 256 + rr] = rstd16(ssq, row);
        const f32x4* p = (const f32x4*)(ssqc + (size_t)row * 16); const f32x4 a = p[0], b = p[1], c = p[2], d = p[3]; const f32x4 q = (a + b) + (c + d);
        rsl[1024 + ti * 256 + rr] = rsqrtf(((q[0] + q[1]) + (q[2] + q[3])) * (1.f / 512.f) + EPS); }
    __syncthreads();
}
template <int MODE  > struct EpiRes {
    const float* xold; float* xf; bf16_t* xb; float* ssq_out; const LAS unsigned char* lds_rs; const bf16_t* tp;
    __device__ __forceinline__ void operator()(AccRef acc, const Unit& u, int wr, int wc, int fr, int fq) const {
        const int col0 = u.pn * 256 + wc * 32 + 8 * fq;
        EPI_ROWS_BEGIN
            float r = 1.f; if (MODE == 1) r = RSL(u, row);
            float ss = 0.f;
#pragma unroll
            for (int bj = 0; bj < 2; ++bj) {
                const size_t off = (size_t)row * 1024 + col0 + bj * 128;
                f32x4 a0 = acc[ai][bj][m][0], a1 = acc[ai][bj][m][1];
                if (MODE == 1) { f32x4 t0, t1; unpack8(*(const u32x4*)(tp + off), t0, t1);
#pragma unroll
                    for (int e = 0; e < 4; ++e) { a0[e] = sigmoidf_(a0[e] * r) * t0[e]; a1[e] = sigmoidf_(a1[e] * r) * t1[e]; } }
                const f32x4 n0 = *(const f32x4*)(xold + off) + a0, n1 = *(const f32x4*)(xold + off + 4) + a1;
                *(f32x4*)(xf + off) = n0; *(f32x4*)(xf + off + 4) = n1;
                if (MODE == 0) *(u32x4*)(xb + off) = pack8(n0, n1);
                ss += (n0[0] * n0[0] + n0[1] * n0[1]) + (n0[2] * n0[2] + n0[3] * n0[3]) + (n1[0] * n1[0] + n1[1] * n1[1]) + (n1[2] * n1[2] + n1[3] * n1[3]);
            }
            ss += __shfl_xor(ss, 16); ss = xhalf_sum(ss);
            if (fq == 0) ssq_out[(size_t)row * 16 + u.pn * 4 + wc] = ss;
        EPI_ROWS_END
    }
};
struct EpiFF1 {
    bf16_t* h; const LAS unsigned char* lds_rs;
    __device__ __forceinline__ void operator()(AccRef acc, const Unit& u, int wr, int wc, int fr, int fq) const {
        const int col0 = u.pn * 256 + wc * 32 + 8 * fq;
        EPI_ROWS_BEGIN
            const float r = RSL(u, row);
#pragma unroll
            for (int bj = 0; bj < 2; ++bj) {
                f32x4 a0 = acc[ai][bj][m][0] * r, a1 = acc[ai][bj][m][1] * r;
#pragma unroll
                for (int e = 0; e < 4; ++e) { const float p = fmaxf(a0[e], 0.f), q = fmaxf(a1[e], 0.f); a0[e] = p * p; a1[e] = q * q; }
                *(u32x4*)(h + (size_t)row * 4096 + col0 + bj * 128) = pack8(a0, a1);
            }
        EPI_ROWS_END
    }
};
}

__device__ __forceinline__ void conv_weights(PP P, int l, bf16_t* W, int tid_, int bid_, int ngt, LAS unsigned char* lds) {
    asm volatile("" : "+v"(tid_)); const int gt = bid_ * 512 + tid_;
    if (l == 0 && gt < 64) ((unsigned*)P->ws)[64 + gt] = 0u;
    const float* g_mix = P->in[3] + l * 1024; const float* w_in = P->in[4] + (size_t)l * 1024 * INC;
    const float* q_norm = P->in[5] + l * 384; const float* w_uq = P->in[6] + (size_t)l * 384 * 768;
    const float* kv_norm = P->in[7] + l * 256; const float* w_ukv = P->in[8] + (size_t)l * 256 * 1024;
    const float* w_pool = P->in[9] + (size_t)l * 4 * 128 * 128; const float* pool_scale = P->in[10] + l * 512;
    const float* ssd_norm = P->in[16] + l * 512;
    const float* w_a = P->in[19] + (size_t)l * 8 * 64 * 64; const float* w_i = P->in[21] + (size_t)l * 8 * 64 * 64;
    const float* w_branch = P->in[24] + (size_t)l * 4 * 512 * 1024; const float* w_out = P->in[25] + (size_t)l * 1024 * 1024;
    const float* g_mlp = P->in[26] + l * 1024; const float* w_ff1 = P->in[27] + (size_t)l * 1024 * 4096; const float* w_ff2 = P->in[28] + (size_t)l * 4096 * 1024;
    const float* g_ple = P->in[29] + l * 1024; const float* w_pg = P->in[30] + (size_t)l * 1024 * 1024; const float* w_ple = P->in[31] + (size_t)l * 256 * 1024;
    constexpr int TOTAL_ITEMS = (int)(W_TOTAL / 2048);
    const int wave_ = tid_ >> 6, lane = tid_ & 63;
    LAS float* scr = (LAS float*)(lds + wave_ * 8448);
    for (int item = bid_ * 8 + wave_; item < TOTAL_ITEMS; item += ngt / 64) {
        const long e = (long)item * 2048;
        int N, K; size_t base; int mat;
        if (e < (long)W_G) { mat = 0; base = W_IN; N = 3584; K = 1024; }
        else if (e < (long)W_UQ) { mat = 1; base = W_G; N = 4096; K = 1024; }
        else if (e < (long)W_UKV) { mat = 2; base = W_UQ; N = 768; K = 384; }
        else if (e < (long)W_POOL) { mat = 3; base = W_UKV; N = 1024; K = 256; }
        else if (e < (long)W_LRU) { mat = 4; base = W_POOL; N = 512; K = 256; }
        else if (e < (long)W_BR) { mat = 5; base = W_LRU; N = 1024; K = 128; }
        else if (e < (long)W_OUT) { mat = 6; base = W_BR; N = 4096; K = 512; }
        else if (e < (long)W_FF1) { mat = 7; base = W_OUT; N = 1024; K = 1024; }
        else if (e < (long)W_FF2) { mat = 8; base = W_FF1; N = 4096; K = 1024; }
        else if (e < (long)W_PG) { mat = 9; base = W_FF2; N = 1024; K = 4096; }
        else if (e < (long)W_PLE) { mat = 10; base = W_PG; N = 1024; K = 1024; }
        else { mat = 11; base = W_PLE; N = 1024; K = 256; }
        const int idx = item - (int)(base / 2048), nblk = N / 32, n0 = (idx % nblk) * 32, k0 = (idx / nblk) * 64;
        const int n = n0 + (lane & 31);
        const float* ptr = nullptr; int stride = 0; const float* gk = nullptr; float sn = 1.f; bool valid = true;
        switch (mat) {
        case 0: { int sc;
            if (n < 512) sc = 1184 + n; else if (n < 1024) sc = 2472 + (n - 512);
            else if (n < 1408) sc = n - 1024; else if (n < 1664) sc = 384 + (n - 1408); else if (n < 1696) sc = 640 + (n - 1664);
            else if (n < 1704) sc = 2464 + (n - 1696); else if (n < 1792) { sc = 0; valid = false; }
            else { const int q = n - 1792; if (q < 512) sc = 672 + q; else if (q < 1280) sc = 1696 + (q - 512); else sc = 2984 + (q - 1280); }
            ptr = w_in + (size_t)k0 * INC + sc; stride = INC; gk = g_mix + k0; } break;
        case 1: ptr = w_in + (size_t)k0 * INC + 3496 + n; stride = INC; gk = g_mix + k0; break;
        case 2: { int sc; if (n < 512) sc = (n >> 6) * 96 + (n & 63); else { const int q = n - 512, hd = q >> 5, jj = q & 31; sc = hd * 96 + 64 + (jj & 1) * 16 + (jj >> 1); }
            ptr = w_uq + (size_t)k0 * 768 + sc; stride = 768; gk = q_norm + k0; } break;
        case 3: { int sc; if (n < 512) sc = (n >> 6) * 128 + (n & 63); else { const int q = n - 512; sc = (q >> 6) * 128 + 64 + (q & 63); }
            ptr = w_ukv + (size_t)k0 * 1024 + sc; stride = 1024; gk = kv_norm + k0; } break;
        case 4: { const int g = n >> 7, j = n & 127, pn = n >> 8, gk_ = 2 * pn + (k0 >> 7), i0 = k0 & 127; valid = (gk_ == g);
            ptr = w_pool + (size_t)g * 16384 + i0 * 128 + j; stride = 128; sn = pool_scale[n]; } break;
        case 5: { const int pn = n >> 8, bj = (n & 255) >> 7, ch = 128 * pn + (n & 127), hb = ch >> 6, j = ch & 63, hbk = 2 * pn + (k0 >> 6), i0 = k0 & 63; valid = (hbk == hb);
            ptr = (bj ? w_i : w_a) + (size_t)hb * 4096 + i0 * 64 + j; stride = 64; } break;
        case 6: { const int br = n >> 10, nn = n & 1023; ptr = w_branch + (size_t)br * 512 * 1024 + (size_t)k0 * 1024 + nn; stride = 1024; if (br == 2) gk = ssd_norm + k0; } break;
        case 7: ptr = w_out + (size_t)k0 * 1024 + n; stride = 1024; break;
        case 8: ptr = w_ff1 + (size_t)k0 * 4096 + n; stride = 4096; gk = g_mlp + k0; break;
        case 9: ptr = w_ff2 + (size_t)k0 * 1024 + n; stride = 1024; break;
        case 10: ptr = w_pg + (size_t)k0 * 1024 + n; stride = 1024; gk = g_ple + k0; break;
        default: ptr = w_ple + (size_t)k0 * 1024 + n; stride = 1024; break;
        }
        const int kh = lane >> 5;
#pragma unroll 8
        for (int i = 0; i < 32; ++i) { const int kk = 2 * i + kh; float x = 0.f; if (valid) { x = ptr[(size_t)kk * stride] * sn; if (gk) x *= gk[kk]; } scr[kk * 33 + (lane & 31)] = x; }
        asm volatile("s_waitcnt lgkmcnt(0)" ::: "memory");
        const int c = lane & 7;
#pragma unroll
        for (int jj = 0; jj < 4; ++jj) { const int nn = (lane >> 3) + 8 * jj; const LAS float* sp_ = scr + (8 * c) * 33 + nn;
            u32x4 o; o.x = cvt_pk_bf16(sp_[0], sp_[33]); o.y = cvt_pk_bf16(sp_[66], sp_[99]); o.z = cvt_pk_bf16(sp_[132], sp_[165]); o.w = cvt_pk_bf16(sp_[198], sp_[231]);
            *(u32x4*)(W + base + (size_t)(n0 + nn) * K + k0 + 8 * c) = o; }
        asm volatile("s_waitcnt lgkmcnt(0)" ::: "memory");
    }
}

__device__ __forceinline__ void p0_rows(PP P, const float* x, bool first, bf16_t* XB, float* ssq, f32x2* CS, int gw, int ngw, int tid_) {
    asm volatile("" : "+v"(tid_)); const int lane = tid_ & 63;
    const int* pos = (const int*)P->in[2];
    f32x4 v[4][4], nx[4][4];
#pragma unroll
    for (int u = 0; u < 4; ++u) { const int m = gw + u * ngw; if (m < M) { const f32x4* xr = (const f32x4*)(x + (size_t)m * D) + lane;
#pragma unroll
        for (int j = 0; j < 4; ++j) v[u][j] = xr[64 * j]; } }
    for (int mb = gw; mb < M; mb += 4 * ngw) {
#pragma unroll
        for (int u = 0; u < 4; ++u) { const int m = mb + 4 * ngw + u * ngw; if (m < M) { const f32x4* xr = (const f32x4*)(x + (size_t)m * D) + lane;
#pragma unroll
            for (int j = 0; j < 4; ++j) nx[u][j] = xr[64 * j]; } }
#pragma unroll
        for (int u = 0; u < 4; ++u) { const int m = mb + u * ngw; if (m >= M) continue; u32x2* o = (u32x2*)(XB + (size_t)m * D) + lane; float s = 0.f;
#pragma unroll
            for (int j = 0; j < 4; ++j) { const f32x4 t = v[u][j]; s += (t[0] * t[0] + t[1] * t[1]) + (t[2] * t[2] + t[3] * t[3]); u32x2 w; w.x = cvt_pk_bf16(t[0], t[1]); w.y = cvt_pk_bf16(t[2], t[3]); o[64 * j] = w; }
            if (first) {
                s = wave_sum(s);
                if (lane < 16) {
                    ssq[(size_t)m * 16 + lane] = (lane == 0) ? s : 0.f;
                    const double ang = (double)pos[m] * P->inv_freq[lane];
                    const double k = rint(ang * 0.15915494309189535);
                    const float r = (float)(ang - k * 6.283185307179586);
                    f32x2 cs_; cs_[0] = cosf(r); cs_[1] = sinf(r);
                    CS[(size_t)m * 16 + lane] = cs_;
                }
            }
        }
#pragma unroll
        for (int u = 0; u < 4; ++u)
#pragma unroll
            for (int j = 0; j < 4; ++j) v[u][j] = nx[u][j];
    }
}

__device__ __forceinline__ void p2_pool_block(const bf16_t* UB, bf16_t* Y, int m0, int lane) {
    const int g = lane >> 4, w = 2 << g, t0 = m0 & (SEQ - 1);
    const bf16_t* base = UB + (size_t)m0 * 1792 + lane * 8;
    bf16_t* ob = Y + (size_t)m0 * 2048 + 512 + lane * 8;
    u32x4 prev[16];
#pragma unroll
    for (int j = 0; j < 16; ++j) { prev[j] = (u32x4){0u, 0u, 0u, 0u}; if (t0 > 0) prev[j] = *(const u32x4*)(base - (size_t)(16 - j) * 1792); }
    f32x4 s0 = {0.f, 0.f, 0.f, 0.f}, s1 = {0.f, 0.f, 0.f, 0.f};
#pragma unroll
    for (int j = 0; j < 16; ++j) { f32x4 a, b; unpack8(prev[j], a, b); const float mk = (16 - j <= w) ? 1.f : 0.f; s0 += a * mk; s1 += b * mk; }
    for (int bt = 0; bt < 4; ++bt) {
        u32x4 cur[16];
#pragma unroll
        for (int j = 0; j < 16; ++j) cur[j] = *(const u32x4*)(base + (size_t)(bt * 16 + j) * 1792);
#pragma unroll
        for (int j = 0; j < 16; ++j) {
            const u32x4 o2 = (j >= 2) ? cur[j >= 2 ? j - 2 : 0] : prev[14 + j < 16 ? 14 + j : 15];
            const u32x4 o4 = (j >= 4) ? cur[j >= 4 ? j - 4 : 0] : prev[12 + j < 16 ? 12 + j : 15];
            const u32x4 o8 = (j >= 8) ? cur[j >= 8 ? j - 8 : 0] : prev[8 + j < 16 ? 8 + j : 15];
            const u32x4 o16 = prev[j];
            u32x4 os;
            os.x = g == 0 ? o2.x : g == 1 ? o4.x : g == 2 ? o8.x : o16.x; os.y = g == 0 ? o2.y : g == 1 ? o4.y : g == 2 ? o8.y : o16.y;
            os.z = g == 0 ? o2.z : g == 1 ? o4.z : g == 2 ? o8.z : o16.z; os.w = g == 0 ? o2.w : g == 1 ? o4.w : g == 2 ? o8.w : o16.w;
            f32x4 c0, c1, q0, q1; unpack8(cur[j], c0, c1); unpack8(os, q0, q1);
            s0 += c0 - q0; s1 += c1 - q1;
            const int t = t0 + bt * 16 + j; const int cnt = (t + 1) < w ? (t + 1) : w; const float inv = __builtin_amdgcn_rcpf((float)cnt);
            *(u32x4*)(ob + (size_t)(bt * 16 + j) * 2048) = pack8(s0 * inv - c0, s1 * inv - c1);
        }
#pragma unroll
        for (int j = 0; j < 16; ++j) prev[j] = cur[j];
    }
}
__device__ __forceinline__ void p2_conv_block(const bf16_t* src, int m0, bool active, const float* wgt, int wp, const float* bias, bool silu, bf16_t* out, int opitch) {
    if (!active) return;
    const int t0 = m0 & (SEQ - 1);
    const bf16_t* base = src + (size_t)m0 * 1792; bf16_t* ob = out + (size_t)m0 * opitch;
    f32x4 w0[4], w1[4];
#pragma unroll
    for (int k = 0; k < 4; ++k) { w0[k] = *(const f32x4*)(wgt + k * wp); w1[k] = *(const f32x4*)(wgt + k * wp + 4); }
    const f32x4 b0 = *(const f32x4*)bias, b1 = *(const f32x4*)(bias + 4);
    u32x4 p3[3];
#pragma unroll
    for (int j = 0; j < 3; ++j) { p3[j] = (u32x4){0u, 0u, 0u, 0u}; if (t0 > 0) p3[j] = *(const u32x4*)(base - (size_t)(3 - j) * 1792); }
    for (int bt = 0; bt < 4; ++bt) {
        u32x4 cur[16];
#pragma unroll
        for (int j = 0; j < 16; ++j) cur[j] = *(const u32x4*)(base + (size_t)(bt * 16 + j) * 1792);
#pragma unroll
        for (int j = 0; j < 16; ++j) {
            f32x4 a0 = b0, a1 = b1;
#pragma unroll
            for (int k = 0; k < 4; ++k) { const int jj = j - 3 + k; const u32x4 rw = (jj >= 0) ? cur[jj >= 0 ? jj : 0] : p3[jj < 0 ? 3 + jj : 0];
                f32x4 x0, x1; unpack8(rw, x0, x1); a0 += x0 * w0[k]; a1 += x1 * w1[k]; }
            if (silu) {
#pragma unroll
                for (int e = 0; e < 4; ++e) { a0[e] = a0[e] * sigmoidf_(a0[e]); a1[e] = a1[e] * sigmoidf_(a1[e]); } }
            *(u32x4*)(ob + (size_t)(bt * 16 + j) * opitch) = pack8(a0, a1);
        }
        p3[0] = cur[13]; p3[1] = cur[14]; p3[2] = cur[15];
    }
}
__device__ __forceinline__ void p2_prep(PP P, int l, unsigned char* ws, int gw, int ngw, int tid_) {
    asm volatile("" : "+v"(tid_)); const int lane = tid_ & 63;
    const bf16_t* UA = (const bf16_t*)(ws + B_UA); const bf16_t* UB = (const bf16_t*)(ws + B_UB);
    bf16_t* Y = (bf16_t*)(ws + WS_Y); bf16_t* BC = (bf16_t*)(ws + B_BC); bf16_t* KR = (bf16_t*)(ws + B_KR);
    float* RSQ = (float*)(ws + WS_RSQ); float* RSKV = (float*)(ws + WS_RSKV); float* DTF = (float*)(ws + WS_DTF); const f32x2* CS = (const f32x2*)(ws + WS_CS);
    const float* scw = P->in[11] + l * 4 * 768; const float* scb = P->in[12] + l * 768; const float* dtb = P->in[13] + l * 8;
    const float* lcw = P->in[17] + l * 4 * 512; const float* lcb = P->in[18] + l * 512;
    for (int mb = gw; mb < M; mb += 4 * ngw) {
        u32x4 q4[4], k4[4]; float x1[4], x2[4], dtr[4]; f32x2 cc[4];
#pragma unroll
        for (int u = 0; u < 4; ++u) { const int m = M - 1 - (mb + u * ngw); const bf16_t* ua = UA + (size_t)m * 768;
            q4[u] = (u32x4){0u, 0u, 0u, 0u}; k4[u] = (u32x4){0u, 0u, 0u, 0u}; x1[u] = 0.f; x2[u] = 0.f; dtr[u] = 0.f; cc[u] = (f32x2){0.f, 0.f};
            if (lane < 48) q4[u] = *(const u32x4*)(ua + lane * 8);
            if (lane < 32) k4[u] = *(const u32x4*)(ua + 384 + lane * 8);
            if (lane < 16) { x1[u] = bf2f(ua[640 + lane]); x2[u] = bf2f(ua[656 + lane]); cc[u] = CS[(size_t)m * 16 + lane]; }
            if (lane < 8) dtr[u] = bf2f(ua[672 + lane]); }
#pragma unroll
        for (int u = 0; u < 4; ++u) { const int m = M - 1 - (mb + u * ngw);
            f32x4 a, b; unpack8(q4[u], a, b); float s = (a[0]*a[0]+a[1]*a[1])+(a[2]*a[2]+a[3]*a[3])+(b[0]*b[0]+b[1]*b[1])+(b[2]*b[2]+b[3]*b[3]);
            unpack8(k4[u], a, b); float s2 = (a[0]*a[0]+a[1]*a[1])+(a[2]*a[2]+a[3]*a[3])+(b[0]*b[0]+b[1]*b[1])+(b[2]*b[2]+b[3]*b[3]);
            s = wave_sum(s); s2 = wave_sum(s2);
            if (lane == 0) { RSQ[m] = rsqrtf(s * (1.f / 384.f) + EPS); RSKV[m] = rsqrtf(s2 * (1.f / 256.f) + EPS); }
            if (lane < 16) *(unsigned*)(KR + (size_t)m * 32 + 2 * lane) = cvt_pk_bf16(x1[u] * cc[u][0] - x2[u] * cc[u][1], x2[u] * cc[u][0] + x1[u] * cc[u][1]);
            if (lane < 8) { const float v = dtr[u] + dtb[lane]; DTF[(size_t)m * 8 + lane] = v > 20.f ? v : log1pf(__expf(v)); } }
    }
    for (int wt = gw; wt < 2048; wt += ngw) {
        const int rb = 511 - (wt >> 2), cgp = wt & 3, m0 = rb * 64;
        if (cgp == 0) p2_pool_block(UB, Y, m0, lane);
        else if (cgp == 1) p2_conv_block(UB + 512 + 8 * lane, m0, true, scw + 8 * lane, 768, scb + 8 * lane, true, Y + 1024 + 8 * lane, 2048);
        else if (cgp == 2) p2_conv_block(UB + 1024 + 8 * (lane & 31), m0, lane < 32, scw + 512 + 8 * (lane & 31), 768, scb + 512 + 8 * (lane & 31), true, BC + 8 * (lane & 31), 256);
        else p2_conv_block(UB + 1280 + 8 * lane, m0, true, lcw + 8 * lane, 512, lcb + 8 * lane, false, Y + 1536 + 8 * lane, 2048);
    }
}

__device__ __forceinline__ void rstd_c_rows(unsigned char* ws, int gw, int ngw, int tid_) {
    asm volatile("" : "+v"(tid_)); const int lane = tid_ & 63;
    const bf16_t* Y = (const bf16_t*)(ws + WS_Y); float* RSC = (float*)(ws + WS_RSC);
    for (int m = gw; m < M; m += ngw) { f32x4 a, b; unpack8(*(const u32x4*)(Y + (size_t)m * 2048 + 1024 + lane * 8), a, b);
        float s = (a[0]*a[0]+a[1]*a[1])+(a[2]*a[2]+a[3]*a[3])+(b[0]*b[0]+b[1]*b[1])+(b[2]*b[2]+b[3]*b[3]); s = wave_sum(s);
        if (lane == 0) RSC[m] = rsqrtf(s * (1.f / 512.f) + EPS); }
}
__device__ __forceinline__ void conv_p(PP P, int l, bf16_t* PB, int tid_, int bid_, int ngt) {
    asm volatile("" : "+v"(tid_)); const int gt = bid_ * 512 + tid_;
    const f32x4* src = (const f32x4*)(P->in[1] + (size_t)l * M * 256);
    for (long c = gt; c < (long)M * 256 / 8; c += 4L * ngt) {
        f32x4 a[4], b[4];
#pragma unroll
        for (int u = 0; u < 4; ++u) { const long cc = c + (long)u * ngt; a[u] = src[2 * cc]; b[u] = src[2 * cc + 1]; }
#pragma unroll
        for (int u = 0; u < 4; ++u) { const long cc = c + (long)u * ngt; *(u32x4*)(PB + cc * 8) = pack8(a[u], b[u]); }
    }
}
__device__ __forceinline__ void final_norm(PP P, const float* ssq, int gw, int ngw, int tid_) {
    asm volatile("" : "+v"(tid_)); const int lane = tid_ & 63;
    const f32x4* gf = (const f32x4*)P->in[32];
    f32x4 g4[4];
#pragma unroll
    for (int j = 0; j < 4; ++j) g4[j] = gf[64 * j + lane];
    for (int mb = gw; mb < M; mb += 4 * ngw) {
        f32x4 v[4][4]; float r[4];
#pragma unroll
        for (int u = 0; u < 4; ++u) { const int m = mb + u * ngw; r[u] = 0.f;
            if (m < M) { const f32x4* xr = (const f32x4*)(P->out + (size_t)m * D) + lane; r[u] = rstd16(ssq, m);
#pragma unroll
                for (int j = 0; j < 4; ++j) v[u][j] = xr[64 * j]; } }
#pragma unroll
        for (int u = 0; u < 4; ++u) { const int m = mb + u * ngw;
            if (m < M) { f32x4* xr = (f32x4*)(P->out + (size_t)m * D) + lane;
#pragma unroll
                for (int j = 0; j < 4; ++j) xr[64 * j] = v[u][j] * r[u] * g4[j]; } }
    }
}


typedef float f32x16 __attribute__((ext_vector_type(16)));
__device__ __forceinline__ unsigned pk2c(float lo, float hi) { f32x2 v = {lo, hi}; bf16x2_t b = __builtin_convertvector(v, bf16x2_t); return __builtin_bit_cast(unsigned, b); }
constexpr int AT_KP = 208, AT_VP = 192, AT_KB = 64 * AT_KP, AT_VB = 64 * AT_VP, AT_BUF = AT_KB + AT_VB;
typedef short v4i16_t __attribute__((ext_vector_type(4)));
__device__ __forceinline__ void attn_unit(unsigned char* ws, LAS unsigned char* lds, int b, int h, int qb, int wave, int tid_, bf16_t* Obase, int opitch) {
    asm volatile("" : "+v"(tid_));
    const int lane = tid_ & 63, r = lane & 31, hh = lane >> 5;
    bf16_t* Y = (bf16_t*)(ws + WS_Y); const bf16_t* QR = (const bf16_t*)(ws + B_QR); const bf16_t* KV = (const bf16_t*)(ws + B_KV); const bf16_t* KR = (const bf16_t*)(ws + B_KR);
    const int q0 = qb * 256, qw0 = q0 + wave * 32;
    const size_t mrow = (size_t)b * SEQ + qw0 + r;
    bf16x8 qf[6];
#pragma unroll
    for (int ks = 0; ks < 4; ++ks) qf[ks] = *(const bf16x8*)(Y + mrow * 2048 + h * 64 + 16 * ks + 8 * hh);
#pragma unroll
    for (int ks = 0; ks < 2; ++ks) qf[4 + ks] = *(const bf16x8*)(QR + mrow * 256 + h * 32 + 16 * ks + 8 * hh);
    f32x16 o0, o1;
#pragma unroll
    for (int i = 0; i < 16; ++i) { o0[i] = 0.f; o1[i] = 0.f; }
    float mx = -1e30f, lsum = 0.f;
    const int nkt = (q0 + 256) / 64;
    const int skv = tid_ >> 3, sc = tid_ & 7;
    const int rkv = tid_ >> 2, rc = tid_ & 3;
    const bf16_t* gk = KV + ((size_t)b * SEQ + skv) * 1024 + h * 64 + sc * 8;
    const bf16_t* gv = gk + 512;
    const bf16_t* gr = KR + ((size_t)b * SEQ + rkv) * 32 + rc * 8;
    u32x4 rk, rv, rr;
    rk = *(const u32x4*)gk; rv = *(const u32x4*)gv; if (tid_ < 256) rr = *(const u32x4*)gr;
    __syncthreads();
    {
        LAS unsigned char* kb = lds; LAS unsigned char* vb = lds + AT_KB;
        *(LAS u32x4*)(kb + skv * AT_KP + sc * 16) = rk;
        if (tid_ < 256) *(LAS u32x4*)(kb + rkv * AT_KP + 128 + rc * 16) = rr;
        *(LAS u32x4*)(vb + skv * AT_VP + sc * 16) = rv;
    }
    __syncthreads();
    for (int kt = 0; kt < nkt; ++kt) {
        const bool more = (kt + 1 < nkt);
        if (more) { const size_t adv = (size_t)(kt + 1) * 64;
            rk = *(const u32x4*)(gk + adv * 1024); rv = *(const u32x4*)(gv + adv * 1024); if (tid_ < 256) rr = *(const u32x4*)(gr + adv * 32); }
        LAS unsigned char* kb = lds + (kt & 1) * AT_BUF; LAS unsigned char* vb = kb + AT_KB;
        const int kv0 = kt * 64;
        if (kv0 <= qw0 + 31) {
            __builtin_amdgcn_iglp_opt(0);
            f32x16 p0, p1;
#pragma unroll
            for (int i = 0; i < 16; ++i) { p0[i] = 0.f; p1[i] = 0.f; }
            bf16x8 kf0[6], kf1[6];
#pragma unroll
            for (int ks = 0; ks < 6; ++ks) {
                kf0[ks] = *(const LAS bf16x8*)(kb + r * AT_KP + (16 * ks + 8 * hh) * 2);
                kf1[ks] = *(const LAS bf16x8*)(kb + (32 + r) * AT_KP + (16 * ks + 8 * hh) * 2);
            }
#pragma unroll
            for (int ks = 0; ks < 6; ++ks) {
                p0 = __builtin_amdgcn_mfma_f32_32x32x16_bf16(kf0[ks], qf[ks], p0, 0, 0, 0);
                p1 = __builtin_amdgcn_mfma_f32_32x32x16_bf16(kf1[ks], qf[ks], p1, 0, 0, 0);
            }
            if (kv0 + 63 > qw0) {
                const int qg = qw0 + r;
#pragma unroll
                for (int i = 0; i < 16; ++i) { const int kvl = kv0 + (i & 3) + 8 * (i >> 2) + 4 * hh; if (kvl > qg) p0[i] = -1e30f; if (kvl + 32 > qg) p1[i] = -1e30f; }
            }
            float tm = fmaxf(p0[0], p1[0]);
#pragma unroll
            for (int i = 1; i < 16; ++i) tm = fmaxf(tm, fmaxf(p0[i], p1[i]));
            tm = xhalf_max(tm);
            if (__any(tm > mx + 8.f)) {
                const float mn = fmaxf(mx, tm);
                const float alpha = __builtin_amdgcn_exp2f(mx - mn);
                mx = mn; lsum *= alpha;
#pragma unroll
                for (int i = 0; i < 16; ++i) { o0[i] *= alpha; o1[i] *= alpha; }
            }
            float ps = 0.f;
#pragma unroll
            for (int i = 0; i < 16; ++i) { p0[i] = __builtin_amdgcn_exp2f(p0[i] - mx); p1[i] = __builtin_amdgcn_exp2f(p1[i] - mx); ps += p0[i] + p1[i]; }
            lsum += ps;
            u32x4 vw0[4], vw1[4];
            {
                const int li = lane & 15, tq = li >> 2, tp = li & 3, dblk = (lane >> 4) & 1;
                const LAS unsigned char* vbase = vb + (4 * hh + tq) * AT_VP + (16 * dblk + 4 * tp) * 2;
#pragma unroll
                for (int f = 0; f < 4; ++f) {
                    const v4i16_t lo0 = __builtin_amdgcn_ds_read_tr16_b64_v4i16((LAS v4i16_t*)(vbase + (16 * f) * AT_VP));
                    const v4i16_t hi0 = __builtin_amdgcn_ds_read_tr16_b64_v4i16((LAS v4i16_t*)(vbase + (16 * f + 8) * AT_VP));
                    const v4i16_t lo1 = __builtin_amdgcn_ds_read_tr16_b64_v4i16((LAS v4i16_t*)(vbase + (16 * f) * AT_VP + 64));
                    const v4i16_t hi1 = __builtin_amdgcn_ds_read_tr16_b64_v4i16((LAS v4i16_t*)(vbase + (16 * f + 8) * AT_VP + 64));
                    const u32x2 a = __builtin_bit_cast(u32x2, lo0), b2 = __builtin_bit_cast(u32x2, hi0), c = __builtin_bit_cast(u32x2, lo1), d2 = __builtin_bit_cast(u32x2, hi1);
                    vw0[f].x = a.x; vw0[f].y = a.y; vw0[f].z = b2.x; vw0[f].w = b2.y; vw1[f].x = c.x; vw1[f].y = c.y; vw1[f].z = d2.x; vw1[f].w = d2.y;
                }
            }
            u32x4 pw[4];
#pragma unroll
            for (int s2 = 0; s2 < 2; ++s2) {
                pw[s2].x = pk2c(p0[8 * s2 + 0], p0[8 * s2 + 1]); pw[s2].y = pk2c(p0[8 * s2 + 2], p0[8 * s2 + 3]); pw[s2].z = pk2c(p0[8 * s2 + 4], p0[8 * s2 + 5]); pw[s2].w = pk2c(p0[8 * s2 + 6], p0[8 * s2 + 7]);
                pw[2 + s2].x = pk2c(p1[8 * s2 + 0], p1[8 * s2 + 1]); pw[2 + s2].y = pk2c(p1[8 * s2 + 2], p1[8 * s2 + 3]); pw[2 + s2].z = pk2c(p1[8 * s2 + 4], p1[8 * s2 + 5]); pw[2 + s2].w = pk2c(p1[8 * s2 + 6], p1[8 * s2 + 7]); }
#pragma unroll
            for (int f = 0; f < 4; ++f) {
                const bf16x8 pf = __builtin_bit_cast(bf16x8, pw[f]);
                o0 = __builtin_amdgcn_mfma_f32_32x32x16_bf16(__builtin_bit_cast(bf16x8, vw0[f]), pf, o0, 0, 0, 0);
                o1 = __builtin_amdgcn_mfma_f32_32x32x16_bf16(__builtin_bit_cast(bf16x8, vw1[f]), pf, o1, 0, 0, 0);
            }
        }
        if (more) {
            LAS unsigned char* kb2 = lds + ((kt + 1) & 1) * AT_BUF; LAS unsigned char* vb2 = kb2 + AT_KB;
            *(LAS u32x4*)(kb2 + skv * AT_KP + sc * 16) = rk;
            if (tid_ < 256) *(LAS u32x4*)(kb2 + rkv * AT_KP + 128 + rc * 16) = rr;
            *(LAS u32x4*)(vb2 + skv * AT_VP + sc * 16) = rv;
        }
        __syncthreads();
    }
    lsum = xhalf_sum(lsum);
    const float inv = 1.f / lsum;
    bf16_t* orow = Obase + mrow * opitch + h * 64;
#pragma unroll
    for (int g = 0; g < 4; ++g) {
        u32x2 w0, w1;
        w0.x = pk2c(o0[4 * g] * inv, o0[4 * g + 1] * inv); w0.y = pk2c(o0[4 * g + 2] * inv, o0[4 * g + 3] * inv);
        w1.x = pk2c(o1[4 * g] * inv, o1[4 * g + 1] * inv); w1.y = pk2c(o1[4 * g + 2] * inv, o1[4 * g + 3] * inv);
        *(u32x2*)(orow + 8 * g + 4 * hh) = w0;
        *(u32x2*)(orow + 32 + 8 * g + 4 * hh) = w1;
    }
}
__device__ __forceinline__ void attn_phase(unsigned char* ws, LAS unsigned char* lds, unsigned* ctr, int wave, int tid_, bf16_t* Obase, int opitch) {
    LAS unsigned* slot = (LAS unsigned*)(lds + 2 * AT_BUF + 64);
    for (;;) {
        if (tid_ == 0) *slot = atomicAdd(ctr, 1u);
        __syncthreads();
        const unsigned u = *slot;
        if (u >= 1024u) break;
        const int qb = 15 - (int)(u >> 6), bh = (int)(u & 63u);
        attn_unit(ws, lds, bh >> 3, bh & 7, qb, wave, tid_, Obase, opitch);
    }
}

constexpr int SD_CS = 0, SD_BS = 18432, SD_XT = 36864, SD_BDT = 62464, SD_MM = 79872, SD_F = 131072;
constexpr int SD_CP = 144, SD_XP = 400, SD_DP = 272, SD_MP = 400;
#define MFMA32(a, b, c) __builtin_amdgcn_mfma_f32_32x32x16_bf16((a), (b), (c), 0, 0, 0)
__device__ __forceinline__ void ssd_mfma(PP P, int l, unsigned char* ws, LAS unsigned char* lds, int unit, int wave, int tid_) {
    asm volatile("" : "+v"(tid_));
    const int lane = tid_ & 63, r = lane & 31, hh = lane >> 5;
    const int b = unit >> 3, h = unit & 7, g = h >> 2;
    bf16_t* Y = (bf16_t*)(ws + WS_Y); const bf16_t* BC = (const bf16_t*)(ws + B_BC); const bf16_t* U1 = (const bf16_t*)(ws + B_U1); const float* DTF = (const float*)(ws + WS_DTF);
    const float Ah = -__expf(P->in[14][l * 8 + h]); const float Dh = P->in[15][l * 8 + h];
    LAS float* F0 = (LAS float*)(lds + SD_F);
    for (int idx = tid_; idx < 64 * 32; idx += 512) { const int p = idx >> 5, c = idx & 31; *(LAS unsigned*)(lds + SD_XT + p * SD_XP + 256 + c * 4) = 0u; }
    f32x16 S;
#pragma unroll
    for (int i = 0; i < 16; ++i) S[i] = 0.f;
    const int l_ = tid_ >> 2, qd = tid_ & 3;
    const size_t mb0 = (size_t)b * SEQ;
    u32x4 c0, c1, b0, b1, x0, x1;
#define SSD_LOAD(ck_) do { const size_t m_ = mb0 + (size_t)(ck_) * 128 + l_; \
        c0 = *(const u32x4*)(BC + m_ * 256 + 128 + g * 64 + 16 * qd); c1 = *(const u32x4*)(BC + m_ * 256 + 128 + g * 64 + 16 * qd + 8); \
        b0 = *(const u32x4*)(BC + m_ * 256 + g * 64 + 16 * qd); b1 = *(const u32x4*)(BC + m_ * 256 + g * 64 + 16 * qd + 8); \
        x0 = *(const u32x4*)(Y + m_ * 2048 + 1024 + h * 64 + 16 * qd); x1 = *(const u32x4*)(Y + m_ * 2048 + 1024 + h * 64 + 16 * qd + 8); } while (0)
#define SSD_FCALC(ck_) do { LAS float* F_ = F0 + ((ck_) & 1) * 512; const size_t m_ = mb0 + (size_t)(ck_) * 128; \
        const float d0 = DTF[(m_ + lane) * 8 + h], d1 = DTF[(m_ + 64 + lane) * 8 + h]; float s0 = d0 * Ah, s1 = d1 * Ah; \
        _Pragma("unroll") for (int o = 1; o < 64; o <<= 1) { const float t0 = __shfl_up(s0, o), t1 = __shfl_up(s1, o); if (lane >= o) { s0 += t0; s1 += t1; } } \
        const float tot0 = __shfl(s0, 63); s1 += tot0; const float tot = __shfl(s1, 63); \
        F_[lane] = s0; F_[64 + lane] = s1; F_[128 + lane] = __expf(s0); F_[192 + lane] = __expf(s1); \
        F_[256 + lane] = __expf(tot - s0); F_[320 + lane] = __expf(tot - s1); F_[384 + lane] = d0; F_[448 + lane] = d1; } while (0)
#define SSD_STAGE(ck_) do { const LAS float* F_ = F0 + ((ck_) & 1) * 512; const float ea = F_[128 + l_], dec = F_[256 + l_], dt = F_[384 + l_]; \
        *(LAS u32x4*)(lds + SD_CS + l_ * SD_CP + qd * 32) = c0; *(LAS u32x4*)(lds + SD_CS + l_ * SD_CP + qd * 32 + 16) = c1; \
        *(LAS u32x4*)(lds + SD_BS + l_ * SD_CP + qd * 32) = b0; *(LAS u32x4*)(lds + SD_BS + l_ * SD_CP + qd * 32 + 16) = b1; \
        f32x4 ca, cb, cc, cd; unpack8(c0, ca, cb); unpack8(c1, cc, cd); \
        *(LAS u32x4*)(lds + SD_MM + l_ * SD_MP + 256 + qd * 32) = pack8(ca * ea, cb * ea); *(LAS u32x4*)(lds + SD_MM + l_ * SD_MP + 256 + qd * 32 + 16) = pack8(cc * ea, cd * ea); \
        f32x4 ba, bb, bc, bd; unpack8(b0, ba, bb); unpack8(b1, bc, bd); f32x4 xa, xb, xc, xd; unpack8(x0, xa, xb); unpack8(x1, xc, xd); \
        LAS unsigned short* bdt = (LAS unsigned short*)(lds + SD_BDT + (16 * qd) * SD_DP + l_ * 2); LAS unsigned short* xt = (LAS unsigned short*)(lds + SD_XT + (16 * qd) * SD_XP + l_ * 2); \
        _Pragma("unroll") for (int e = 0; e < 4; ++e) { \
            bdt[(e) * (SD_DP / 2)] = f2bf(ba[e] * dec); bdt[(4 + e) * (SD_DP / 2)] = f2bf(bb[e] * dec); bdt[(8 + e) * (SD_DP / 2)] = f2bf(bc[e] * dec); bdt[(12 + e) * (SD_DP / 2)] = f2bf(bd[e] * dec); \
            xt[(e) * (SD_XP / 2)] = f2bf(xa[e] * dt); xt[(4 + e) * (SD_XP / 2)] = f2bf(xb[e] * dt); xt[(8 + e) * (SD_XP / 2)] = f2bf(xc[e] * dt); xt[(12 + e) * (SD_XP / 2)] = f2bf(xd[e] * dt); } } while (0)
    SSD_LOAD(0);
    if (wave == 0) SSD_FCALC(0);
    __syncthreads();
    SSD_STAGE(0);
    SSD_LOAD(1);
    if (wave == 7) SSD_FCALC(1);
    __syncthreads();
    for (int ck = 0; ck < 32; ++ck) {
        const size_t m0 = mb0 + (size_t)ck * 128;
        const LAS float* F = F0 + (ck & 1) * 512;
        {
            const int lt = wave & 3;
#pragma unroll
            for (int sti = 0; sti < 2; ++sti) {
                const int st = 2 * (wave >> 2) + sti;
                if (st <= lt) {
                    f32x16 ga;
#pragma unroll
                    for (int i = 0; i < 16; ++i) ga[i] = 0.f;
#pragma unroll
                    for (int ks = 0; ks < 4; ++ks) {
                        const bf16x8 a = *(const LAS bf16x8*)(lds + SD_CS + (32 * lt + r) * SD_CP + 32 * ks + 16 * hh);
                        const bf16x8 bq = *(const LAS bf16x8*)(lds + SD_BS + (32 * st + r) * SD_CP + 32 * ks + 16 * hh);
                        ga = MFMA32(a, bq, ga);
                    }
                    const int sg = 32 * st + r; const float acs_s = F[sg];
#pragma unroll
                    for (int i = 0; i < 16; ++i) { const int lg = 32 * lt + (i & 3) + 8 * (i >> 2) + 4 * hh;
                        const float v = (sg <= lg) ? ga[i] * __expf(F[lg] - acs_s) : 0.f;
                        *(LAS unsigned short*)(lds + SD_MM + lg * SD_MP + sg * 2) = f2bf(v); }
                }
            }
        }
        __syncthreads();
        {
            const int lt = wave >> 1, pt = wave & 1;
            const size_t m = m0 + 32 * lt + r;
            bf16_t* yrow = Y + m * 2048 + 1024 + h * 64 + 32 * pt + 4 * hh; const bf16_t* zrow = U1 + m * 1024 + h * 64 + 32 * pt + 4 * hh;
            u32x2 xs4[4], z4[4]; float ssl = 0.f;
#pragma unroll
            for (int g4 = 0; g4 < 4; ++g4) { xs4[g4] = *(const u32x2*)(yrow + 8 * g4); z4[g4] = *(const u32x2*)(zrow + 8 * g4); }
            f32x16 ya;
#pragma unroll
            for (int i = 0; i < 16; ++i) ya[i] = 0.f;
            const LAS unsigned char* bp = lds + SD_MM + (32 * lt + r) * SD_MP + 16 * hh;
            const LAS unsigned char* ap = lds + SD_XT + (32 * pt + r) * SD_XP + 16 * hh;
            const int nks = 2 * (lt + 1);
            for (int ks = 0; ks < nks; ++ks) ya = MFMA32(*(const LAS bf16x8*)(ap + 32 * ks), *(const LAS bf16x8*)(bp + 32 * ks), ya);
#pragma unroll
            for (int ks = 8; ks < 12; ++ks) ya = MFMA32(*(const LAS bf16x8*)(ap + 32 * ks), *(const LAS bf16x8*)(bp + 32 * ks), ya);
#pragma unroll
            for (int g4 = 0; g4 < 4; ++g4) {
                const float xv[4] = {bflo(xs4[g4].x), bfhi(xs4[g4].x), bflo(xs4[g4].y), bfhi(xs4[g4].y)};
                const float zv[4] = {bflo(z4[g4].x), bfhi(z4[g4].x), bflo(z4[g4].y), bfhi(z4[g4].y)};
                float o[4];
#pragma unroll
                for (int e = 0; e < 4; ++e) o[e] = (ya[4 * g4 + e] + xv[e] * Dh) * (zv[e] * sigmoidf_(zv[e]));
                u32x2 w; w.x = cvt_pk_bf16(o[0], o[1]); w.y = cvt_pk_bf16(o[2], o[3]);
                *(u32x2*)(yrow + 8 * g4) = w;
                const float q0 = bflo(w.x), q1 = bfhi(w.x), q2 = bflo(w.y), q3 = bfhi(w.y);
                ssl += (q0 * q0 + q1 * q1) + (q2 * q2 + q3 * q3);
            }
            ssl = xhalf_sum(ssl);
            if (hh == 0) ((float*)(ws + WS_SSQC))[m * 16 + h * 2 + pt] = ssl;
        }
        const int spt = wave >> 1, snt = wave & 1;
        if (wave < 4) {
            const float et = F[255];
#pragma unroll
            for (int i = 0; i < 16; ++i) S[i] *= et;
#pragma unroll
            for (int ks = 0; ks < 8; ++ks) {
                const bf16x8 a = *(const LAS bf16x8*)(lds + SD_XT + (32 * spt + r) * SD_XP + 32 * ks + 16 * hh);
                const bf16x8 bq = *(const LAS bf16x8*)(lds + SD_BDT + (32 * snt + r) * SD_DP + 32 * ks + 16 * hh);
                S = MFMA32(a, bq, S);
            }
        }
        __syncthreads();
        if (wave < 4) {
#pragma unroll
            for (int i = 0; i < 16; ++i) { const int pgl = 32 * spt + (i & 3) + 8 * (i >> 2) + 4 * hh;
                *(LAS unsigned short*)(lds + SD_XT + pgl * SD_XP + (128 + 32 * snt + r) * 2) = f2bf(S[i]); }
        }
        if (ck + 1 < 32) {
            SSD_STAGE(ck + 1);
            if (ck + 2 < 32) { SSD_LOAD(ck + 2); if (wave == 7) SSD_FCALC(ck + 2); }
        }
        __syncthreads();
    }
#undef SSD_LOAD
#undef SSD_FCALC
#undef SSD_STAGE
}

__device__ __forceinline__ void attn_naive(unsigned char* ws, int gw, int tid_) {
    asm volatile("" : "+v"(tid_)); const int lane = tid_ & 63;
    const bf16_t* Y = (const bf16_t*)(ws + WS_Y); const bf16_t* QR = (const bf16_t*)(ws + B_QR); const bf16_t* KV = (const bf16_t*)(ws + B_KV); const bf16_t* KR = (const bf16_t*)(ws + B_KR);
    bf16_t* YO = (bf16_t*)(ws + WS_Y);
    const int bh = gw >> 5, j = gw & 31, b = bh >> 3, h = bh & 7;
    for (int pass = 0; pass < 2; ++pass) {
        const int qb = pass ? 63 - j : j;
        const int t = qb * 64 + lane; const size_t m = (size_t)b * SEQ + t;
        unsigned q[48];
#pragma unroll
        for (int i = 0; i < 8; ++i) { const u32x4 w = *(const u32x4*)(Y + m * 2048 + h * 64 + i * 8); q[4 * i] = w.x; q[4 * i + 1] = w.y; q[4 * i + 2] = w.z; q[4 * i + 3] = w.w; }
#pragma unroll
        for (int i = 0; i < 4; ++i) { const u32x4 w = *(const u32x4*)(QR + m * 256 + h * 32 + i * 8); q[32 + 4 * i] = w.x; q[33 + 4 * i] = w.y; q[34 + 4 * i] = w.z; q[35 + 4 * i] = w.w; }
        float acc[64];
#pragma unroll
        for (int d = 0; d < 64; ++d) acc[d] = 0.f;
        float mx = -1e30f, lsum = 0.f;
        const int kend = qb * 64 + 64;
        for (int kv = 0; kv < kend; ++kv) {
            const size_t mk = (size_t)b * SEQ + kv;
            const u32x4* kn = (const u32x4*)(KV + mk * 1024 + h * 64); const u32x4* kr = (const u32x4*)(KR + mk * 32); const u32x4* vv = (const u32x4*)(KV + mk * 1024 + 512 + h * 64);
            float s0 = 0.f, s1 = 0.f;
#pragma unroll
            for (int i = 0; i < 8; ++i) { const u32x4 w = kn[i];
                s0 = dot2x(q[4 * i], w.x, s0);
                s1 = dot2x(q[4 * i + 1], w.y, s1);
                s0 = dot2x(q[4 * i + 2], w.z, s0);
                s1 = dot2x(q[4 * i + 3], w.w, s1); }
#pragma unroll
            for (int i = 0; i < 4; ++i) { const u32x4 w = kr[i];
                s0 = dot2x(q[32 + 4 * i], w.x, s0);
                s1 = dot2x(q[33 + 4 * i], w.y, s1);
                s0 = dot2x(q[34 + 4 * i], w.z, s0);
                s1 = dot2x(q[35 + 4 * i], w.w, s1); }
            float s = s0 + s1;
            if (kv > t) s = -1e30f;
            const float mn = fmaxf(mx, s);
            const float alpha = exp2f(mx - mn), p = (kv > t) ? 0.f : exp2f(s - mn);
            mx = mn; lsum = lsum * alpha + p;
#pragma unroll
            for (int i = 0; i < 8; ++i) { const u32x4 w = vv[i];
                acc[8 * i + 0] = acc[8 * i + 0] * alpha + p * bflo(w.x); acc[8 * i + 1] = acc[8 * i + 1] * alpha + p * bfhi(w.x);
                acc[8 * i + 2] = acc[8 * i + 2] * alpha + p * bflo(w.y); acc[8 * i + 3] = acc[8 * i + 3] * alpha + p * bfhi(w.y);
                acc[8 * i + 4] = acc[8 * i + 4] * alpha + p * bflo(w.z); acc[8 * i + 5] = acc[8 * i + 5] * alpha + p * bfhi(w.z);
                acc[8 * i + 6] = acc[8 * i + 6] * alpha + p * bflo(w.w); acc[8 * i + 7] = acc[8 * i + 7] * alpha + p * bfhi(w.w); }
        }
        const float inv = 1.f / lsum;
#pragma unroll
        for (int i = 0; i < 8; ++i) { u32x4 w; w.x = cvt_pk_bf16(acc[8 * i] * inv, acc[8 * i + 1] * inv); w.y = cvt_pk_bf16(acc[8 * i + 2] * inv, acc[8 * i + 3] * inv);
            w.z = cvt_pk_bf16(acc[8 * i + 4] * inv, acc[8 * i + 5] * inv); w.w = cvt_pk_bf16(acc[8 * i + 6] * inv, acc[8 * i + 7] * inv);
            *(u32x4*)(YO + m * 2048 + h * 64 + i * 8) = w; }
    }
}

__device__ __forceinline__ void ssd_naive(PP P, int l, unsigned char* ws, int unit, int wave, int tid_) {
    asm volatile("" : "+v"(tid_)); const int lane = tid_ & 63;
    const int b = unit >> 3, h = unit & 7, g = h >> 2;
    bf16_t* Y = (bf16_t*)(ws + WS_Y); const bf16_t* BC = (const bf16_t*)(ws + B_BC); const bf16_t* U1 = (const bf16_t*)(ws + B_U1); const float* DTF = (const float*)(ws + WS_DTF);
    const float Ah = -__expf(P->in[14][l * 8 + h]); const float Dh = P->in[15][l * 8 + h];
    const int p = wave * 8 + (lane >> 3), no = lane & 7;
    float S[8];
#pragma unroll
    for (int i = 0; i < 8; ++i) S[i] = 0.f;
    for (int t = 0; t < SEQ; ++t) {
        const size_t m = (size_t)b * SEQ + t;
        const float dt = DTF[m * 8 + h]; const float a = __expf(dt * Ah);
        bf16_t* xp = Y + m * 2048 + 1024 + h * 64 + p;
        const float xv = bf2f(*xp); const float xdt = xv * dt;
        f32x4 b0, b1, c0, c1; unpack8(*(const u32x4*)(BC + m * 256 + g * 64 + no * 8), b0, b1); unpack8(*(const u32x4*)(BC + m * 256 + 128 + g * 64 + no * 8), c0, c1);
        float y = 0.f;
#pragma unroll
        for (int i = 0; i < 4; ++i) { S[i] = a * S[i] + xdt * b0[i]; y += S[i] * c0[i]; S[4 + i] = a * S[4 + i] + xdt * b1[i]; y += S[4 + i] * c1[i]; }
        y += __shfl_xor(y, 1); y += __shfl_xor(y, 2); y += __shfl_xor(y, 4);
        const float z = bf2f(U1[m * 1024 + h * 64 + p]);
        y = (y + xv * Dh) * (z * sigmoidf_(z));
        if (no == 0) *xp = f2bf(y);
    }
}

__device__ __forceinline__ float gelu_tanh(float x) { const float u = 0.7978845608028654f * (x + 0.044715f * x * x * x); return x * sigmoidf_(2.f * u); }
__device__ __forceinline__ void lru_scan(unsigned char* ws, int unit, int wave, int tid_, LAS float* sm) {
    asm volatile("" : "+v"(tid_)); const int lane = tid_ & 63;
    const int b = unit >> 3, ch = (unit & 7) * 64 + lane;
    bf16_t* Y = (bf16_t*)(ws + WS_Y); const bf16_t* LA = (const bf16_t*)(ws + B_LA); const bf16_t* U1 = (const bf16_t*)(ws + B_U1);
    const int t0 = wave * 512;
    const size_t m0 = (size_t)b * SEQ + t0;
    const bf16_t* lap = LA + m0 * 512 + ch; bf16_t* up = Y + m0 * 2048 + 1536 + ch; const bf16_t* gp = U1 + m0 * 1024 + 512 + ch;
    float A = 1.f, H = 0.f;
    for (int t = 0; t < 512; t += 16) {
        bf16_t la[16], uu[16];
#pragma unroll
        for (int k = 0; k < 16; ++k) { la[k] = lap[(size_t)(t + k) * 512]; uu[k] = up[(size_t)(t + k) * 2048]; }
#pragma unroll
        for (int k = 0; k < 16; ++k) { const float a = __expf(bf2f(la[k])); H = a * H + bf2f(uu[k]); A *= a; }
    }
    sm[wave * 64 + lane] = A; sm[512 + wave * 64 + lane] = H;
    __syncthreads();
    float hcar = 0.f;
    for (int w = 0; w < wave; ++w) hcar = sm[w * 64 + lane] * hcar + sm[512 + w * 64 + lane];
    for (int t = 0; t < 512; t += 16) {
        bf16_t la[16], uu[16], gg[16];
#pragma unroll
        for (int k = 0; k < 16; ++k) { la[k] = lap[(size_t)(t + k) * 512]; uu[k] = up[(size_t)(t + k) * 2048]; gg[k] = gp[(size_t)(t + k) * 1024]; }
#pragma unroll
        for (int k = 0; k < 16; ++k) { const float a = __expf(bf2f(la[k])); hcar = a * hcar + bf2f(uu[k]); up[(size_t)(t + k) * 2048] = f2bf(bf2f(f2bf(hcar)) * gelu_tanh(bf2f(gg[k]))); }
    }
    __syncthreads();
}


#define RLX_AGENT __ATOMIC_RELAXED, __HIP_MEMORY_SCOPE_AGENT
#define XB_TMO      128
#define XB_XCNT(j)  (256  + 64 * (j))
#define XB_XSUB(j)  (1280 + 64 * (j))
#define XB_XGEN(j)  (2304 + 64 * (j))
#define XB_TOP      3328
#define XB_TOPGEN   3392
#define XCD_BAR_WORDS 3456
#define XB_SPIN_CAP (1u << 18)

__device__ __forceinline__ unsigned xb_ld(unsigned* p)              { return __hip_atomic_load(p, __ATOMIC_RELAXED, __HIP_MEMORY_SCOPE_AGENT); }
__device__ __forceinline__ unsigned xb_add(unsigned* p, unsigned v) { return __hip_atomic_fetch_add(p, v, __ATOMIC_RELAXED, __HIP_MEMORY_SCOPE_AGENT); }
__device__ __forceinline__ unsigned xb_xcc_id() { return (unsigned)__builtin_amdgcn_s_getreg((3 << 11) | 20) & 0xFu; }
#define XB_SPIN(cond, bar) do { unsigned _sp = 0; while (cond) { __builtin_amdgcn_s_sleep(1); \
    if ((++_sp & 255u) == 0u) { if (xb_ld(&(bar)[XB_TMO])) break; if (_sp > XB_SPIN_CAP) { atomicAdd(&(bar)[XB_TMO], 1u); break; } } } } while (0)

struct XcdBarrier {
    unsigned* bar; unsigned x;
    volatile LAS unsigned* st;
};

__device__ __forceinline__ XcdBarrier xcd_barrier_post(unsigned* bar, volatile LAS unsigned* st) {
    XcdBarrier b; b.bar = bar; b.x = xb_xcc_id(); b.st = st;
    if (threadIdx.x == 0) (void)xb_add(&bar[XB_XCNT(b.x)], 1u);
    return b;
}
__device__ __forceinline__ void xcd_barrier_complete(unsigned* bar, unsigned x, unsigned& nloc, unsigned& nx) {
    const unsigned G = gridDim.x * gridDim.y * gridDim.z;
    unsigned sum, cnt, mine, sp = 0u;
    for (;;) {
        sum = 0u; cnt = 0u; mine = 0u;
#pragma unroll
        for (unsigned j = 0; j < 16; ++j) { const unsigned c = xb_ld(&bar[XB_XCNT(j)]); sum += c; cnt += (c > 0u) ? 1u : 0u; mine = (j == x) ? c : mine; }
        if (sum == G) break;
        __builtin_amdgcn_s_sleep(1);
        if ((++sp & 255u) == 0u) { if (xb_ld(&bar[XB_TMO])) break; if (sp > XB_SPIN_CAP) { atomicAdd(&bar[XB_TMO], 1u); break; } }
    }
    nloc = mine > 0u ? mine : 1u; nx = cnt > 0u ? cnt : 1u;
}

__device__ __forceinline__ void xcd_barrier(const XcdBarrier& b) {
    asm volatile("s_waitcnt vmcnt(0)" ::: "memory");
    __syncthreads();
    if (threadIdx.x == 0) {
        unsigned* bar = b.bar;
        __builtin_amdgcn_s_waitcnt(0);
        unsigned nloc = b.st[0], nx = b.st[1];
        if (nloc == 0u) { xcd_barrier_complete(bar, b.x, nloc, nx); b.st[0] = nloc; b.st[1] = nx; }
        const unsigned old = xb_add(&bar[XB_XSUB(b.x)], 1u);
        const unsigned gen = old / nloc;
        if (old + 1u == (gen + 1u) * nloc) {
            __builtin_amdgcn_fence(__ATOMIC_RELEASE, "agent");
            asm volatile("s_waitcnt vmcnt(0)" ::: "memory");
            const unsigned og = xb_add(&bar[XB_TOP], 1u);
            const unsigned tg = og / nx;
            if (og + 1u == (tg + 1u) * nx) xb_add(&bar[XB_TOPGEN], 1u);
            else XB_SPIN(xb_ld(&bar[XB_TOPGEN]) == tg, bar);
            __builtin_amdgcn_fence(__ATOMIC_ACQUIRE, "agent");
            xb_add(&bar[XB_XGEN(b.x)], 1u);
            asm volatile("s_waitcnt vmcnt(0)" ::: "memory");
        } else {
            XB_SPIN(xb_ld(&bar[XB_XGEN(b.x)]) == gen, bar);
            __builtin_amdgcn_fence(__ATOMIC_ACQUIRE, "agent");
            asm volatile("s_waitcnt vmcnt(0)" ::: "memory");
        }
    }
    __syncthreads();
}


constexpr int LDS_BYTES = 147456;
#ifndef GMASK
#define GMASK 0xffffffffu
#endif
__global__ void __launch_bounds__(512, 2) mk_fwd(Params Pk) {
    extern __shared__ __attribute__((aligned(16))) unsigned char lds_raw[];
    LAS unsigned char* lds = (LAS unsigned char*)lds_raw;
    cg::grid_group grid = cg::this_grid();
    const int tid = threadIdx.x, wave = __builtin_amdgcn_readfirstlane(tid >> 6);
    const int G = gridDim.x, bid = blockIdx.x;
    const int gw = bid * 8 + wave, NGW = G * 8, NGT = G * 512;
    PP P = (PP)__builtin_amdgcn_kernarg_segment_ptr();
    unsigned char* ws = (unsigned char*)(__attribute__((address_space(1))) unsigned char*)P->ws;
    { volatile LAS unsigned* st0 = (volatile LAS unsigned*)(lds + 146000); if (tid == 0) { st0[0] = 0u; st0[1] = 0u; } __syncthreads(); }
    XcdBarrier xbar = xcd_barrier_post((unsigned*)P->ws + 4096, (volatile LAS unsigned*)(lds + 146000));
    if (G > 100000) grid.sync();
#define FRESH() do { asm volatile("" : "+s"(P)); { __attribute__((address_space(1))) unsigned char* g_ = (__attribute__((address_space(1))) unsigned char*)P->ws; asm volatile("" : "+s"(g_), "+s"(l)); ws = (unsigned char*)g_; } W = (bf16_t*)(ws + WS_W); XB = (bf16_t*)(ws + WS_XB); Y = (bf16_t*)(ws + WS_Y); } while (0)
#define GSYNC() do { xcd_barrier(xbar); } while (0)
    bf16_t* W = (bf16_t*)(ws + WS_W); bf16_t* XB = (bf16_t*)(ws + WS_XB); bf16_t* Y = (bf16_t*)(ws + WS_Y);
    #define SSQA ((float*)(ws + WS_SSQA))
#define SSQB ((float*)(ws + WS_SSQB))
#define SSQC_ (cur ? SSQB : SSQA)
#define SSQN_ (cur ? SSQA : SSQB)
    int cur = 0;
    using namespace pg8;

    for (int l = 0; l < DEPTH; ++l) {
        FRESH();
        conv_weights(P, l, W, tid, bid, NGT, lds);
        p0_rows(P, l == 0 ? P->in[0] : (const float*)P->out, l == 0, XB, SSQA, (f32x2*)(ws + WS_CS), gw, NGW, tid);
        GSYNC(); FRESH();
        { Gemm g{XB, W + W_IN, M, 3584, 1024, 1024, 0, 0}; StaticOrder S; S.init(M, 3584, G, bid);
          EpiInproj E{(bf16_t*)(ws + B_U1), (bf16_t*)(ws + B_UA), (bf16_t*)(ws + B_UB), lds};
          rstd_prepass(lds, SSQC_, S, tid); if (GMASK & (1u << 0)) gemm_phase(lds, g, S, E); }
        GSYNC(); FRESH();
        p2_prep(P, l, ws, gw, NGW, tid);
        GSYNC(); FRESH();
        { Gemm g{(const bf16_t*)(ws + B_UA), W + W_UQ, M, 768, 384, 768, 0, 0}; StaticOrder S; S.init(M, 768, G, bid);
          EpiQ E{Y, (bf16_t*)(ws + B_QR), (const float*)(ws + WS_RSQ), (const f32x2*)(ws + WS_CS)}; if (GMASK & (1u << 1)) gemm_phase(lds, g, S, E); }
        { Gemm g{(const bf16_t*)(ws + B_UA) + 384, W + W_UKV, M, 1024, 256, 768, 0, 0}; StaticOrder S; S.init(M, 1024, G, (bid + 128) % G);
          EpiRowScale E{(bf16_t*)(ws + B_KV), 1024, (const float*)(ws + WS_RSKV), 0}; if (GMASK & (1u << 2)) gemm_phase(lds, g, S, E); }
        if (G == 256 ? bid >= 128 : true) { Gemm g{Y + 512, W + W_POOL, M, 512, 256, 2048, 256, 0}; StaticOrder S; if (G == 256) S.init(M, 512, 128, bid - 128); else S.init(M, 512, G, bid);
          EpiRowScale E{Y + 512, 2048, nullptr, 0}; if (GMASK & (1u << 3)) gemm_phase(lds, g, S, E); }
        { Gemm g{Y + 1536, W + W_LRU, M, 1024, 128, 2048, 128, 0}; StaticOrder S; S.init(M, 1024, G, bid);
          EpiLru E{Y + 1536, (bf16_t*)(ws + B_LA), P->in[20] + l * 512, P->in[22] + l * 512, P->in[23] + l * 512}; if (GMASK & (1u << 4)) gemm_phase(lds, g, S, E); }
        GSYNC(); FRESH();
#ifdef NAIVE_SSD
        if (bid < 64) ssd_naive(P, l, ws, bid, wave, tid);
#else
        if (bid < 64) ssd_mfma(P, l, ws, lds, bid, wave, tid);
#endif
#ifndef NO_LRU
        if (bid >= 64 && bid < 128) lru_scan(ws, bid - 64, wave, tid, (LAS float*)lds);
#endif
#ifdef NAIVE_ATTN
        if (gw < 2048) attn_naive(ws, gw, tid);
#else
#ifdef PROBE_ATTN
        attn_phase(ws, lds, (unsigned*)ws + 64 + 16 * l + 8, wave, tid, (bf16_t*)(ws + B_UA), 512);
#endif
        attn_phase(ws, lds, (unsigned*)ws + 64 + 16 * l, wave, tid, (bf16_t*)(ws + WS_Y), 2048);
#endif
        GSYNC(); FRESH();
#define TBUF(n) ((bf16_t*)(ws + WS_BIG + (size_t)(n) * 64 * MiB))
#define MB ((bf16_t*)(ws + WS_BIG + 64 * MiB))
        { MergeOrder S; S.base.init(M, 1024, G, bid); EpiMerge E{lds, TBUF(0), MB};
          merge_prepass(lds, SSQC_, (const float*)(ws + WS_SSQC), S, tid);
          if (GMASK & (1u << 5)) gemm_merge_fused(lds, Y, XB, W + W_BR, W + W_G, S, E); }
        GSYNC(); FRESH();
        { Gemm g{MB, W + W_OUT, M, 1024, 1024, 1024, 0, 0}; StaticOrder S; S.init(M, 1024, G, bid);
          EpiRes<0> E{l == 0 ? P->in[0] : P->out, P->out, XB, SSQN_, (const LAS unsigned char*)nullptr, nullptr}; if (GMASK & (1u << 8)) gemm_phase(lds, g, S, E); cur ^= 1; }
        GSYNC(); FRESH();
        conv_p(P, l, (bf16_t*)(ws + Y_PB), tid, bid, NGT);
        { Gemm g{XB, W + W_FF1, M, 4096, 1024, 1024, 0, 0}; StaticOrder S; S.init(M, 4096, G, bid);
          EpiFF1 E{(bf16_t*)(ws + B_H), lds}; rstd_prepass(lds, SSQC_, S, tid); if (GMASK & (1u << 9)) gemm_phase(lds, g, S, E); }
        GSYNC(); FRESH();
        { Gemm g{(const bf16_t*)(ws + B_H), W + W_FF2, M, 1024, 4096, 4096, 0, 0}; StaticOrder S; S.init(M, 1024, G, bid); S.rev = 1;
          EpiRes<0> E{P->out, P->out, XB, SSQN_, (const LAS unsigned char*)nullptr, nullptr}; if (GMASK & (1u << 10)) gemm_phase(lds, g, S, E); cur ^= 1; }
        { Gemm g{(const bf16_t*)(ws + Y_PB), W + W_PLE, M, 1024, 256, 256, 0, 0}; StaticOrder S; S.init(M, 1024, G, bid);
          EpiRowScale E{(bf16_t*)(ws + Y_TP), 1024, nullptr, 0}; if (GMASK & (1u << 11)) gemm_phase(lds, g, S, E); }
        GSYNC(); FRESH();
        { Gemm g{XB, W + W_PG, M, 1024, 1024, 1024, 0, 0}; StaticOrder S; S.init(M, 1024, G, bid);
          EpiRes<1> E{P->out, P->out, XB, SSQN_, lds, (const bf16_t*)(ws + Y_TP)}; rstd_prepass(lds, SSQC_, S, tid); if (GMASK & (1u << 12)) gemm_phase(lds, g, S, E); cur ^= 1; }
        GSYNC(); FRESH();
    }
    final_norm(P, SSQC_, gw, NGW, tid);
}

extern "C" void kernel_launch(void* const* d_in, const int* in_sizes, int n_in, void* d_out, int out_size, void* d_ws, size_t ws_size, hipStream_t stream) {
    static int grid = 0;
    if (grid == 0) {
        if (n_in != 33 || out_size != M * D || ws_size < WS_END) { fprintf(stderr, "kernel_launch: unexpected shapes (n_in %d out %d ws %zu)\n", n_in, out_size, ws_size); grid = -1; return; }
        int dev = 0, cus = 0, per_cu = 0;
        hipGetDevice(&dev); hipDeviceGetAttribute(&cus, hipDeviceAttributeMultiprocessorCount, dev);
        hipFuncSetAttribute((const void*)mk_fwd, hipFuncAttributeMaxDynamicSharedMemorySize, LDS_BYTES);
        hipOccupancyMaxActiveBlocksPerMultiprocessor(&per_cu, (const void*)mk_fwd, 512, LDS_BYTES);
        if (per_cu < 1) per_cu = 1;
        grid = cus >= 256 ? 256 : cus;
        (void)hipGetLastError();
    }
    if (grid < 0) return;
    if (hipMemsetAsync(d_ws, 0, 65536, stream) != hipSuccess) { fprintf(stderr, "memset failed\n"); return; }
    Params p{};
    for (int i = 0; i < 33; ++i) p.in[i] = (const float*)d_in[i];
    p.out = (float*)d_out; p.ws = (unsigned char*)d_ws;
    for (int i = 0; i < 16; ++i) p.inv_freq[i] = 1.0 / pow(10000.0, (double)i / 16.0);
    void* args[] = {&p};
    hipError_t e = hipLaunchCooperativeKernel((const void*)mk_fwd, dim3(grid), dim3(512), args, LDS_BYTES, stream);
    if (e != hipSuccess) fprintf(stderr, "cooperative launch failed: %s (grid %d)\n", hipGetErrorString(e), grid);
}
```

```cpp
#include <hip/hip_runtime.h>
#include <hip/hip_cooperative_groups.h>
#include <cstdio>
#include <cstdint>
#include <cmath>
namespace cg = cooperative_groups;

#define LAS __attribute__((address_space(3)))
typedef unsigned short bf16_t;
typedef short bf16x8 __attribute__((ext_vector_type(8)));
typedef float f32x4 __attribute__((ext_vector_type(4)));
typedef float f32x2 __attribute__((ext_vector_type(2)));
typedef unsigned u32x4 __attribute__((ext_vector_type(4)));
typedef unsigned u32x2 __attribute__((ext_vector_type(2)));
typedef __bf16 bf16x2_t __attribute__((ext_vector_type(2)));

constexpr int M = 32768, SEQ = 4096, NB = 8, D = 1024, DEPTH = 2;
constexpr int INC = 7592;
constexpr float EPS = 1e-6f;
constexpr float QSCALE = 0.10206207261596577f * 1.4426950408889634f;

constexpr size_t MiB = 1u << 20;
constexpr size_t WS_SSQA = 2 * MiB, WS_SSQB = 4 * MiB, WS_RSQ = 6 * MiB, WS_RSKV = WS_RSQ + 128 * 1024, WS_RSC = WS_RSKV + 128 * 1024;
constexpr size_t WS_DTF = 7 * MiB, WS_CS = 8 * MiB, WS_SSQC = 12 * MiB;
constexpr size_t WS_W = 16 * MiB, WS_XB = 60 * MiB, WS_Y = 124 * MiB, WS_BIG = 252 * MiB, WS_END = 512 * MiB;
constexpr size_t B_U1 = WS_BIG, B_UA = WS_BIG + 64 * MiB, B_UB = WS_BIG + 112 * MiB, B_BC = WS_BIG + 224 * MiB, B_KR = WS_BIG + 240 * MiB;
constexpr size_t B_QR = WS_BIG + 112 * MiB, B_KV = WS_BIG + 128 * MiB, B_LA = WS_BIG + 192 * MiB;
constexpr size_t B_T0 = WS_BIG, B_T1 = WS_BIG + 64 * MiB, B_MB = WS_BIG + 128 * MiB;
constexpr size_t B_H = WS_BIG;
constexpr size_t Y_TP = WS_Y, Y_PB = WS_Y + 64 * MiB;
constexpr size_t W_IN = 0, W_G = W_IN + 3584ull * 1024, W_UQ = W_G + 4096ull * 1024, W_UKV = W_UQ + 768ull * 384, W_POOL = W_UKV + 1024ull * 256,
                 W_LRU = W_POOL + 512ull * 256, W_BR = W_LRU + 1024ull * 128, W_OUT = W_BR + 4096ull * 512, W_FF1 = W_OUT + 1024ull * 1024,
                 W_FF2 = W_FF1 + 4096ull * 1024, W_PG = W_FF2 + 4096ull * 1024, W_PLE = W_PG + 1024ull * 1024, W_TOTAL = W_PLE + 1024ull * 256;
static_assert(W_TOTAL * 2 <= 44 * MiB, "weights fit");

struct Params {
    const float* in[33];
    float* out;
    unsigned char* ws;
    double inv_freq[16];
};

typedef const __attribute__((address_space(4))) Params* PP;
#if defined(__HIP_DEVICE_COMPILE__)
#define ASSUME_GLOBAL(p) do { __builtin_assume(!__builtin_amdgcn_is_shared((const __attribute__((address_space(0))) void*)(p))); __builtin_assume(!__builtin_amdgcn_is_private((const __attribute__((address_space(0))) void*)(p))); } while (0)
#else
#define ASSUME_GLOBAL(p) do { } while (0)
#endif
__device__ __forceinline__ unsigned cvt_pk_bf16(float lo, float hi) { unsigned r; asm("v_cvt_pk_bf16_f32 %0, %1, %2" : "=v"(r) : "v"(lo), "v"(hi)); return r; }
__device__ __forceinline__ float bflo(unsigned w) { return __uint_as_float(w << 16); }
__device__ __forceinline__ float bfhi(unsigned w) { return __uint_as_float(w & 0xffff0000u); }
__device__ __forceinline__ float bf2f(bf16_t h) { return __uint_as_float(((unsigned)h) << 16); }
__device__ __forceinline__ bf16_t f2bf(float f) { return (bf16_t)(cvt_pk_bf16(f, 0.f) & 0xffffu); }
__device__ __forceinline__ u32x4 pack8(f32x4 a, f32x4 b) { u32x4 w; w.x = cvt_pk_bf16(a[0], a[1]); w.y = cvt_pk_bf16(a[2], a[3]); w.z = cvt_pk_bf16(b[0], b[1]); w.w = cvt_pk_bf16(b[2], b[3]); return w; }
__device__ __forceinline__ void unpack8(u32x4 w, f32x4& a, f32x4& b) { a = (f32x4){bflo(w.x), bfhi(w.x), bflo(w.y), bfhi(w.y)}; b = (f32x4){bflo(w.z), bfhi(w.z), bflo(w.w), bfhi(w.w)}; }
__device__ __forceinline__ float dot2x(unsigned a, unsigned b, float c) { return c + bflo(a) * bflo(b) + bfhi(a) * bfhi(b); }
__device__ __forceinline__ float sigmoidf_(float x) { return __builtin_amdgcn_rcpf(1.f + __builtin_amdgcn_exp2f(-1.4426950408889634f * x)); }
__device__ __forceinline__ float one_minus_exp(float x) {
    const float p = -x * (1.f + x * (0.5f + x * (0.16666667f + x * (0.041666668f + x * (0.008333334f + x * (0.0013888889f + x * 0.0001984127f))))));
    return x < -0.25f ? 1.f - __expf(x) : p;
}
__device__ __forceinline__ float xhalf_sum(float v) { const auto r_ = __builtin_amdgcn_permlane32_swap(__float_as_uint(v), __float_as_uint(v), false, false); return __uint_as_float(r_[0]) + __uint_as_float(r_[1]); }
__device__ __forceinline__ float xhalf_max(float v) { const auto r_ = __builtin_amdgcn_permlane32_swap(__float_as_uint(v), __float_as_uint(v), false, false); return fmaxf(__uint_as_float(r_[0]), __uint_as_float(r_[1])); }
__device__ __forceinline__ float wave_sum(float v) {
#pragma unroll
    for (int o = 1; o < 64; o <<= 1) v += __shfl_xor(v, o);
    return v;
}
__device__ __forceinline__ float rstd16(const float* ssq, int row) {
    const f32x4* p = (const f32x4*)(ssq + (size_t)row * 16);
    f32x4 a = p[0], b = p[1], c = p[2], d = p[3];
    f32x4 s = (a + b) + (c + d);
    return rsqrtf(((s[0] + s[1]) + (s[2] + s[3])) * (1.f / 1024.f) + EPS);
}

namespace pg8 {
constexpr int BM = 256, BK = 64, HALF = 128, HTB = HALF * BK * 2, STAGE_BYTES = 8 * HTB, NXCD = 8, WGM = 8;
__host__ __device__ __forceinline__ int lds_byte(int r, int c) { const int st = (r >> 4) * 2 + (c >> 5), rr = r & 15, cc = c & 31, ob = rr * 64 + cc * 2; return st * 1024 + (ob ^ (((ob >> 9) & 1) << 5)); }
__host__ __device__ __forceinline__ void stage_rc(int b, int& R, int& C) { const int st = b / 1024, sb = b % 1024, swz = sb ^ (((sb >> 9) & 1) << 5); R = (st >> 1) * 16 + swz / 64; C = (st & 1) * 32 + (swz % 64) / 2; }
__host__ __device__ __forceinline__ int perm32(int rho) { const int n = rho >> 4, i = rho & 15; return 8 * (i >> 2) + 4 * n + (i & 3); }

struct Unit { int pm, pn, ui; };
struct Gemm { const bf16_t* A; const bf16_t* Bt; int M, N, K, lda, a_pn_off, a_sh; };

struct StaticOrder {
    int nM, nN, nwg, G, c, rev;
    __device__ __forceinline__ void init(int M_, int N_, int G_, int c_) { nM = M_ / BM; nN = N_ / BM; nwg = nM * nN; G = G_; c = c_; rev = 0; }
    __device__ __forceinline__ bool next(int i, Unit& u) const {
        const long L = (long)i * G + c; if (L >= nwg) return false;
        int wgid = (int)L; { const int q = nwg / NXCD, r = nwg % NXCD, xcd = wgid % NXCD, off = wgid / NXCD; wgid = (xcd < r ? xcd * (q + 1) : r * (q + 1) + (xcd - r) * q) + off; }
        const int nig = WGM * nN, gid = wgid / nig, fm = gid * WGM, gsz = (nM - fm) < WGM ? (nM - fm) : WGM;
        u.pm = fm + ((wgid % nig) % gsz); u.pn = (wgid % nig) / gsz; if (rev) u.pm = nM - 1 - u.pm; return true;
    }
};

struct GateOrder {
    StaticOrder base;
    __device__ __forceinline__ bool next(int i, Unit& u) const { Unit t; if (!base.next(i >> 2, t)) return false; u.pm = t.pm; u.pn = (i & 3) * 4 + t.pn; return true; }
};
constexpr int RSL_OFF = 135168;
template <class Sched>
__device__ __forceinline__ void rstd_prepass(LAS unsigned char* lds, const float* ssq, const Sched& S, int tid_) {
    asm volatile("" : "+v"(tid_));
    LAS float* rsl = (LAS float*)(lds + RSL_OFF); Unit u;
    for (int i = tid_ >> 8; i < 10 && S.next(i, u); i += 2) rsl[i * 256 + (tid_ & 255)] = rstd16(ssq, u.pm * 256 + (tid_ & 255));
    __syncthreads();
}
#define RSL(u_, row_) (((const LAS float*)(lds_rs + RSL_OFF))[(u_).ui * 256 + ((row_) & 255)])
template <class Epi, class Sched>
__device__ __forceinline__ void gemm_phase(LAS unsigned char* lds, const Gemm g, const Sched& S, const Epi& E) {
    int tid = threadIdx.x; asm volatile("" : "+v"(tid));
    const int wid = __builtin_amdgcn_readfirstlane(tid >> 6), lane = tid & 63, wr = wid >> 2, wc = wid & 3, fr = lane & 15, fq = lane >> 4;
    int K = g.K, lda = g.lda; asm volatile("" : "+s"(K), "+s"(lda));
    const int nt = K / BK;
    unsigned voffA[2], voffB[2];
#pragma unroll
    for (int i = 0; i < 2; ++i) { int R, C; stage_rc(tid * 16 + i * 8192, R, C); const int Rb = (R & ~31) + perm32(R & 31);
        voffA[i] = (unsigned)(R * lda + C) * 2u; voffB[i] = (unsigned)(Rb * K + C) * 2u; }
    const size_t kstep = (size_t)(BK * 2);
    const size_t hsA = (size_t)HALF * lda * 2, hsB = (size_t)HALF * K * 2;
    const size_t tsA = 2 * hsA, tsB = 2 * hsB, pnA = (size_t)g.a_pn_off * 2;
    const unsigned ldsw = (unsigned)wid * 1024u;
    const int aoff = lds_byte(wr * 64 + fr, fq * 8), boff = lds_byte(wc * 32 + fr, fq * 8);
#define PG8_SA(b, h) (((b) * 2 + (h)) * HTB)
#define PG8_SB(b, h) ((4 + (b) * 2 + (h)) * HTB)
#define PG8_STAGE(bufoff, gbase, voff) do { _Pragma("unroll") for (int _i = 0; _i < 2; ++_i) \
        __builtin_amdgcn_global_load_lds((const unsigned*)((const char*)(gbase) + (voff)[_i]), (LAS unsigned*)(lds + (bufoff) + ldsw + _i * 8192), 16, 0, 0); } while (0)
#define PG8_LDA(dst, b, h) do { _Pragma("unroll") for (int m = 0; m < 4; ++m) _Pragma("unroll") for (int k = 0; k < 2; ++k) dst[m][k] = *(const LAS bf16x8*)(lds + PG8_SA(b, h) + aoff + m * 2048 + k * 1024); } while (0)
#define PG8_LDB(dst, b, h) do { _Pragma("unroll") for (int n = 0; n < 2; ++n) _Pragma("unroll") for (int k = 0; k < 2; ++k) dst[n][k] = *(const LAS bf16x8*)(lds + PG8_SB(b, h) + boff + n * 2048 + k * 1024); } while (0)
#define PG8_MMA(ai, bj, At, Bt) do { __builtin_amdgcn_s_setprio(1); _Pragma("unroll") for (int m = 0; m < 4; ++m) _Pragma("unroll") for (int n = 0; n < 2; ++n) _Pragma("unroll") for (int k = 0; k < 2; ++k) \
        acc[ai][bj][m][n] = __builtin_amdgcn_mfma_f32_16x16x32_bf16(Bt[n][k], At[m][k], acc[ai][bj][m][n], 0, 0, 0); __builtin_amdgcn_s_setprio(0); } while (0)
#define PG8_WAIT_V(n) asm volatile("s_waitcnt vmcnt(" #n ")" ::: "memory")
#define PG8_WAIT_L(n) asm volatile("s_waitcnt lgkmcnt(" #n ")" ::: "memory")
#define PG8_BAR __builtin_amdgcn_s_barrier()
#define PG8_SCHED __builtin_amdgcn_sched_barrier(0)
    Unit cur, nxt; int ui = 0;
    if (!S.next(0, cur)) return;
    f32x4 acc[2][2][4][2];
#pragma unroll
    for (int a = 0; a < 2; ++a)
#pragma unroll
        for (int b = 0; b < 2; ++b)
#pragma unroll
            for (int m = 0; m < 4; ++m)
#pragma unroll
                for (int n = 0; n < 2; ++n) acc[a][b][m][n] = (f32x4){0.f, 0.f, 0.f, 0.f};
    bf16x8 At[4][2], B0[2][2], B1[2][2];
    const char* cA = (const char*)g.A + (size_t)cur.pm * tsA + (size_t)(cur.pn >> g.a_sh) * pnA; const char* cB = (const char*)g.Bt + (size_t)cur.pn * tsB;
    PG8_STAGE(PG8_SB(0, 0), cB, voffB); PG8_STAGE(PG8_SB(0, 1), cB + hsB, voffB); PG8_STAGE(PG8_SA(0, 0), cA, voffA); PG8_STAGE(PG8_SA(0, 1), cA + hsA, voffA);
    if (wr == 1) PG8_BAR;
    PG8_WAIT_V(2); PG8_BAR;
    PG8_STAGE(PG8_SB(1, 0), cB + kstep, voffB); PG8_STAGE(PG8_SA(1, 0), cA + kstep, voffA); PG8_STAGE(PG8_SB(1, 1), cB + hsB + kstep, voffB);
    PG8_WAIT_V(6); PG8_BAR;
    for (;;) {
        const bool has_next = S.next(ui + 1, nxt);
        const char* nA = has_next ? (const char*)g.A + (size_t)nxt.pm * tsA + (size_t)(nxt.pn >> g.a_sh) * pnA : cA; const char* nB = has_next ? (const char*)g.Bt + (size_t)nxt.pn * tsB : cB;
        for (int t = 0; t < nt; t += 2) {
            const bool last = (t == nt - 2);
            const char* a1 = cA + (size_t)(t + 1) * kstep;
            const char* a2 = last ? nA : cA + (size_t)(t + 2) * kstep; const char* b2 = last ? nB : cB + (size_t)(t + 2) * kstep;
            const char* a3 = a2 + kstep; const char* b3 = b2 + kstep;
            PG8_LDB(B0, 0, 0); PG8_LDB(B1, 0, 1); PG8_SCHED; PG8_LDA(At, 0, 0); PG8_STAGE(PG8_SA(1, 1), a1 + hsA, voffA);
            PG8_WAIT_V(8); PG8_WAIT_L(0); PG8_BAR; PG8_MMA(0, 0, At, B0); PG8_MMA(0, 1, At, B1); PG8_BAR; PG8_SCHED;
            PG8_LDA(At, 0, 1); PG8_STAGE(PG8_SB(0, 0), b2, voffB); PG8_STAGE(PG8_SB(0, 1), b2 + hsB, voffB); PG8_STAGE(PG8_SA(0, 0), a2, voffA);
            PG8_WAIT_V(8); PG8_WAIT_L(0); PG8_BAR; PG8_MMA(1, 0, At, B0); PG8_MMA(1, 1, At, B1); PG8_BAR; PG8_SCHED;
            PG8_LDB(B0, 1, 0); PG8_LDB(B1, 1, 1); PG8_SCHED; PG8_LDA(At, 1, 0); PG8_STAGE(PG8_SA(0, 1), a2 + hsA, voffA);
            PG8_WAIT_V(8); PG8_WAIT_L(0); PG8_BAR; PG8_MMA(0, 0, At, B0); PG8_MMA(0, 1, At, B1); PG8_BAR; PG8_SCHED;
            PG8_LDA(At, 1, 1); PG8_STAGE(PG8_SB(1, 0), b3, voffB); PG8_STAGE(PG8_SB(1, 1), b3 + hsB, voffB); PG8_STAGE(PG8_SA(1, 0), a3, voffA);
            PG8_WAIT_V(8); PG8_WAIT_L(0); PG8_BAR; PG8_MMA(1, 0, At, B0); PG8_MMA(1, 1, At, B1); PG8_BAR; PG8_SCHED;
        }
        if (wr == 0) PG8_BAR;
        cur.ui = ui; E(acc, cur, wr, wc, fr, fq);
        if (!has_next) break;
#pragma unroll
        for (int a = 0; a < 2; ++a)
#pragma unroll
            for (int b = 0; b < 2; ++b)
#pragma unroll
                for (int m = 0; m < 4; ++m)
#pragma unroll
                    for (int n = 0; n < 2; ++n) acc[a][b][m][n] = (f32x4){0.f, 0.f, 0.f, 0.f};
        cur = nxt; cA = nA; cB = nB; ++ui;
        if (wr == 1) PG8_BAR;
    }
    PG8_WAIT_V(0);
    PG8_BAR;
#undef PG8_SA
#undef PG8_SB
#undef PG8_STAGE
#undef PG8_LDA
#undef PG8_LDB
#undef PG8_MMA
#undef PG8_WAIT_V
#undef PG8_WAIT_L
#undef PG8_BAR
#undef PG8_SCHED
}

struct MUnit { int pm, pn, ui, kind, n; };
struct MergeOrder { StaticOrder base;
    __device__ __forceinline__ bool next(int i, MUnit& u) const { Unit t; if (!base.next(i >> 3, t)) return false; u.pm = t.pm; u.pn = t.pn; u.n = (i >> 1) & 3; u.kind = i & 1; u.ui = i; return true; } };
template <class Epi>
__device__ __forceinline__ void gemm_merge_fused(LAS unsigned char* lds, const bf16_t* Yb, const bf16_t* XBb, const bf16_t* WBR, const bf16_t* WG, const MergeOrder& S, const Epi& E) {
    int tid = threadIdx.x; asm volatile("" : "+v"(tid));
    const int wid = __builtin_amdgcn_readfirstlane(tid >> 6), lane = tid & 63, wr = wid >> 2, wc = wid & 3, fr = lane & 15, fq = lane >> 4;
    int R0, C0; stage_rc(tid * 16, R0, C0);
    const unsigned Rb0 = (unsigned)((R0 & ~31) + perm32(R0 & 31)), Ra0 = (unsigned)R0, C2 = (unsigned)C0 * 2u;
    int la0 = 4096, lb0 = 1024, la1_ = 2048, lb1 = 2048, nt0 = 8, nt1 = 16;
    asm volatile("" : "+s"(la0), "+s"(lb0), "+s"(la1_), "+s"(lb1), "+s"(nt0), "+s"(nt1));
#define MF_LA(k) ((unsigned)((k) ? la1_ : la0))
#define MF_LB(k) ((unsigned)((k) ? lb1 : lb0))
    const size_t kstep = (size_t)(BK * 2);
#define MF_ABASE(u_) ((u_).kind ? (const char*)XBb + (size_t)(u_).pm * 256 * 1024 * 2 : (const char*)Yb + (size_t)(u_).pm * 256 * 2048 * 2 + (size_t)(u_).n * 512 * 2)
#define MF_BBASE(u_) ((u_).kind ? (const char*)WG + ((size_t)(u_).n * 1024 + (size_t)(u_).pn * 256) * 1024 * 2 : (const char*)WBR + ((size_t)(u_).n * 1024 + (size_t)(u_).pn * 256) * 512 * 2)
    const unsigned ldsw = (unsigned)wid * 1024u;
    const int aoff = lds_byte(wr * 64 + fr, fq * 8), boff = lds_byte(wc * 32 + fr, fq * 8);
#define PG8_SA(b, h) (((b) * 2 + (h)) * HTB)
#define PG8_SB(b, h) ((4 + (b) * 2 + (h)) * HTB)
#define PG8_STAGE(bufoff, gbase, voff) do { _Pragma("unroll") for (int _i = 0; _i < 2; ++_i) \
        __builtin_amdgcn_global_load_lds((const unsigned*)((const char*)(gbase) + (voff)[_i]), (LAS unsigned*)(lds + (bufoff) + ldsw + _i * 8192), 16, 0, 0); } while (0)
#define PG8_LDA(dst, b, h) do { _Pragma("unroll") for (int m = 0; m < 4; ++m) _Pragma("unroll") for (int k = 0; k < 2; ++k) dst[m][k] = *(const LAS bf16x8*)(lds + PG8_SA(b, h) + aoff + m * 2048 + k * 1024); } while (0)
#define PG8_LDB(dst, b, h) do { _Pragma("unroll") for (int n = 0; n < 2; ++n) _Pragma("unroll") for (int k = 0; k < 2; ++k) dst[n][k] = *(const LAS bf16x8*)(lds + PG8_SB(b, h) + boff + n * 2048 + k * 1024); } while (0)
#define PG8_MMA(ai, bj, At, Bt) do { __builtin_amdgcn_s_setprio(1); _Pragma("unroll") for (int m = 0; m < 4; ++m) _Pragma("unroll") for (int n = 0; n < 2; ++n) _Pragma("unroll") for (int k = 0; k < 2; ++k) \
        acc[ai][bj][m][n] = __builtin_amdgcn_mfma_f32_16x16x32_bf16(Bt[n][k], At[m][k], acc[ai][bj][m][n], 0, 0, 0); __builtin_amdgcn_s_setprio(0); } while (0)
#define PG8_WAIT_V(n) asm volatile("s_waitcnt vmcnt(" #n ")" ::: "memory")
#define PG8_WAIT_L(n) asm volatile("s_waitcnt lgkmcnt(" #n ")" ::: "memory")
#define PG8_BAR __builtin_amdgcn_s_barrier()
#define PG8_SCHED __builtin_amdgcn_sched_barrier(0)
    MUnit cur, nxt; int ui = 0;
    if (!S.next(0, cur)) return;
    f32x4 acc[2][2][4][2];
#pragma unroll
    for (int a = 0; a < 2; ++a)
#pragma unroll
        for (int b = 0; b < 2; ++b)
#pragma unroll
            for (int m = 0; m < 4; ++m)
#pragma unroll
                for (int n = 0; n < 2; ++n) acc[a][b][m][n] = (f32x4){0.f, 0.f, 0.f, 0.f};
    bf16x8 At[4][2], B0[2][2], B1[2][2];
    const char* cA = MF_ABASE(cur); const char* cB = MF_BBASE(cur); int ck = cur.kind;
    { const unsigned la = MF_LA(ck), lb = MF_LB(ck); unsigned voffA[2] = {Ra0 * la + C2, Ra0 * la + C2 + 64u * la}, voffB[2] = {Rb0 * lb + C2, Rb0 * lb + C2 + 64u * lb}; const size_t hsA = (size_t)128 * la, hsB = (size_t)128 * lb;
    PG8_STAGE(PG8_SB(0, 0), cB, voffB); PG8_STAGE(PG8_SB(0, 1), cB + hsB, voffB); PG8_STAGE(PG8_SA(0, 0), cA, voffA); PG8_STAGE(PG8_SA(0, 1), cA + hsA, voffA);
    if (wr == 1) PG8_BAR;
    PG8_WAIT_V(2); PG8_BAR;
    PG8_STAGE(PG8_SB(1, 0), cB + kstep, voffB); PG8_STAGE(PG8_SA(1, 0), cA + kstep, voffA); PG8_STAGE(PG8_SB(1, 1), cB + hsB + kstep, voffB);
    PG8_WAIT_V(6); PG8_BAR; }
    for (;;) {
        const bool has_next = S.next(ui + 1, nxt);
        const char* nA = cA; const char* nB = cB; int nk = ck;
        if (has_next) { nA = MF_ABASE(nxt); nB = MF_BBASE(nxt); nk = nxt.kind; }
        const int nt = ck ? nt1 : nt0;
        for (int t = 0; t < nt; t += 2) {
            const bool last = (t == nt - 2);
            const int kx = last ? nk : ck;
            const unsigned la1 = MF_LA(ck), lax = MF_LA(kx), lbx = MF_LB(kx);
            unsigned voffA1[2] = {Ra0 * la1 + C2, Ra0 * la1 + C2 + 64u * la1};
            unsigned voffA[2] = {Ra0 * lax + C2, Ra0 * lax + C2 + 64u * lax};
            unsigned voffB[2] = {Rb0 * lbx + C2, Rb0 * lbx + C2 + 64u * lbx};
            const size_t hsA1 = (size_t)128 * la1, hsA = (size_t)128 * lax, hsB = (size_t)128 * lbx;
            const char* a1 = cA + (size_t)(t + 1) * kstep;
            const char* a2 = last ? nA : cA + (size_t)(t + 2) * kstep; const char* b2 = last ? nB : cB + (size_t)(t + 2) * kstep;
            const char* a3 = a2 + kstep; const char* b3 = b2 + kstep;
            PG8_LDB(B0, 0, 0); PG8_LDB(B1, 0, 1); PG8_SCHED; PG8_LDA(At, 0, 0); PG8_STAGE(PG8_SA(1, 1), a1 + hsA1, voffA1);
            PG8_WAIT_V(8); PG8_WAIT_L(0); PG8_BAR; PG8_MMA(0, 0, At, B0); PG8_MMA(0, 1, At, B1); PG8_BAR; PG8_SCHED;
            PG8_LDA(At, 0, 1); PG8_STAGE(PG8_SB(0, 0), b2, voffB); PG8_STAGE(PG8_SB(0, 1), b2 + hsB, voffB); PG8_STAGE(PG8_SA(0, 0), a2, voffA);
            PG8_WAIT_V(8); PG8_WAIT_L(0); PG8_BAR; PG8_MMA(1, 0, At, B0); PG8_MMA(1, 1, At, B1); PG8_BAR; PG8_SCHED;
            PG8_LDB(B0, 1, 0); PG8_LDB(B1, 1, 1); PG8_SCHED; PG8_LDA(At, 1, 0); PG8_STAGE(PG8_SA(0, 1), a2 + hsA, voffA);
            PG8_WAIT_V(8); PG8_WAIT_L(0); PG8_BAR; PG8_MMA(0, 0, At, B0); PG8_MMA(0, 1, At, B1); PG8_BAR; PG8_SCHED;
            PG8_LDA(At, 1, 1); PG8_STAGE(PG8_SB(1, 0), b3, voffB); PG8_STAGE(PG8_SB(1, 1), b3 + hsB, voffB); PG8_STAGE(PG8_SA(1, 0), a3, voffA);
            PG8_WAIT_V(8); PG8_WAIT_L(0); PG8_BAR; PG8_MMA(1, 0, At, B0); PG8_MMA(1, 1, At, B1); PG8_BAR; PG8_SCHED;
        }
        if (wr == 0) PG8_BAR;
        cur.ui = ui; E(acc, cur, wr, wc, fr, fq);
        if (!has_next) break;
#pragma unroll
        for (int a = 0; a < 2; ++a)
#pragma unroll
            for (int b = 0; b < 2; ++b)
#pragma unroll
                for (int m = 0; m < 4; ++m)
#pragma unroll
                    for (int n = 0; n < 2; ++n) acc[a][b][m][n] = (f32x4){0.f, 0.f, 0.f, 0.f};
        cur = nxt; cA = nA; cB = nB; ck = nk; ++ui;
        if (wr == 1) PG8_BAR;
    }
    PG8_WAIT_V(0);
    PG8_BAR;
#undef MF_ABASE
#undef MF_BBASE
#undef MF_LA
#undef MF_LB
#undef PG8_SA
#undef PG8_SB
#undef PG8_STAGE
#undef PG8_LDA
#undef PG8_LDB
#undef PG8_MMA
#undef PG8_WAIT_V
#undef PG8_WAIT_L
#undef PG8_BAR
#undef PG8_SCHED
}

#define EPI_ROWS_BEGIN _Pragma("unroll") for (int ai = 0; ai < 2; ++ai) _Pragma("unroll") for (int m = 0; m < 4; ++m) { const int row = u.pm * 256 + ai * 128 + wr * 64 + m * 16 + fr;
#define EPI_ROWS_END if (m & 1) asm volatile("" ::: "memory"); }
typedef const f32x4 (&AccRef)[2][2][4][2];

struct EpiInproj {
    bf16_t *u1, *ua, *ub; const LAS unsigned char* lds_rs;
    __device__ __forceinline__ void operator()(AccRef acc, const Unit& u, int wr, int wc, int fr, int fq) const {
        bf16_t* base; int ld, ct; const int pn = u.pn;
        if (pn < 4) { base = u1; ld = 1024; ct = pn; } else if (pn < 7) { base = ua; ld = 768; ct = pn - 4; } else { base = ub; ld = 1792; ct = pn - 7; }
        const int col0 = ct * 256 + wc * 32 + 8 * fq;
        EPI_ROWS_BEGIN
            const float r = RSL(u, row);
#pragma unroll
            for (int bj = 0; bj < 2; ++bj) *(u32x4*)(base + (size_t)row * ld + col0 + bj * 128) = pack8(acc[ai][bj][m][0] * r, acc[ai][bj][m][1] * r);
        EPI_ROWS_END
    }
};
struct EpiQ {
    bf16_t *y, *qr; const float* rsq; const f32x2* cs;
    __device__ __forceinline__ void operator()(AccRef acc, const Unit& u, int wr, int wc, int fr, int fq) const {
        const int pn = u.pn;
        EPI_ROWS_BEGIN
            const float r = rsq[row] * QSCALE;
#pragma unroll
            for (int bj = 0; bj < 2; ++bj) {
                f32x4 v0 = acc[ai][bj][m][0] * r, v1 = acc[ai][bj][m][1] * r;
                if (pn < 2) { *(u32x4*)(y + (size_t)row * 2048 + pn * 256 + bj * 128 + wc * 32 + 8 * fq) = pack8(v0, v1); }
                else {
                    const int c0 = bj * 128 + wc * 32 + 8 * fq, i0 = (c0 & 31) >> 1;
                    const f32x4* cp = (const f32x4*)(cs + (size_t)row * 16 + i0);
                    const f32x4 t0 = cp[0], t1 = cp[1];
                    f32x4 o0, o1;
                    o0[0] = v0[0] * t0[0] - v0[1] * t0[1]; o0[1] = v0[1] * t0[0] + v0[0] * t0[1];
                    o0[2] = v0[2] * t0[2] - v0[3] * t0[3]; o0[3] = v0[3] * t0[2] + v0[2] * t0[3];
                    o1[0] = v1[0] * t1[0] - v1[1] * t1[1]; o1[1] = v1[1] * t1[0] + v1[0] * t1[1];
                    o1[2] = v1[2] * t1[2] - v1[3] * t1[3]; o1[3] = v1[3] * t1[2] + v1[2] * t1[3];
                    *(u32x4*)(qr + (size_t)row * 256 + c0) = pack8(o0, o1);
                }
            }
        EPI_ROWS_END
    }
};
struct EpiRowScale {
    bf16_t* o0; int ld; const float* rs; size_t split;
    __device__ __forceinline__ void operator()(AccRef acc, const Unit& u, int wr, int wc, int fr, int fq) const {
        bf16_t* o = split ? o0 + (size_t)(u.pn >> 2) * split : o0;
        const int col0 = (split ? (u.pn & 3) : u.pn) * 256 + wc * 32 + 8 * fq;
        EPI_ROWS_BEGIN
            const float r = rs ? rs[row] : 1.f;
#pragma unroll
            for (int bj = 0; bj < 2; ++bj) *(u32x4*)(o + (size_t)row * ld + col0 + bj * 128) = pack8(acc[ai][bj][m][0] * r, acc[ai][bj][m][1] * r);
        EPI_ROWS_END
    }
};
struct EpiLru {
    bf16_t* y3; bf16_t* la; const float *b_a, *b_i, *lam;
    __device__ __forceinline__ void operator()(AccRef acc, const Unit& u, int wr, int wc, int fr, int fq) const {
#pragma unroll
        for (int n = 0; n < 2; ++n) {
            const int ch0 = u.pn * 128 + wc * 32 + 8 * fq + 4 * n;
            const f32x4 ba = *(const f32x4*)(b_a + ch0), bi = *(const f32x4*)(b_i + ch0), lm = *(const f32x4*)(lam + ch0);
            f32x4 sp;
#pragma unroll
            for (int e = 0; e < 4; ++e) sp[e] = -8.f * log1pf(__expf(-lm[e]));
            EPI_ROWS_BEGIN
                bf16_t* xp = y3 + (size_t)row * 2048 + ch0;
                const u32x2 xw = *(const u32x2*)xp;
                const f32x4 xc = (f32x4){bflo(xw.x), bfhi(xw.x), bflo(xw.y), bfhi(xw.y)};
                f32x4 uo, lo;
#pragma unroll
                for (int e = 0; e < 4; ++e) {
                    const float rr = acc[ai][0][m][n][e] + ba[e], ii = acc[ai][1][m][n][e] + bi[e];
                    const float log_a = sp[e] * sigmoidf_(rr);
                    const float mult = sqrtf(one_minus_exp(2.f * log_a));
                    uo[e] = xc[e] * sigmoidf_(ii) * mult; lo[e] = log_a;
                }
                u32x2 w0, w1; w0.x = cvt_pk_bf16(uo[0], uo[1]); w0.y = cvt_pk_bf16(uo[2], uo[3]); w1.x = cvt_pk_bf16(lo[0], lo[1]); w1.y = cvt_pk_bf16(lo[2], lo[3]);
                *(u32x2*)xp = w0;
                *(u32x2*)(la + (size_t)row * 512 + ch0) = w1;
                asm volatile("" ::: "memory");
            EPI_ROWS_END
        }
    }
};
struct EpiGate {
    const LAS unsigned char* lds_rs; const bf16_t* tall; bf16_t* mb; const float* rsc;
    __device__ __forceinline__ void operator()(AccRef acc, const Unit& u, int wr, int wc, int fr, int fq) const {
        const int n = u.pn >> 2; const bf16_t* tn = tall + (size_t)n * 64 * MiB / 2; const float* trs = (n == 2) ? rsc : nullptr;
        const int col0 = (u.pn & 3) * 256 + wc * 32 + 8 * fq;
        u32x4 tq[2][4][2];
#pragma unroll
        for (int ai = 0; ai < 2; ++ai)
#pragma unroll
            for (int m = 0; m < 4; ++m)
#pragma unroll
                for (int bj = 0; bj < 2; ++bj) tq[ai][m][bj] = *(const u32x4*)(tn + (size_t)(u.pm * 256 + ai * 128 + wr * 64 + m * 16 + fr) * 1024 + col0 + bj * 128);
        EPI_ROWS_BEGIN
            const float r = RSL(u, row); const float ts = trs ? trs[row] : 1.f;
#pragma unroll
            for (int bj = 0; bj < 2; ++bj) {
                const size_t off = (size_t)row * 1024 + col0 + bj * 128;
                f32x4 t0, t1; unpack8(tq[ai][m][bj], t0, t1); t0 = t0 * ts; t1 = t1 * ts;
                f32x4 g0 = acc[ai][bj][m][0] * r, g1 = acc[ai][bj][m][1] * r;
#pragma unroll
                for (int e = 0; e < 4; ++e) { g0[e] = sigmoidf_(g0[e]) * t0[e]; g1[e] = sigmoidf_(g1[e]) * t1[e]; }
                if (n > 0) { f32x4 p0, p1; unpack8(*(const u32x4*)(mb + off), p0, p1); g0 += p0; g1 += p1; }
                *(u32x4*)(mb + off) = pack8(g0, g1);
            }
        EPI_ROWS_END
    }
};
struct EpiMerge {
    const LAS unsigned char* lds_rs; bf16_t* tall; bf16_t* mb;
    __device__ __forceinline__ void operator()(AccRef acc, const MUnit& u, int wr, int wc, int fr, int fq) const {
        const int n = u.n; bf16_t* tn = tall;
        const int col0 = u.pn * 256 + wc * 32 + 8 * fq;
        if (u.kind == 0) {
            EPI_ROWS_BEGIN
#pragma unroll
                for (int bj = 0; bj < 2; ++bj) *(u32x4*)(tn + (size_t)row * 1024 + col0 + bj * 128) = pack8(acc[ai][bj][m][0], acc[ai][bj][m][1]);
            EPI_ROWS_END
        } else {
            const LAS float* rsl = (const LAS float*)(lds_rs + RSL_OFF) + (u.ui >> 3) * 256;
            u32x4 tq[2][4][2];
#pragma unroll
            for (int ai = 0; ai < 2; ++ai)
#pragma unroll
                for (int m = 0; m < 4; ++m)
#pragma unroll
                    for (int bj = 0; bj < 2; ++bj) tq[ai][m][bj] = *(const u32x4*)(tn + (size_t)(u.pm * 256 + ai * 128 + wr * 64 + m * 16 + fr) * 1024 + col0 + bj * 128);
            EPI_ROWS_BEGIN
                const float r = rsl[row & 255]; const float ts = (n == 2) ? rsl[1024 + (row & 255)] : 1.f;
#pragma unroll
                for (int bj = 0; bj < 2; ++bj) {
                    const size_t off = (size_t)row * 1024 + col0 + bj * 128;
                    f32x4 t0, t1; unpack8(tq[ai][m][bj], t0, t1); t0 = t0 * ts; t1 = t1 * ts;
                    f32x4 g0 = acc[ai][bj][m][0] * r, g1 = acc[ai][bj][m][1] * r;
#pragma unroll
                    for (int e = 0; e < 4; ++e) { g0[e] = sigmoidf_(g0[e]) * t0[e]; g1[e] = sigmoidf_(g1[e]) * t1[e]; }
                    if (n > 0) { f32x4 p0, p1; unpack8(*(const u32x4*)(mb + off), p0, p1); g0 += p0; g1 += p1; }
                    *(u32x4*)(mb + off) = pack8(g0, g1);
                }
            EPI_ROWS_END
        }
    }
};
__device__ __forceinline__ void merge_prepass(LAS unsigned char* lds, const float* ssq, const float* ssqc, const MergeOrder& S, int tid_) {
    asm volatile("" : "+v"(tid_));
    LAS float* rsl = (LAS float*)(lds + RSL_OFF); Unit t;
    const int ti = tid_ >> 8, rr = tid_ & 255;
    if (S.base.next(ti, t)) { const int row = t.pm * 256 + rr; rsl[ti * 256 + rr] = rstd16(ssq, row);
        const f32x4* p = (const f32x4*)(ssqc + (size_t)row * 16); const f32x4 a = p[0], b = p[1], c = p[2], d = p[3]; const f32x4 q = (a + b) + (c + d);
        rsl[1024 + ti * 256 + rr] = rsqrtf(((q[0] + q[1]) + (q[2] + q[3])) * (1.f / 512.f) + EPS); }
    __syncthreads();
}
template <int MODE  > struct EpiRes {
    const float* xold; float* xf; bf16_t* xb; float* ssq_out; const LAS unsigned char* lds_rs; const bf16_t* tp;
    __device__ __forceinline__ void operator()(AccRef acc, const Unit& u, int wr, int wc, int fr, int fq) const {
        const int col0 = u.pn * 256 + wc * 32 + 8 * fq;
        EPI_ROWS_BEGIN
            float r = 1.f; if (MODE == 1) r = RSL(u, row);
            float ss = 0.f;
#pragma unroll
            for (int bj = 0; bj < 2; ++bj) {
                const size_t off = (size_t)row * 1024 + col0 + bj * 128;
                f32x4 a0 = acc[ai][bj][m][0], a1 = acc[ai][bj][m][1];
                if (MODE == 1) { f32x4 t0, t1; unpack8(*(const u32x4*)(tp + off), t0, t1);
#pragma unroll
                    for (int e = 0; e < 4; ++e) { a0[e] = sigmoidf_(a0[e] * r) * t0[e]; a1[e] = sigmoidf_(a1[e] * r) * t1[e]; } }
                const f32x4 n0 = *(const f32x4*)(xold + off) + a0, n1 = *(const f32x4*)(xold + off + 4) + a1;
                *(f32x4*)(xf + off) = n0; *(f32x4*)(xf + off + 4) = n1;
                if (MODE == 0) *(u32x4*)(xb + off) = pack8(n0, n1);
                ss += (n0[0] * n0[0] + n0[1] * n0[1]) + (n0[2] * n0[2] + n0[3] * n0[3]) + (n1[0] * n1[0] + n1[1] * n1[1]) + (n1[2] * n1[2] + n1[3] * n1[3]);
            }
            ss += __shfl_xor(ss, 16); ss = xhalf_sum(ss);
            if (fq == 0) ssq_out[(size_t)row * 16 + u.pn * 4 + wc] = ss;
        EPI_ROWS_END
    }
};
struct EpiFF1 {
    bf16_t* h; const LAS unsigned char* lds_rs;
    __device__ __forceinline__ void operator()(AccRef acc, const Unit& u, int wr, int wc, int fr, int fq) const {
        const int col0 = u.pn * 256 + wc * 32 + 8 * fq;
        EPI_ROWS_BEGIN
            const float r = RSL(u, row);
#pragma unroll
            for (int bj = 0; bj < 2; ++bj) {
                f32x4 a0 = acc[ai][bj][m][0] * r, a1 = acc[ai][bj][m][1] * r;
#pragma unroll
                for (int e = 0; e < 4; ++e) { const float p = fmaxf(a0[e], 0.f), q = fmaxf(a1[e], 0.f); a0[e] = p * p; a1[e] = q * q; }
                *(u32x4*)(h + (size_t)row * 4096 + col0 + bj * 128) = pack8(a0, a1);
            }
        EPI_ROWS_END
    }
};
}

__device__ __forceinline__ void conv_weights(PP P, int l, bf16_t* W, int tid_, int bid_, int ngt, LAS unsigned char* lds) {
    asm volatile("" : "+v"(tid_)); const int gt = bid_ * 512 + tid_;
    if (l == 0 && gt < 64) ((unsigned*)P->ws)[64 + gt] = 0u;
    const float* g_mix = P->in[3] + l * 1024; const float* w_in = P->in[4] + (size_t)l * 1024 * INC;
    const float* q_norm = P->in[5] + l * 384; const float* w_uq = P->in[6] + (size_t)l * 384 * 768;
    const float* kv_norm = P->in[7] + l * 256; const float* w_ukv = P->in[8] + (size_t)l * 256 * 1024;
    const float* w_pool = P->in[9] + (size_t)l * 4 * 128 * 128; const float* pool_scale = P->in[10] + l * 512;
    const float* ssd_norm = P->in[16] + l * 512;
    const float* w_a = P->in[19] + (size_t)l * 8 * 64 * 64; const float* w_i = P->in[21] + (size_t)l * 8 * 64 * 64;
    const float* w_branch = P->in[24] + (size_t)l * 4 * 512 * 1024; const float* w_out = P->in[25] + (size_t)l * 1024 * 1024;
    const float* g_mlp = P->in[26] + l * 1024; const float* w_ff1 = P->in[27] + (size_t)l * 1024 * 4096; const float* w_ff2 = P->in[28] + (size_t)l * 4096 * 1024;
    const float* g_ple = P->in[29] + l * 1024; const float* w_pg = P->in[30] + (size_t)l * 1024 * 1024; const float* w_ple = P->in[31] + (size_t)l * 256 * 1024;
    constexpr int TOTAL_ITEMS = (int)(W_TOTAL / 2048);
    const int wave_ = tid_ >> 6, lane = tid_ & 63;
    LAS float* scr = (LAS float*)(lds + wave_ * 8448);
    for (int item = bid_ * 8 + wave_; item < TOTAL_ITEMS; item += ngt / 64) {
        const long e = (long)item * 2048;
        int N, K; size_t base; int mat;
        if (e < (long)W_G) { mat = 0; base = W_IN; N = 3584; K = 1024; }
        else if (e < (long)W_UQ) { mat = 1; base = W_G; N = 4096; K = 1024; }
        else if (e < (long)W_UKV) { mat = 2; base = W_UQ; N = 768; K = 384; }
        else if (e < (long)W_POOL) { mat = 3; base = W_UKV; N = 1024; K = 256; }
        else if (e < (long)W_LRU) { mat = 4; base = W_POOL; N = 512; K = 256; }
        else if (e < (long)W_BR) { mat = 5; base = W_LRU; N = 1024; K = 128; }
        else if (e < (long)W_OUT) { mat = 6; base = W_BR; N = 4096; K = 512; }
        else if (e < (long)W_FF1) { mat = 7; base = W_OUT; N = 1024; K = 1024; }
        else if (e < (long)W_FF2) { mat = 8; base = W_FF1; N = 4096; K = 1024; }
        else if (e < (long)W_PG) { mat = 9; base = W_FF2; N = 1024; K = 4096; }
        else if (e < (long)W_PLE) { mat = 10; base = W_PG; N = 1024; K = 1024; }
        else { mat = 11; base = W_PLE; N = 1024; K = 256; }
        const int idx = item - (int)(base / 2048), nblk = N / 32, n0 = (idx % nblk) * 32, k0 = (idx / nblk) * 64;
        const int n = n0 + (lane & 31);
        const float* ptr = nullptr; int stride = 0; const float* gk = nullptr; float sn = 1.f; bool valid = true;
        switch (mat) {
        case 0: { int sc;
            if (n < 512) sc = 1184 + n; else if (n < 1024) sc = 2472 + (n - 512);
            else if (n < 1408) sc = n - 1024; else if (n < 1664) sc = 384 + (n - 1408); else if (n < 1696) sc = 640 + (n - 1664);
            else if (n < 1704) sc = 2464 + (n - 1696); else if (n < 1792) { sc = 0; valid = false; }
            else { const int q = n - 1792; if (q < 512) sc = 672 + q; else if (q < 1280) sc = 1696 + (q - 512); else sc = 2984 + (q - 1280); }
            ptr = w_in + (size_t)k0 * INC + sc; stride = INC; gk = g_mix + k0; } break;
        case 1: ptr = w_in + (size_t)k0 * INC + 3496 + n; stride = INC; gk = g_mix + k0; break;
        case 2: { int sc; if (n < 512) sc = (n >> 6) * 96 + (n & 63); else { const int q = n - 512, hd = q >> 5, jj = q & 31; sc = hd * 96 + 64 + (jj & 1) * 16 + (jj >> 1); }
            ptr = w_uq + (size_t)k0 * 768 + sc; stride = 768; gk = q_norm + k0; } break;
        case 3: { int sc; if (n < 512) sc = (n >> 6) * 128 + (n & 63); else { const int q = n - 512; sc = (q >> 6) * 128 + 64 + (q & 63); }
            ptr = w_ukv + (size_t)k0 * 1024 + sc; stride = 1024; gk = kv_norm + k0; } break;
        case 4: { const int g = n >> 7, j = n & 127, pn = n >> 8, gk_ = 2 * pn + (k0 >> 7), i0 = k0 & 127; valid = (gk_ == g);
            ptr = w_pool + (size_t)g * 16384 + i0 * 128 + j; stride = 128; sn = pool_scale[n]; } break;
        case 5: { const int pn = n >> 8, bj = (n & 255) >> 7, ch = 128 * pn + (n & 127), hb = ch >> 6, j = ch & 63, hbk = 2 * pn + (k0 >> 6), i0 = k0 & 63; valid = (hbk == hb);
            ptr = (bj ? w_i : w_a) + (size_t)hb * 4096 + i0 * 64 + j; stride = 64; } break;
        case 6: { const int br = n >> 10, nn = n & 1023; ptr = w_branch + (size_t)br * 512 * 1024 + (size_t)k0 * 1024 + nn; stride = 1024; if (br == 2) gk = ssd_norm + k0; } break;
        case 7: ptr = w_out + (size_t)k0 * 1024 + n; stride = 1024; break;
        case 8: ptr = w_ff1 + (size_t)k0 * 4096 + n; stride = 4096; gk = g_mlp + k0; break;
        case 9: ptr = w_ff2 + (size_t)k0 * 1024 + n; stride = 1024; break;
        case 10: ptr = w_pg + (size_t)k0 * 1024 + n; stride = 1024; gk = g_ple + k0; break;
        default: ptr = w_ple + (size_t)k0 * 1024 + n; stride = 1024; break;
        }
        const int kh = lane >> 5;
#pragma unroll 8
        for (int i = 0; i < 32; ++i) { const int kk = 2 * i + kh; float x = 0.f; if (valid) { x = ptr[(size_t)kk * stride] * sn; if (gk) x *= gk[kk]; } scr[kk * 33 + (lane & 31)] = x; }
        asm volatile("s_waitcnt lgkmcnt(0)" ::: "memory");
        const int c = lane & 7;
#pragma unroll
        for (int jj = 0; jj < 4; ++jj) { const int nn = (lane >> 3) + 8 * jj; const LAS float* sp_ = scr + (8 * c) * 33 + nn;
            u32x4 o; o.x = cvt_pk_bf16(sp_[0], sp_[33]); o.y = cvt_pk_bf16(sp_[66], sp_[99]); o.z = cvt_pk_bf16(sp_[132], sp_[165]); o.w = cvt_pk_bf16(sp_[198], sp_[231]);
            *(u32x4*)(W + base + (size_t)(n0 + nn) * K + k0 + 8 * c) = o; }
        asm volatile("s_waitcnt lgkmcnt(0)" ::: "memory");
    }
}

__device__ __forceinline__ void p0_rows(PP P, const float* x, bool first, bf16_t* XB, float* ssq, f32x2* CS, int gw, int ngw, int tid_) {
    asm volatile("" : "+v"(tid_)); const int lane = tid_ & 63;
    const int* pos = (const int*)P->in[2];
    f32x4 v[4][4], nx[4][4];
#pragma unroll
    for (int u = 0; u < 4; ++u) { const int m = gw + u * ngw; if (m < M) { const f32x4* xr = (const f32x4*)(x + (size_t)m * D) + lane;
#pragma unroll
        for (int j = 0; j < 4; ++j) v[u][j] = xr[64 * j]; } }
    for (int mb = gw; mb < M; mb += 4 * ngw) {
#pragma unroll
        for (int u = 0; u < 4; ++u) { const int m = mb + 4 * ngw + u * ngw; if (m < M) { const f32x4* xr = (const f32x4*)(x + (size_t)m * D) + lane;
#pragma unroll
            for (int j = 0; j < 4; ++j) nx[u][j] = xr[64 * j]; } }
#pragma unroll
        for (int u = 0; u < 4; ++u) { const int m = mb + u * ngw; if (m >= M) continue; u32x2* o = (u32x2*)(XB + (size_t)m * D) + lane; float s = 0.f;
#pragma unroll
            for (int j = 0; j < 4; ++j) { const f32x4 t = v[u][j]; s += (t[0] * t[0] + t[1] * t[1]) + (t[2] * t[2] + t[3] * t[3]); u32x2 w; w.x = cvt_pk_bf16(t[0], t[1]); w.y = cvt_pk_bf16(t[2], t[3]); o[64 * j] = w; }
            if (first) {
                s = wave_sum(s);
                if (lane < 16) {
                    ssq[(size_t)m * 16 + lane] = (lane == 0) ? s : 0.f;
                    const double ang = (double)pos[m] * P->inv_freq[lane];
                    const double k = rint(ang * 0.15915494309189535);
                    const float r = (float)(ang - k * 6.283185307179586);
                    f32x2 cs_; cs_[0] = cosf(r); cs_[1] = sinf(r);
                    CS[(size_t)m * 16 + lane] = cs_;
                }
            }
        }
#pragma unroll
        for (int u = 0; u < 4; ++u)
#pragma unroll
            for (int j = 0; j < 4; ++j) v[u][j] = nx[u][j];
    }
}

__device__ __forceinline__ void p2_pool_block(const bf16_t* UB, bf16_t* Y, int m0, int lane) {
    const int g = lane >> 4, w = 2 << g, t0 = m0 & (SEQ - 1);
    const bf16_t* base = UB + (size_t)m0 * 1792 + lane * 8;
    bf16_t* ob = Y + (size_t)m0 * 2048 + 512 + lane * 8;
    u32x4 prev[16];
#pragma unroll
    for (int j = 0; j < 16; ++j) { prev[j] = (u32x4){0u, 0u, 0u, 0u}; if (t0 > 0) prev[j] = *(const u32x4*)(base - (size_t)(16 - j) * 1792); }
    f32x4 s0 = {0.f, 0.f, 0.f, 0.f}, s1 = {0.f, 0.f, 0.f, 0.f};
#pragma unroll
    for (int j = 0; j < 16; ++j) { f32x4 a, b; unpack8(prev[j], a, b); const float mk = (16 - j <= w) ? 1.f : 0.f; s0 += a * mk; s1 += b * mk; }
    for (int bt = 0; bt < 4; ++bt) {
        u32x4 cur[16];
#pragma unroll
        for (int j = 0; j < 16; ++j) cur[j] = *(const u32x4*)(base + (size_t)(bt * 16 + j) * 1792);
#pragma unroll
        for (int j = 0; j < 16; ++j) {
            const u32x4 o2 = (j >= 2) ? cur[j >= 2 ? j - 2 : 0] : prev[14 + j < 16 ? 14 + j : 15];
            const u32x4 o4 = (j >= 4) ? cur[j >= 4 ? j - 4 : 0] : prev[12 + j < 16 ? 12 + j : 15];
            const u32x4 o8 = (j >= 8) ? cur[j >= 8 ? j - 8 : 0] : prev[8 + j < 16 ? 8 + j : 15];
            const u32x4 o16 = prev[j];
            u32x4 os;
            os.x = g == 0 ? o2.x : g == 1 ? o4.x : g == 2 ? o8.x : o16.x; os.y = g == 0 ? o2.y : g == 1 ? o4.y : g == 2 ? o8.y : o16.y;
            os.z = g == 0 ? o2.z : g == 1 ? o4.z : g == 2 ? o8.z : o16.z; os.w = g == 0 ? o2.w : g == 1 ? o4.w : g == 2 ? o8.w : o16.w;
            f32x4 c0, c1, q0, q1; unpack8(cur[j], c0, c1); unpack8(os, q0, q1);
            s0 += c0 - q0; s1 += c1 - q1;
            const int t = t0 + bt * 16 + j; const int cnt = (t + 1) < w ? (t + 1) : w; const float inv = __builtin_amdgcn_rcpf((float)cnt);
            *(u32x4*)(ob + (size_t)(bt * 16 + j) * 2048) = pack8(s0 * inv - c0, s1 * inv - c1);
        }
#pragma unroll
        for (int j = 0; j < 16; ++j) prev[j] = cur[j];
    }
}
__device__ __forceinline__ void p2_conv_block(const bf16_t* src, int m0, bool active, const float* wgt, int wp, const float* bias, bool silu, bf16_t* out, int opitch) {
    if (!active) return;
    const int t0 = m0 & (SEQ - 1);
    const bf16_t* base = src + (size_t)m0 * 1792; bf16_t* ob = out + (size_t)m0 * opitch;
    f32x4 w0[4], w1[4];
#pragma unroll
    for (int k = 0; k < 4; ++k) { w0[k] = *(const f32x4*)(wgt + k * wp); w1[k] = *(const f32x4*)(wgt + k * wp + 4); }
    const f32x4 b0 = *(const f32x4*)bias, b1 = *(const f32x4*)(bias + 4);
    u32x4 p3[3];
#pragma unroll
    for (int j = 0; j < 3; ++j) { p3[j] = (u32x4){0u, 0u, 0u, 0u}; if (t0 > 0) p3[j] = *(const u32x4*)(base - (size_t)(3 - j) * 1792); }
    for (int bt = 0; bt < 4; ++bt) {
        u32x4 cur[16];
#pragma unroll
        for (int j = 0; j < 16; ++j) cur[j] = *(const u32x4*)(base + (size_t)(bt * 16 + j) * 1792);
#pragma unroll
        for (int j = 0; j < 16; ++j) {
            f32x4 a0 = b0, a1 = b1;
#pragma unroll
            for (int k = 0; k < 4; ++k) { const int jj = j - 3 + k; const u32x4 rw = (jj >= 0) ? cur[jj >= 0 ? jj : 0] : p3[jj < 0 ? 3 + jj : 0];
                f32x4 x0, x1; unpack8(rw, x0, x1); a0 += x0 * w0[k]; a1 += x1 * w1[k]; }
            if (silu) {
#pragma unroll
                for (int e = 0; e < 4; ++e) { a0[e] = a0[e] * sigmoidf_(a0[e]); a1[e] = a1[e] * sigmoidf_(a1[e]); } }
            *(u32x4*)(ob + (size_t)(bt * 16 + j) * opitch) = pack8(a0, a1);
        }
        p3[0] = cur[13]; p3[1] = cur[14]; p3[2] = cur[15];
    }
}
__device__ __forceinline__ void p2_prep(PP P, int l, unsigned char* ws, int gw, int ngw, int tid_) {
    asm volatile("" : "+v"(tid_)); const int lane = tid_ & 63;
    const bf16_t* UA = (const bf16_t*)(ws + B_UA); const bf16_t* UB = (const bf16_t*)(ws + B_UB);
    bf16_t* Y = (bf16_t*)(ws + WS_Y); bf16_t* BC = (bf16_t*)(ws + B_BC); bf16_t* KR = (bf16_t*)(ws + B_KR);
    float* RSQ = (float*)(ws + WS_RSQ); float* RSKV = (float*)(ws + WS_RSKV); float* DTF = (float*)(ws + WS_DTF); const f32x2* CS = (const f32x2*)(ws + WS_CS);
    const float* scw = P->in[11] + l * 4 * 768; const float* scb = P->in[12] + l * 768; const float* dtb = P->in[13] + l * 8;
    const float* lcw = P->in[17] + l * 4 * 512; const float* lcb = P->in[18] + l * 512;
    for (int mb = gw; mb < M; mb += 4 * ngw) {
        u32x4 q4[4], k4[4]; float x1[4], x2[4], dtr[4]; f32x2 cc[4];
#pragma unroll
        for (int u = 0; u < 4; ++u) { const int m = M - 1 - (mb + u * ngw); const bf16_t* ua = UA + (size_t)m * 768;
            q4[u] = (u32x4){0u, 0u, 0u, 0u}; k4[u] = (u32x4){0u, 0u, 0u, 0u}; x1[u] = 0.f; x2[u] = 0.f; dtr[u] = 0.f; cc[u] = (f32x2){0.f, 0.f};
            if (lane < 48) q4[u] = *(const u32x4*)(ua + lane * 8);
            if (lane < 32) k4[u] = *(const u32x4*)(ua + 384 + lane * 8);
            if (lane < 16) { x1[u] = bf2f(ua[640 + lane]); x2[u] = bf2f(ua[656 + lane]); cc[u] = CS[(size_t)m * 16 + lane]; }
            if (lane < 8) dtr[u] = bf2f(ua[672 + lane]); }
#pragma unroll
        for (int u = 0; u < 4; ++u) { const int m = M - 1 - (mb + u * ngw);
            f32x4 a, b; unpack8(q4[u], a, b); float s = (a[0]*a[0]+a[1]*a[1])+(a[2]*a[2]+a[3]*a[3])+(b[0]*b[0]+b[1]*b[1])+(b[2]*b[2]+b[3]*b[3]);
            unpack8(k4[u], a, b); float s2 = (a[0]*a[0]+a[1]*a[1])+(a[2]*a[2]+a[3]*a[3])+(b[0]*b[0]+b[1]*b[1])+(b[2]*b[2]+b[3]*b[3]);
            s = wave_sum(s); s2 = wave_sum(s2);
            if (lane == 0) { RSQ[m] = rsqrtf(s * (1.f / 384.f) + EPS); RSKV[m] = rsqrtf(s2 * (1.f / 256.f) + EPS); }
            if (lane < 16) *(unsigned*)(KR + (size_t)m * 32 + 2 * lane) = cvt_pk_bf16(x1[u] * cc[u][0] - x2[u] * cc[u][1], x2[u] * cc[u][0] + x1[u] * cc[u][1]);
            if (lane < 8) { const float v = dtr[u] + dtb[lane]; DTF[(size_t)m * 8 + lane] = v > 20.f ? v : log1pf(__expf(v)); } }
    }
    for (int wt = gw; wt < 2048; wt += ngw) {
        const int rb = 511 - (wt >> 2), cgp = wt & 3, m0 = rb * 64;
        if (cgp == 0) p2_pool_block(UB, Y, m0, lane);
        else if (cgp == 1) p2_conv_block(UB + 512 + 8 * lane, m0, true, scw + 8 * lane, 768, scb + 8 * lane, true, Y + 1024 + 8 * lane, 2048);
        else if (cgp == 2) p2_conv_block(UB + 1024 + 8 * (lane & 31), m0, lane < 32, scw + 512 + 8 * (lane & 31), 768, scb + 512 + 8 * (lane & 31), true, BC + 8 * (lane & 31), 256);
        else p2_conv_block(UB + 1280 + 8 * lane, m0, true, lcw + 8 * lane, 512, lcb + 8 * lane, false, Y + 1536 + 8 * lane, 2048);
    }
}

__device__ __forceinline__ void rstd_c_rows(unsigned char* ws, int gw, int ngw, int tid_) {
    asm volatile("" : "+v"(tid_)); const int lane = tid_ & 63;
    const bf16_t* Y = (const bf16_t*)(ws + WS_Y); float* RSC = (float*)(ws + WS_RSC);
    for (int m = gw; m < M; m += ngw) { f32x4 a, b; unpack8(*(const u32x4*)(Y + (size_t)m * 2048 + 1024 + lane * 8), a, b);
        float s = (a[0]*a[0]+a[1]*a[1])+(a[2]*a[2]+a[3]*a[3])+(b[0]*b[0]+b[1]*b[1])+(b[2]*b[2]+b[3]*b[3]); s = wave_sum(s);
        if (lane == 0) RSC[m] = rsqrtf(s * (1.f / 512.f) + EPS); }
}
__device__ __forceinline__ void conv_p(PP P, int l, bf16_t* PB, int tid_, int bid_, int ngt) {
    asm volatile("" : "+v"(tid_)); const int gt = bid_ * 512 + tid_;
    const f32x4* src = (const f32x4*)(P->in[1] + (size_t)l * M * 256);
    for (long c = gt; c < (long)M * 256 / 8; c += 4L * ngt) {
        f32x4 a[4], b[4];
#pragma unroll
        for (int u = 0; u < 4; ++u) { const long cc = c + (long)u * ngt; a[u] = src[2 * cc]; b[u] = src[2 * cc + 1]; }
#pragma unroll
        for (int u = 0; u < 4; ++u) { const long cc = c + (long)u * ngt; *(u32x4*)(PB + cc * 8) = pack8(a[u], b[u]); }
    }
}
__device__ __forceinline__ void final_norm(PP P, const float* ssq, int gw, int ngw, int tid_) {
    asm volatile("" : "+v"(tid_)); const int lane = tid_ & 63;
    const f32x4* gf = (const f32x4*)P->in[32];
    f32x4 g4[4];
#pragma unroll
    for (int j = 0; j < 4; ++j) g4[j] = gf[64 * j + lane];
    f32x4 v[4][4], nx[4][4]; float r[4], nr[4];
#pragma unroll
    for (int u = 0; u < 4; ++u) { const int m = gw + u * ngw; r[u] = 0.f; if (m < M) { const f32x4* xr = (const f32x4*)(P->out + (size_t)m * D) + lane; r[u] = rstd16(ssq, m);
#pragma unroll
        for (int j = 0; j < 4; ++j) v[u][j] = xr[64 * j]; } }
    for (int mb = gw; mb < M; mb += 4 * ngw) {
#pragma unroll
        for (int u = 0; u < 4; ++u) { const int m = mb + 4 * ngw + u * ngw; nr[u] = 0.f; if (m < M) { const f32x4* xr = (const f32x4*)(P->out + (size_t)m * D) + lane; nr[u] = rstd16(ssq, m);
#pragma unroll
            for (int j = 0; j < 4; ++j) nx[u][j] = xr[64 * j]; } }
#pragma unroll
        for (int u = 0; u < 4; ++u) { const int m = mb + u * ngw;
            if (m < M) { f32x4* xr = (f32x4*)(P->out + (size_t)m * D) + lane;
#pragma unroll
                for (int j = 0; j < 4; ++j) xr[64 * j] = v[u][j] * r[u] * g4[j]; } }
#pragma unroll
        for (int u = 0; u < 4; ++u) { r[u] = nr[u];
#pragma unroll
            for (int j = 0; j < 4; ++j) v[u][j] = nx[u][j]; }
    }
}


typedef float f32x16 __attribute__((ext_vector_type(16)));
__device__ __forceinline__ unsigned pk2c(float lo, float hi) { f32x2 v = {lo, hi}; bf16x2_t b = __builtin_convertvector(v, bf16x2_t); return __builtin_bit_cast(unsigned, b); }
constexpr int AT_KP = 208, AT_VP = 192, AT_KB = 64 * AT_KP, AT_VB = 64 * AT_VP, AT_BUF = AT_KB + AT_VB;
typedef short v4i16_t __attribute__((ext_vector_type(4)));
__device__ __forceinline__ void attn_unit(unsigned char* ws, LAS unsigned char* lds, int b, int h, int qb, int wave, int tid_, bf16_t* Obase, int opitch) {
    asm volatile("" : "+v"(tid_));
    const int lane = tid_ & 63, r = lane & 31, hh = lane >> 5;
    bf16_t* Y = (bf16_t*)(ws + WS_Y); const bf16_t* QR = (const bf16_t*)(ws + B_QR); const bf16_t* KV = (const bf16_t*)(ws + B_KV); const bf16_t* KR = (const bf16_t*)(ws + B_KR);
    const int q0 = qb * 256, qw0 = q0 + wave * 32;
    const size_t mrow = (size_t)b * SEQ + qw0 + r;
    bf16x8 qf[6];
#pragma unroll
    for (int ks = 0; ks < 4; ++ks) qf[ks] = *(const bf16x8*)(Y + mrow * 2048 + h * 64 + 16 * ks + 8 * hh);
#pragma unroll
    for (int ks = 0; ks < 2; ++ks) qf[4 + ks] = *(const bf16x8*)(QR + mrow * 256 + h * 32 + 16 * ks + 8 * hh);
    f32x16 o0, o1;
#pragma unroll
    for (int i = 0; i < 16; ++i) { o0[i] = 0.f; o1[i] = 0.f; }
    float mx = -1e30f, lsum = 0.f;
    const int nkt = (q0 + 256) / 64;
    const int skv = tid_ >> 3, sc = tid_ & 7;
    const int rkv = tid_ >> 2, rc = tid_ & 3;
    const bf16_t* gk = KV + ((size_t)b * SEQ + skv) * 1024 + h * 64 + sc * 8;
    const bf16_t* gv = gk + 512;
    const bf16_t* gr = KR + ((size_t)b * SEQ + rkv) * 32 + rc * 8;
    u32x4 rk, rv, rr;
    rk = *(const u32x4*)gk; rv = *(const u32x4*)gv; if (tid_ < 256) rr = *(const u32x4*)gr;
    __syncthreads();
    {
        LAS unsigned char* kb = lds; LAS unsigned char* vb = lds + AT_KB;
        *(LAS u32x4*)(kb + skv * AT_KP + sc * 16) = rk;
        if (tid_ < 256) *(LAS u32x4*)(kb + rkv * AT_KP + 128 + rc * 16) = rr;
        *(LAS u32x4*)(vb + skv * AT_VP + sc * 16) = rv;
    }
    __syncthreads();
    for (int kt = 0; kt < nkt; ++kt) {
        const bool more = (kt + 1 < nkt);
        if (more) { const size_t adv = (size_t)(kt + 1) * 64;
            rk = *(const u32x4*)(gk + adv * 1024); rv = *(const u32x4*)(gv + adv * 1024); if (tid_ < 256) rr = *(const u32x4*)(gr + adv * 32); }
        LAS unsigned char* kb = lds + (kt & 1) * AT_BUF; LAS unsigned char* vb = kb + AT_KB;
        const int kv0 = kt * 64;
        if (kv0 <= qw0 + 31) {
            __builtin_amdgcn_iglp_opt(0);
            f32x16 p0, p1;
#pragma unroll
            for (int i = 0; i < 16; ++i) { p0[i] = 0.f; p1[i] = 0.f; }
            bf16x8 kf0[6], kf1[6];
#pragma unroll
            for (int ks = 0; ks < 6; ++ks) {
                kf0[ks] = *(const LAS bf16x8*)(kb + r * AT_KP + (16 * ks + 8 * hh) * 2);
                kf1[ks] = *(const LAS bf16x8*)(kb + (32 + r) * AT_KP + (16 * ks + 8 * hh) * 2);
            }
#pragma unroll
            for (int ks = 0; ks < 6; ++ks) {
                p0 = __builtin_amdgcn_mfma_f32_32x32x16_bf16(kf0[ks], qf[ks], p0, 0, 0, 0);
                p1 = __builtin_amdgcn_mfma_f32_32x32x16_bf16(kf1[ks], qf[ks], p1, 0, 0, 0);
            }
            if (kv0 + 63 > qw0) {
                const int qg = qw0 + r;
#pragma unroll
                for (int i = 0; i < 16; ++i) { const int kvl = kv0 + (i & 3) + 8 * (i >> 2) + 4 * hh; if (kvl > qg) p0[i] = -1e30f; if (kvl + 32 > qg) p1[i] = -1e30f; }
            }
            float tm = fmaxf(p0[0], p1[0]);
#pragma unroll
            for (int i = 1; i < 16; ++i) tm = fmaxf(tm, fmaxf(p0[i], p1[i]));
            tm = xhalf_max(tm);
            if (__any(tm > mx + 8.f)) {
                const float mn = fmaxf(mx, tm);
                const float alpha = __builtin_amdgcn_exp2f(mx - mn);
                mx = mn; lsum *= alpha;
#pragma unroll
                for (int i = 0; i < 16; ++i) { o0[i] *= alpha; o1[i] *= alpha; }
            }
            float ps = 0.f;
#pragma unroll
            for (int i = 0; i < 16; ++i) { p0[i] = __builtin_amdgcn_exp2f(p0[i] - mx); p1[i] = __builtin_amdgcn_exp2f(p1[i] - mx); ps += p0[i] + p1[i]; }
            lsum += ps;
            u32x4 vw0[4], vw1[4];
            {
                const int li = lane & 15, tq = li >> 2, tp = li & 3, dblk = (lane >> 4) & 1;
                const LAS unsigned char* vbase = vb + (4 * hh + tq) * AT_VP + (16 * dblk + 4 * tp) * 2;
#pragma unroll
                for (int f = 0; f < 4; ++f) {
                    const v4i16_t lo0 = __builtin_amdgcn_ds_read_tr16_b64_v4i16((LAS v4i16_t*)(vbase + (16 * f) * AT_VP));
                    const v4i16_t hi0 = __builtin_amdgcn_ds_read_tr16_b64_v4i16((LAS v4i16_t*)(vbase + (16 * f + 8) * AT_VP));
                    const v4i16_t lo1 = __builtin_amdgcn_ds_read_tr16_b64_v4i16((LAS v4i16_t*)(vbase + (16 * f) * AT_VP + 64));
                    const v4i16_t hi1 = __builtin_amdgcn_ds_read_tr16_b64_v4i16((LAS v4i16_t*)(vbase + (16 * f + 8) * AT_VP + 64));
                    const u32x2 a = __builtin_bit_cast(u32x2, lo0), b2 = __builtin_bit_cast(u32x2, hi0), c = __builtin_bit_cast(u32x2, lo1), d2 = __builtin_bit_cast(u32x2, hi1);
                    vw0[f].x = a.x; vw0[f].y = a.y; vw0[f].z = b2.x; vw0[f].w = b2.y; vw1[f].x = c.x; vw1[f].y = c.y; vw1[f].z = d2.x; vw1[f].w = d2.y;
                }
            }
            u32x4 pw[4];
#pragma unroll
            for (int s2 = 0; s2 < 2; ++s2) {
                pw[s2].x = pk2c(p0[8 * s2 + 0], p0[8 * s2 + 1]); pw[s2].y = pk2c(p0[8 * s2 + 2], p0[8 * s2 + 3]); pw[s2].z = pk2c(p0[8 * s2 + 4], p0[8 * s2 + 5]); pw[s2].w = pk2c(p0[8 * s2 + 6], p0[8 * s2 + 7]);
                pw[2 + s2].x = pk2c(p1[8 * s2 + 0], p1[8 * s2 + 1]); pw[2 + s2].y = pk2c(p1[8 * s2 + 2], p1[8 * s2 + 3]); pw[2 + s2].z = pk2c(p1[8 * s2 + 4], p1[8 * s2 + 5]); pw[2 + s2].w = pk2c(p1[8 * s2 + 6], p1[8 * s2 + 7]); }
#pragma unroll
            for (int f = 0; f < 4; ++f) {
                const bf16x8 pf = __builtin_bit_cast(bf16x8, pw[f]);
                o0 = __builtin_amdgcn_mfma_f32_32x32x16_bf16(__builtin_bit_cast(bf16x8, vw0[f]), pf, o0, 0, 0, 0);
                o1 = __builtin_amdgcn_mfma_f32_32x32x16_bf16(__builtin_bit_cast(bf16x8, vw1[f]), pf, o1, 0, 0, 0);
            }
        }
        if (more) {
            LAS unsigned char* kb2 = lds + ((kt + 1) & 1) * AT_BUF; LAS unsigned char* vb2 = kb2 + AT_KB;
            *(LAS u32x4*)(kb2 + skv * AT_KP + sc * 16) = rk;
            if (tid_ < 256) *(LAS u32x4*)(kb2 + rkv * AT_KP + 128 + rc * 16) = rr;
            *(LAS u32x4*)(vb2 + skv * AT_VP + sc * 16) = rv;
        }
        __syncthreads();
    }
    lsum = xhalf_sum(lsum);
    const float inv = 1.f / lsum;
    bf16_t* orow = Obase + mrow * opitch + h * 64;
#pragma unroll
    for (int g = 0; g < 4; ++g) {
        u32x2 w0, w1;
        w0.x = pk2c(o0[4 * g] * inv, o0[4 * g + 1] * inv); w0.y = pk2c(o0[4 * g + 2] * inv, o0[4 * g + 3] * inv);
        w1.x = pk2c(o1[4 * g] * inv, o1[4 * g + 1] * inv); w1.y = pk2c(o1[4 * g + 2] * inv, o1[4 * g + 3] * inv);
        *(u32x2*)(orow + 8 * g + 4 * hh) = w0;
        *(u32x2*)(orow + 32 + 8 * g + 4 * hh) = w1;
    }
}
__device__ __forceinline__ void attn_phase(unsigned char* ws, LAS unsigned char* lds, unsigned* ctr, int wave, int tid_, bf16_t* Obase, int opitch) {
    LAS unsigned* slot = (LAS unsigned*)(lds + 2 * AT_BUF + 64);
    for (;;) {
        if (tid_ == 0) *slot = atomicAdd(ctr, 1u);
        __syncthreads();
        const unsigned u = *slot;
        if (u >= 1024u) break;
        const int qb = 15 - (int)(u >> 6), bh = (int)(u & 63u);
        attn_unit(ws, lds, bh >> 3, bh & 7, qb, wave, tid_, Obase, opitch);
    }
}

constexpr int SD_CS = 0, SD_BS = 18432, SD_XT = 36864, SD_BDT = 62464, SD_MM = 79872, SD_F = 131072;
constexpr int SD_CP = 144, SD_XP = 400, SD_DP = 272, SD_MP = 400;
#define MFMA32(a, b, c) __builtin_amdgcn_mfma_f32_32x32x16_bf16((a), (b), (c), 0, 0, 0)
__device__ __forceinline__ void ssd_mfma(PP P, int l, unsigned char* ws, LAS unsigned char* lds, int unit, int wave, int tid_) {
    asm volatile("" : "+v"(tid_));
    const int lane = tid_ & 63, r = lane & 31, hh = lane >> 5;
    const int b = unit >> 3, h = unit & 7, g = h >> 2;
    bf16_t* Y = (bf16_t*)(ws + WS_Y); const bf16_t* BC = (const bf16_t*)(ws + B_BC); const bf16_t* U1 = (const bf16_t*)(ws + B_U1); const float* DTF = (const float*)(ws + WS_DTF);
    const float Ah = -__expf(P->in[14][l * 8 + h]); const float Dh = P->in[15][l * 8 + h];
    LAS float* F0 = (LAS float*)(lds + SD_F);
    for (int idx = tid_; idx < 64 * 32; idx += 512) { const int p = idx >> 5, c = idx & 31; *(LAS unsigned*)(lds + SD_XT + p * SD_XP + 256 + c * 4) = 0u; }
    f32x16 S;
#pragma unroll
    for (int i = 0; i < 16; ++i) S[i] = 0.f;
    const int l_ = tid_ >> 2, qd = tid_ & 3;
    const size_t mb0 = (size_t)b * SEQ;
    u32x4 c0, c1, b0, b1, x0, x1;
#define SSD_LOAD(ck_) do { const size_t m_ = mb0 + (size_t)(ck_) * 128 + l_; \
        c0 = *(const u32x4*)(BC + m_ * 256 + 128 + g * 64 + 16 * qd); c1 = *(const u32x4*)(BC + m_ * 256 + 128 + g * 64 + 16 * qd + 8); \
        b0 = *(const u32x4*)(BC + m_ * 256 + g * 64 + 16 * qd); b1 = *(const u32x4*)(BC + m_ * 256 + g * 64 + 16 * qd + 8); \
        x0 = *(const u32x4*)(Y + m_ * 2048 + 1024 + h * 64 + 16 * qd); x1 = *(const u32x4*)(Y + m_ * 2048 + 1024 + h * 64 + 16 * qd + 8); } while (0)
#define SSD_FCALC(ck_) do { LAS float* F_ = F0 + ((ck_) & 1) * 512; const size_t m_ = mb0 + (size_t)(ck_) * 128; \
        const float d0 = DTF[(m_ + lane) * 8 + h], d1 = DTF[(m_ + 64 + lane) * 8 + h]; float s0 = d0 * Ah, s1 = d1 * Ah; \
        _Pragma("unroll") for (int o = 1; o < 64; o <<= 1) { const float t0 = __shfl_up(s0, o), t1 = __shfl_up(s1, o); if (lane >= o) { s0 += t0; s1 += t1; } } \
        const float tot0 = __shfl(s0, 63); s1 += tot0; const float tot = __shfl(s1, 63); \
        F_[lane] = s0; F_[64 + lane] = s1; F_[128 + lane] = __expf(s0); F_[192 + lane] = __expf(s1); \
        F_[256 + lane] = __expf(tot - s0); F_[320 + lane] = __expf(tot - s1); F_[384 + lane] = d0; F_[448 + lane] = d1; } while (0)
#define SSD_STAGE(ck_) do { const LAS float* F_ = F0 + ((ck_) & 1) * 512; const float ea = F_[128 + l_], dec = F_[256 + l_], dt = F_[384 + l_]; \
        *(LAS u32x4*)(lds + SD_CS + l_ * SD_CP + qd * 32) = c0; *(LAS u32x4*)(lds + SD_CS + l_ * SD_CP + qd * 32 + 16) = c1; \
        *(LAS u32x4*)(lds + SD_BS + l_ * SD_CP + qd * 32) = b0; *(LAS u32x4*)(lds + SD_BS + l_ * SD_CP + qd * 32 + 16) = b1; \
        f32x4 ca, cb, cc, cd; unpack8(c0, ca, cb); unpack8(c1, cc, cd); \
        *(LAS u32x4*)(lds + SD_MM + l_ * SD_MP + 256 + qd * 32) = pack8(ca * ea, cb * ea); *(LAS u32x4*)(lds + SD_MM + l_ * SD_MP + 256 + qd * 32 + 16) = pack8(cc * ea, cd * ea); \
        f32x4 ba, bb, bc, bd; unpack8(b0, ba, bb); unpack8(b1, bc, bd); f32x4 xa, xb, xc, xd; unpack8(x0, xa, xb); unpack8(x1, xc, xd); \
        LAS unsigned short* bdt = (LAS unsigned short*)(lds + SD_BDT + (16 * qd) * SD_DP + l_ * 2); LAS unsigned short* xt = (LAS unsigned short*)(lds + SD_XT + (16 * qd) * SD_XP + l_ * 2); \
        _Pragma("unroll") for (int e = 0; e < 4; ++e) { \
            bdt[(e) * (SD_DP / 2)] = f2bf(ba[e] * dec); bdt[(4 + e) * (SD_DP / 2)] = f2bf(bb[e] * dec); bdt[(8 + e) * (SD_DP / 2)] = f2bf(bc[e] * dec); bdt[(12 + e) * (SD_DP / 2)] = f2bf(bd[e] * dec); \
            xt[(e) * (SD_XP / 2)] = f2bf(xa[e] * dt); xt[(4 + e) * (SD_XP / 2)] = f2bf(xb[e] * dt); xt[(8 + e) * (SD_XP / 2)] = f2bf(xc[e] * dt); xt[(12 + e) * (SD_XP / 2)] = f2bf(xd[e] * dt); } } while (0)
    SSD_LOAD(0);
    if (wave == 0) SSD_FCALC(0);
    __syncthreads();
    SSD_STAGE(0);
    SSD_LOAD(1);
    if (wave == 7) SSD_FCALC(1);
    __syncthreads();
    for (int ck = 0; ck < 32; ++ck) {
        const size_t m0 = mb0 + (size_t)ck * 128;
        const LAS float* F = F0 + (ck & 1) * 512;
        {
            const int lt = wave & 3;
#pragma unroll
            for (int sti = 0; sti < 2; ++sti) {
                const int st = 2 * (wave >> 2) + sti;
                if (st <= lt) {
                    f32x16 ga;
#pragma unroll
                    for (int i = 0; i < 16; ++i) ga[i] = 0.f;
#pragma unroll
                    for (int ks = 0; ks < 4; ++ks) {
                        const bf16x8 a = *(const LAS bf16x8*)(lds + SD_CS + (32 * lt + r) * SD_CP + 32 * ks + 16 * hh);
                        const bf16x8 bq = *(const LAS bf16x8*)(lds + SD_BS + (32 * st + r) * SD_CP + 32 * ks + 16 * hh);
                        ga = MFMA32(a, bq, ga);
                    }
                    const int sg = 32 * st + r; const float acs_s = F[sg];
#pragma unroll
                    for (int i = 0; i < 16; ++i) { const int lg = 32 * lt + (i & 3) + 8 * (i >> 2) + 4 * hh;
                        const float v = (sg <= lg) ? ga[i] * __expf(F[lg] - acs_s) : 0.f;
                        *(LAS unsigned short*)(lds + SD_MM + lg * SD_MP + sg * 2) = f2bf(v); }
                }
            }
        }
        __syncthreads();
        {
            const int lt = wave >> 1, pt = wave & 1;
            const size_t m = m0 + 32 * lt + r;
            bf16_t* yrow = Y + m * 2048 + 1024 + h * 64 + 32 * pt + 4 * hh; const bf16_t* zrow = U1 + m * 1024 + h * 64 + 32 * pt + 4 * hh;
            u32x2 xs4[4], z4[4]; float ssl = 0.f;
#pragma unroll
            for (int g4 = 0; g4 < 4; ++g4) { xs4[g4] = *(const u32x2*)(yrow + 8 * g4); z4[g4] = *(const u32x2*)(zrow + 8 * g4); }
            f32x16 ya;
#pragma unroll
            for (int i = 0; i < 16; ++i) ya[i] = 0.f;
            const LAS unsigned char* bp = lds + SD_MM + (32 * lt + r) * SD_MP + 16 * hh;
            const LAS unsigned char* ap = lds + SD_XT + (32 * pt + r) * SD_XP + 16 * hh;
            const int nks = 2 * (lt + 1);
            for (int ks = 0; ks < nks; ++ks) ya = MFMA32(*(const LAS bf16x8*)(ap + 32 * ks), *(const LAS bf16x8*)(bp + 32 * ks), ya);
#pragma unroll
            for (int ks = 8; ks < 12; ++ks) ya = MFMA32(*(const LAS bf16x8*)(ap + 32 * ks), *(const LAS bf16x8*)(bp + 32 * ks), ya);
#pragma unroll
            for (int g4 = 0; g4 < 4; ++g4) {
                const float xv[4] = {bflo(xs4[g4].x), bfhi(xs4[g4].x), bflo(xs4[g4].y), bfhi(xs4[g4].y)};
                const float zv[4] = {bflo(z4[g4].x), bfhi(z4[g4].x), bflo(z4[g4].y), bfhi(z4[g4].y)};
                float o[4];
#pragma unroll
                for (int e = 0; e < 4; ++e) o[e] = (ya[4 * g4 + e] + xv[e] * Dh) * (zv[e] * sigmoidf_(zv[e]));
                u32x2 w; w.x = cvt_pk_bf16(o[0], o[1]); w.y = cvt_pk_bf16(o[2], o[3]);
                *(u32x2*)(yrow + 8 * g4) = w;
                const float q0 = bflo(w.x), q1 = bfhi(w.x), q2 = bflo(w.y), q3 = bfhi(w.y);
                ssl += (q0 * q0 + q1 * q1) + (q2 * q2 + q3 * q3);
            }
            ssl = xhalf_sum(ssl);
            if (hh == 0) ((float*)(ws + WS_SSQC))[m * 16 + h * 2 + pt] = ssl;
        }
        const int spt = wave >> 1, snt = wave & 1;
        if (wave < 4) {
            const float et = F[255];
#pragma unroll
            for (int i = 0; i < 16; ++i) S[i] *= et;
#pragma unroll
            for (int ks = 0; ks < 8; ++ks) {
                const bf16x8 a = *(const LAS bf16x8*)(lds + SD_XT + (32 * spt + r) * SD_XP + 32 * ks + 16 * hh);
                const bf16x8 bq = *(const LAS bf16x8*)(lds + SD_BDT + (32 * snt + r) * SD_DP + 32 * ks + 16 * hh);
                S = MFMA32(a, bq, S);
            }
        }
        __syncthreads();
        if (wave < 4) {
#pragma unroll
            for (int i = 0; i < 16; ++i) { const int pgl = 32 * spt + (i & 3) + 8 * (i >> 2) + 4 * hh;
                *(LAS unsigned short*)(lds + SD_XT + pgl * SD_XP + (128 + 32 * snt + r) * 2) = f2bf(S[i]); }
        }
        if (ck + 1 < 32) {
            SSD_STAGE(ck + 1);
            if (ck + 2 < 32) { SSD_LOAD(ck + 2); if (wave == 7) SSD_FCALC(ck + 2); }
        }
        __syncthreads();
    }
#undef SSD_LOAD
#undef SSD_FCALC
#undef SSD_STAGE
}

__device__ __forceinline__ void attn_naive(unsigned char* ws, int gw, int tid_) {
    asm volatile("" : "+v"(tid_)); const int lane = tid_ & 63;
    const bf16_t* Y = (const bf16_t*)(ws + WS_Y); const bf16_t* QR = (const bf16_t*)(ws + B_QR); const bf16_t* KV = (const bf16_t*)(ws + B_KV); const bf16_t* KR = (const bf16_t*)(ws + B_KR);
    bf16_t* YO = (bf16_t*)(ws + WS_Y);
    const int bh = gw >> 5, j = gw & 31, b = bh >> 3, h = bh & 7;
    for (int pass = 0; pass < 2; ++pass) {
        const int qb = pass ? 63 - j : j;
        const int t = qb * 64 + lane; const size_t m = (size_t)b * SEQ + t;
        unsigned q[48];
#pragma unroll
        for (int i = 0; i < 8; ++i) { const u32x4 w = *(const u32x4*)(Y + m * 2048 + h * 64 + i * 8); q[4 * i] = w.x; q[4 * i + 1] = w.y; q[4 * i + 2] = w.z; q[4 * i + 3] = w.w; }
#pragma unroll
        for (int i = 0; i < 4; ++i) { const u32x4 w = *(const u32x4*)(QR + m * 256 + h * 32 + i * 8); q[32 + 4 * i] = w.x; q[33 + 4 * i] = w.y; q[34 + 4 * i] = w.z; q[35 + 4 * i] = w.w; }
        float acc[64];
#pragma unroll
        for (int d = 0; d < 64; ++d) acc[d] = 0.f;
        float mx = -1e30f, lsum = 0.f;
        const int kend = qb * 64 + 64;
        for (int kv = 0; kv < kend; ++kv) {
            const size_t mk = (size_t)b * SEQ + kv;
            const u32x4* kn = (const u32x4*)(KV + mk * 1024 + h * 64); const u32x4* kr = (const u32x4*)(KR + mk * 32); const u32x4* vv = (const u32x4*)(KV + mk * 1024 + 512 + h * 64);
            float s0 = 0.f, s1 = 0.f;
#pragma unroll
            for (int i = 0; i < 8; ++i) { const u32x4 w = kn[i];
                s0 = dot2x(q[4 * i], w.x, s0);
                s1 = dot2x(q[4 * i + 1], w.y, s1);
                s0 = dot2x(q[4 * i + 2], w.z, s0);
                s1 = dot2x(q[4 * i + 3], w.w, s1); }
#pragma unroll
            for (int i = 0; i < 4; ++i) { const u32x4 w = kr[i];
                s0 = dot2x(q[32 + 4 * i], w.x, s0);
                s1 = dot2x(q[33 + 4 * i], w.y, s1);
                s0 = dot2x(q[34 + 4 * i], w.z, s0);
                s1 = dot2x(q[35 + 4 * i], w.w, s1); }
            float s = s0 + s1;
            if (kv > t) s = -1e30f;
            const float mn = fmaxf(mx, s);
            const float alpha = exp2f(mx - mn), p = (kv > t) ? 0.f : exp2f(s - mn);
            mx = mn; lsum = lsum * alpha + p;
#pragma unroll
            for (int i = 0; i < 8; ++i) { const u32x4 w = vv[i];
                acc[8 * i + 0] = acc[8 * i + 0] * alpha + p * bflo(w.x); acc[8 * i + 1] = acc[8 * i + 1] * alpha + p * bfhi(w.x);
                acc[8 * i + 2] = acc[8 * i + 2] * alpha + p * bflo(w.y); acc[8 * i + 3] = acc[8 * i + 3] * alpha + p * bfhi(w.y);
                acc[8 * i + 4] = acc[8 * i + 4] * alpha + p * bflo(w.z); acc[8 * i + 5] = acc[8 * i + 5] * alpha + p * bfhi(w.z);
                acc[8 * i + 6] = acc[8 * i + 6] * alpha + p * bflo(w.w); acc[8 * i + 7] = acc[8 * i + 7] * alpha + p * bfhi(w.w); }
        }
        const float inv = 1.f / lsum;
#pragma unroll
        for (int i = 0; i < 8; ++i) { u32x4 w; w.x = cvt_pk_bf16(acc[8 * i] * inv, acc[8 * i + 1] * inv); w.y = cvt_pk_bf16(acc[8 * i + 2] * inv, acc[8 * i + 3] * inv);
            w.z = cvt_pk_bf16(acc[8 * i + 4] * inv, acc[8 * i + 5] * inv); w.w = cvt_pk_bf16(acc[8 * i + 6] * inv, acc[8 * i + 7] * inv);
            *(u32x4*)(YO + m * 2048 + h * 64 + i * 8) = w; }
    }
}

__device__ __forceinline__ void ssd_naive(PP P, int l, unsigned char* ws, int unit, int wave, int tid_) {
    asm volatile("" : "+v"(tid_)); const int lane = tid_ & 63;
    const int b = unit >> 3, h = unit & 7, g = h >> 2;
    bf16_t* Y = (bf16_t*)(ws + WS_Y); const bf16_t* BC = (const bf16_t*)(ws + B_BC); const bf16_t* U1 = (const bf16_t*)(ws + B_U1); const float* DTF = (const float*)(ws + WS_DTF);
    const float Ah = -__expf(P->in[14][l * 8 + h]); const float Dh = P->in[15][l * 8 + h];
    const int p = wave * 8 + (lane >> 3), no = lane & 7;
    float S[8];
#pragma unroll
    for (int i = 0; i < 8; ++i) S[i] = 0.f;
    for (int t = 0; t < SEQ; ++t) {
        const size_t m = (size_t)b * SEQ + t;
        const float dt = DTF[m * 8 + h]; const float a = __expf(dt * Ah);
        bf16_t* xp = Y + m * 2048 + 1024 + h * 64 + p;
        const float xv = bf2f(*xp); const float xdt = xv * dt;
        f32x4 b0, b1, c0, c1; unpack8(*(const u32x4*)(BC + m * 256 + g * 64 + no * 8), b0, b1); unpack8(*(const u32x4*)(BC + m * 256 + 128 + g * 64 + no * 8), c0, c1);
        float y = 0.f;
#pragma unroll
        for (int i = 0; i < 4; ++i) { S[i] = a * S[i] + xdt * b0[i]; y += S[i] * c0[i]; S[4 + i] = a * S[4 + i] + xdt * b1[i]; y += S[4 + i] * c1[i]; }
        y += __shfl_xor(y, 1); y += __shfl_xor(y, 2); y += __shfl_xor(y, 4);
        const float z = bf2f(U1[m * 1024 + h * 64 + p]);
        y = (y + xv * Dh) * (z * sigmoidf_(z));
        if (no == 0) *xp = f2bf(y);
    }
}

__device__ __forceinline__ float gelu_tanh(float x) { const float u = 0.7978845608028654f * (x + 0.044715f * x * x * x); return x * sigmoidf_(2.f * u); }
__device__ __forceinline__ void lru_scan(unsigned char* ws, int unit, int wave, int tid_, LAS float* sm) {
    asm volatile("" : "+v"(tid_)); const int lane = tid_ & 63;
    const int b = unit >> 3, ch = (unit & 7) * 64 + lane;
    bf16_t* Y = (bf16_t*)(ws + WS_Y); const bf16_t* LA = (const bf16_t*)(ws + B_LA); const bf16_t* U1 = (const bf16_t*)(ws + B_U1);
    const int t0 = wave * 512;
    const size_t m0 = (size_t)b * SEQ + t0;
    const bf16_t* lap = LA + m0 * 512 + ch; bf16_t* up = Y + m0 * 2048 + 1536 + ch; const bf16_t* gp = U1 + m0 * 1024 + 512 + ch;
    float A = 1.f, H = 0.f;
    for (int t = 0; t < 512; t += 16) {
        bf16_t la[16], uu[16];
#pragma unroll
        for (int k = 0; k < 16; ++k) { la[k] = lap[(size_t)(t + k) * 512]; uu[k] = up[(size_t)(t + k) * 2048]; }
#pragma unroll
        for (int k = 0; k < 16; ++k) { const float a = __expf(bf2f(la[k])); H = a * H + bf2f(uu[k]); A *= a; }
    }
    sm[wave * 64 + lane] = A; sm[512 + wave * 64 + lane] = H;
    __syncthreads();
    float hcar = 0.f;
    for (int w = 0; w < wave; ++w) hcar = sm[w * 64 + lane] * hcar + sm[512 + w * 64 + lane];
    for (int t = 0; t < 512; t += 16) {
        bf16_t la[16], uu[16], gg[16];
#pragma unroll
        for (int k = 0; k < 16; ++k) { la[k] = lap[(size_t)(t + k) * 512]; uu[k] = up[(size_t)(t + k) * 2048]; gg[k] = gp[(size_t)(t + k) * 1024]; }
#pragma unroll
        for (int k = 0; k < 16; ++k) { const float a = __expf(bf2f(la[k])); hcar = a * hcar + bf2f(uu[k]); up[(size_t)(t + k) * 2048] = f2bf(bf2f(f2bf(hcar)) * gelu_tanh(bf2f(gg[k]))); }
    }
    __syncthreads();
}


#define RLX_AGENT __ATOMIC_RELAXED, __HIP_MEMORY_SCOPE_AGENT
#define XB_TMO      128
#define XB_XCNT(j)  (256  + 64 * (j))
#define XB_XSUB(j)  (1280 + 64 * (j))
#define XB_XGEN(j)  (2304 + 64 * (j))
#define XB_TOP      3328
#define XB_TOPGEN   3392
#define XCD_BAR_WORDS 3456
#define XB_SPIN_CAP (1u << 18)

__device__ __forceinline__ unsigned xb_ld(unsigned* p)              { return __hip_atomic_load(p, __ATOMIC_RELAXED, __HIP_MEMORY_SCOPE_AGENT); }
__device__ __forceinline__ unsigned xb_add(unsigned* p, unsigned v) { return __hip_atomic_fetch_add(p, v, __ATOMIC_RELAXED, __HIP_MEMORY_SCOPE_AGENT); }
__device__ __forceinline__ unsigned xb_xcc_id() { return (unsigned)__builtin_amdgcn_s_getreg((3 << 11) | 20) & 0xFu; }
#define XB_SPIN(cond, bar) do { unsigned _sp = 0; while (cond) { __builtin_amdgcn_s_sleep(1); \
    if ((++_sp & 255u) == 0u) { if (xb_ld(&(bar)[XB_TMO])) break; if (_sp > XB_SPIN_CAP) { atomicAdd(&(bar)[XB_TMO], 1u); break; } } } } while (0)

struct XcdBarrier {
    unsigned* bar; unsigned x;
    volatile LAS unsigned* st;
};

__device__ __forceinline__ XcdBarrier xcd_barrier_post(unsigned* bar, volatile LAS unsigned* st) {
    XcdBarrier b; b.bar = bar; b.x = xb_xcc_id(); b.st = st;
    if (threadIdx.x == 0) (void)xb_add(&bar[XB_XCNT(b.x)], 1u);
    return b;
}
__device__ __forceinline__ void xcd_barrier_complete(unsigned* bar, unsigned x, unsigned& nloc, unsigned& nx) {
    const unsigned G = gridDim.x * gridDim.y * gridDim.z;
    unsigned sum, cnt, mine, sp = 0u;
    for (;;) {
        sum = 0u; cnt = 0u; mine = 0u;
#pragma unroll
        for (unsigned j = 0; j < 16; ++j) { const unsigned c = xb_ld(&bar[XB_XCNT(j)]); sum += c; cnt += (c > 0u) ? 1u : 0u; mine = (j == x) ? c : mine; }
        if (sum == G) break;
        __builtin_amdgcn_s_sleep(1);
        if ((++sp & 255u) == 0u) { if (xb_ld(&bar[XB_TMO])) break; if (sp > XB_SPIN_CAP) { atomicAdd(&bar[XB_TMO], 1u); break; } }
    }
    nloc = mine > 0u ? mine : 1u; nx = cnt > 0u ? cnt : 1u;
}

__device__ __forceinline__ void xcd_barrier(const XcdBarrier& b) {
    asm volatile("s_waitcnt vmcnt(0)" ::: "memory");
    __syncthreads();
    if (threadIdx.x == 0) {
        unsigned* bar = b.bar;
        __builtin_amdgcn_s_waitcnt(0);
        unsigned nloc = b.st[0], nx = b.st[1];
        if (nloc == 0u) { xcd_barrier_complete(bar, b.x, nloc, nx); b.st[0] = nloc; b.st[1] = nx; }
        const unsigned old = xb_add(&bar[XB_XSUB(b.x)], 1u);
        const unsigned gen = old / nloc;
        if (old + 1u == (gen + 1u) * nloc) {
            __builtin_amdgcn_fence(__ATOMIC_RELEASE, "agent");
            asm volatile("s_waitcnt vmcnt(0)" ::: "memory");
            const unsigned og = xb_add(&bar[XB_TOP], 1u);
            const unsigned tg = og / nx;
            if (og + 1u == (tg + 1u) * nx) xb_add(&bar[XB_TOPGEN], 1u);
            else XB_SPIN(xb_ld(&bar[XB_TOPGEN]) == tg, bar);
            __builtin_amdgcn_fence(__ATOMIC_ACQUIRE, "agent");
            xb_add(&bar[XB_XGEN(b.x)], 1u);
            asm volatile("s_waitcnt vmcnt(0)" ::: "memory");
        } else {
            XB_SPIN(xb_ld(&bar[XB_XGEN(b.x)]) == gen, bar);
            __builtin_amdgcn_fence(__ATOMIC_ACQUIRE, "agent");
            asm volatile("s_waitcnt vmcnt(0)" ::: "memory");
        }
    }
    __syncthreads();
}


constexpr int LDS_BYTES = 147456;
#ifndef GMASK
#define GMASK 0xffffffffu
#endif
__global__ void __launch_bounds__(512, 2) mk_fwd(Params Pk) {
    extern __shared__ __attribute__((aligned(16))) unsigned char lds_raw[];
    LAS unsigned char* lds = (LAS unsigned char*)lds_raw;
    cg::grid_group grid = cg::this_grid();
    const int tid = threadIdx.x, wave = __builtin_amdgcn_readfirstlane(tid >> 6);
    const int G = gridDim.x, bid = blockIdx.x;
    const int gw = bid * 8 + wave, NGW = G * 8, NGT = G * 512;
    PP P = (PP)__builtin_amdgcn_kernarg_segment_ptr();
    unsigned char* ws = (unsigned char*)(__attribute__((address_space(1))) unsigned char*)P->ws;
    { volatile LAS unsigned* st0 = (volatile LAS unsigned*)(lds + 146000); if (tid == 0) { st0[0] = 0u; st0[1] = 0u; } __syncthreads(); }
    XcdBarrier xbar = xcd_barrier_post((unsigned*)P->ws + 4096, (volatile LAS unsigned*)(lds + 146000));
    if (G > 100000) grid.sync();
#define FRESH() do { asm volatile("" : "+s"(P)); { __attribute__((address_space(1))) unsigned char* g_ = (__attribute__((address_space(1))) unsigned char*)P->ws; asm volatile("" : "+s"(g_), "+s"(l)); ws = (unsigned char*)g_; } W = (bf16_t*)(ws + WS_W); XB = (bf16_t*)(ws + WS_XB); Y = (bf16_t*)(ws + WS_Y); } while (0)
#define GSYNC() do { xcd_barrier(xbar); } while (0)
    bf16_t* W = (bf16_t*)(ws + WS_W); bf16_t* XB = (bf16_t*)(ws + WS_XB); bf16_t* Y = (bf16_t*)(ws + WS_Y);
    #define SSQA ((float*)(ws + WS_SSQA))
#define SSQB ((float*)(ws + WS_SSQB))
#define SSQC_ (cur ? SSQB : SSQA)
#define SSQN_ (cur ? SSQA : SSQB)
    int cur = 0;
    using namespace pg8;

    for (int l = 0; l < DEPTH; ++l) {
        FRESH();
        conv_weights(P, l, W, tid, bid, NGT, lds);
        p0_rows(P, l == 0 ? P->in[0] : (const float*)P->out, l == 0, XB, SSQA, (f32x2*)(ws + WS_CS), gw, NGW, tid);
        GSYNC(); FRESH();
        { Gemm g{XB, W + W_IN, M, 3584, 1024, 1024, 0, 0}; StaticOrder S; S.init(M, 3584, G, bid);
          EpiInproj E{(bf16_t*)(ws + B_U1), (bf16_t*)(ws + B_UA), (bf16_t*)(ws + B_UB), lds};
          rstd_prepass(lds, SSQC_, S, tid); if (GMASK & (1u << 0)) gemm_phase(lds, g, S, E); }
        GSYNC(); FRESH();
        p2_prep(P, l, ws, gw, NGW, tid);
        GSYNC(); FRESH();
        { Gemm g{(const bf16_t*)(ws + B_UA), W + W_UQ, M, 768, 384, 768, 0, 0}; StaticOrder S; S.init(M, 768, G, bid);
          EpiQ E{Y, (bf16_t*)(ws + B_QR), (const float*)(ws + WS_RSQ), (const f32x2*)(ws + WS_CS)}; if (GMASK & (1u << 1)) gemm_phase(lds, g, S, E); }
        { Gemm g{(const bf16_t*)(ws + B_UA) + 384, W + W_UKV, M, 1024, 256, 768, 0, 0}; StaticOrder S; S.init(M, 1024, G, (bid + 128) % G);
          EpiRowScale E{(bf16_t*)(ws + B_KV), 1024, (const float*)(ws + WS_RSKV), 0}; if (GMASK & (1u << 2)) gemm_phase(lds, g, S, E); }
        if (G == 256 ? bid >= 128 : true) { Gemm g{Y + 512, W + W_POOL, M, 512, 256, 2048, 256, 0}; StaticOrder S; if (G == 256) S.init(M, 512, 128, bid - 128); else S.init(M, 512, G, bid);
          EpiRowScale E{Y + 512, 2048, nullptr, 0}; if (GMASK & (1u << 3)) gemm_phase(lds, g, S, E); }
        { Gemm g{Y + 1536, W + W_LRU, M, 1024, 128, 2048, 128, 0}; StaticOrder S; S.init(M, 1024, G, bid);
          EpiLru E{Y + 1536, (bf16_t*)(ws + B_LA), P->in[20] + l * 512, P->in[22] + l * 512, P->in[23] + l * 512}; if (GMASK & (1u << 4)) gemm_phase(lds, g, S, E); }
        GSYNC(); FRESH();
#ifdef NAIVE_SSD
        if (bid < 64) ssd_naive(P, l, ws, bid, wave, tid);
#else
        if (bid < 64) ssd_mfma(P, l, ws, lds, bid, wave, tid);
#endif
#ifndef NO_LRU
        if (bid >= 64 && bid < 128) lru_scan(ws, bid - 64, wave, tid, (LAS float*)lds);
#endif
#ifdef NAIVE_ATTN
        if (gw < 2048) attn_naive(ws, gw, tid);
#else
#ifdef PROBE_ATTN
        attn_phase(ws, lds, (unsigned*)ws + 64 + 16 * l + 8, wave, tid, (bf16_t*)(ws + B_UA), 512);
#endif
        attn_phase(ws, lds, (unsigned*)ws + 64 + 16 * l, wave, tid, (bf16_t*)(ws + WS_Y), 2048);
#endif
        GSYNC(); FRESH();
#define TBUF(n) ((bf16_t*)(ws + WS_BIG + (size_t)(n) * 64 * MiB))
#define MB ((bf16_t*)(ws + WS_BIG + 64 * MiB))
        { MergeOrder S; S.base.init(M, 1024, G, bid); EpiMerge E{lds, TBUF(0), MB};
          merge_prepass(lds, SSQC_, (const float*)(ws + WS_SSQC), S, tid);
          if (GMASK & (1u << 5)) gemm_merge_fused(lds, Y, XB, W + W_BR, W + W_G, S, E); }
        GSYNC(); FRESH();
        { Gemm g{MB, W + W_OUT, M, 1024, 1024, 1024, 0, 0}; StaticOrder S; S.init(M, 1024, G, bid);
          EpiRes<0> E{l == 0 ? P->in[0] : P->out, P->out, XB, SSQN_, (const LAS unsigned char*)nullptr, nullptr}; if (GMASK & (1u << 8)) gemm_phase(lds, g, S, E); cur ^= 1; }
        GSYNC(); FRESH();
        conv_p(P, l, (bf16_t*)(ws + Y_PB), tid, bid, NGT);
        { Gemm g{XB, W + W_FF1, M, 4096, 1024, 1024, 0, 0}; StaticOrder S; S.init(M, 4096, G, bid);
          EpiFF1 E{(bf16_t*)(ws + B_H), lds}; rstd_prepass(lds, SSQC_, S, tid); if (GMASK & (1u << 9)) gemm_phase(lds, g, S, E); }
        GSYNC(); FRESH();
        { Gemm g{(const bf16_t*)(ws + B_H), W + W_FF2, M, 1024, 4096, 4096, 0, 0}; StaticOrder S; S.init(M, 1024, G, bid); S.rev = 1;
          EpiRes<0> E{P->out, P->out, XB, SSQN_, (const LAS unsigned char*)nullptr, nullptr}; if (GMASK & (1u << 10)) gemm_phase(lds, g, S, E); cur ^= 1; }
        { Gemm g{(const bf16_t*)(ws + Y_PB), W + W_PLE, M, 1024, 256, 256, 0, 0}; StaticOrder S; S.init(M, 1024, G, bid);
          EpiRowScale E{(bf16_t*)(ws + Y_TP), 1024, nullptr, 0}; if (GMASK & (1u << 11)) gemm_phase(lds, g, S, E); }
        GSYNC(); FRESH();
        { Gemm g{XB, W + W_PG, M, 1024, 1024, 1024, 0, 0}; StaticOrder S; S.init(M, 1024, G, bid);
          EpiRes<1> E{P->out, P->out, XB, SSQN_, lds, (const bf16_t*)(ws + Y_TP)}; rstd_prepass(lds, SSQC_, S, tid); if (GMASK & (1u << 12)) gemm_phase(lds, g, S, E); cur ^= 1; }
        GSYNC(); FRESH();
    }
    final_norm(P, SSQC_, gw, NGW, tid);
}

extern "C" void kernel_launch(void* const* d_in, const int* in_sizes, int n_in, void* d_out, int out_size, void* d_ws, size_t ws_size, hipStream_t stream) {
    static int grid = 0;
    if (grid == 0) {
        if (n_in != 33 || out_size != M * D || ws_size < WS_END) { fprintf(stderr, "kernel_launch: unexpected shapes (n_in %d out %d ws %zu)\n", n_in, out_size, ws_size); grid = -1; return; }
        int dev = 0, cus = 0, per_cu = 0;
        hipGetDevice(&dev); hipDeviceGetAttribute(&cus, hipDeviceAttributeMultiprocessorCount, dev);
        hipFuncSetAttribute((const void*)mk_fwd, hipFuncAttributeMaxDynamicSharedMemorySize, LDS_BYTES);
        hipOccupancyMaxActiveBlocksPerMultiprocessor(&per_cu, (const void*)mk_fwd, 512, LDS_BYTES);
        if (per_cu < 1) per_cu = 1;
        grid = cus >= 256 ? 256 : cus;
        (void)hipGetLastError();
    }
    if (grid < 0) return;
    if (hipMemsetAsync(d_ws, 0, 65536, stream) != hipSuccess) { fprintf(stderr, "memset failed\n"); return; }
    Params p{};
    for (int i = 0; i < 33; ++i) p.in[i] = (const float*)d_in[i];
    p.out = (float*)d_out; p.ws = (unsigned char*)d_ws;
    for (int i = 0; i < 16; ++i) p.inv_freq[i] = 1.0 / pow(10000.0, (double)i / 16.0);
    void* args[] = {&p};
    hipError_t e = hipLaunchCooperativeKernel((const void*)mk_fwd, dim3(grid), dim3(512), args, LDS_BYTES, stream);
    if (e != hipSuccess) fprintf(stderr, "cooperative launch failed: %s (grid %d)\n", hipGetErrorString(e), grid);
}
```
